# Optimizing an MI355X kernel written in HIP

```python
import math, functools
import jax, jax.numpy as jnp
from jax import lax
import numpy as np

D_MODEL = 1024
BATCH = 4
SEQ = 4096
DEPTH = 1
DEC_BATCH = 128
DEC_SEQ = 4
PAST_LEN = 8192
PAGE_SIZE = 128

N_HEADS = 8
QK_NOPE = 64
QK_ROPE = 32
QK_HEAD = QK_NOPE + QK_ROPE
V_HEAD = 64
Q_LORA = 384
KV_LORA = 256
ROPE_THETA = 10000.0
Q_BLOCK = 128
D_CONV = D_MODEL // 2
CONV_WIDTH = 31
D_FF = -(-8 * D_MODEL // (3 * 256)) * 256
D_IN = 2 * D_CONV + Q_LORA + KV_LORA + QK_ROPE + 2 * D_MODEL
EPS = 1e-6

kernel_name = "conformer_conv_mla_gated_hybrid_step"


def _rmsnorm(x, g):
    x32 = x.astype(jnp.float32)
    y = x32 * lax.rsqrt(jnp.mean(x32 * x32, axis=-1, keepdims=True) + EPS)
    return (y * g.astype(jnp.float32)).astype(x.dtype)


def _layernorm(x, g, b):
    x32 = x.astype(jnp.float32)
    mu = jnp.mean(x32, axis=-1, keepdims=True)
    xc = x32 - mu
    y = xc * lax.rsqrt(jnp.mean(xc * xc, axis=-1, keepdims=True) + EPS)
    return (y * g.astype(jnp.float32) + b.astype(jnp.float32)).astype(x.dtype)


def _head_norm(v, g_compact):
    g = jnp.concatenate([g_compact, g_compact[QK_NOPE:]], axis=0)
    return _rmsnorm(v, g)


def _rope_angles(pos):
    inv_freq = 1.0 / (ROPE_THETA ** (jnp.arange(0, QK_ROPE, 2, dtype=jnp.float32) / QK_ROPE))
    ang = pos.astype(jnp.float32)[:, None] * inv_freq[None, :]
    return jnp.cos(ang), jnp.sin(ang)


def _apply_rope(x, cos, sin):
    half = QK_ROPE // 2
    x1, x2 = x[..., :half], x[..., half:]
    c = cos.astype(x.dtype)
    s = sin.astype(x.dtype)
    return jnp.concatenate([x1 * c - x2 * s, x2 * c + x1 * s], axis=-1)


def _split_in(p):
    i0 = 2 * D_CONV
    i1 = i0 + Q_LORA
    i2 = i1 + KV_LORA
    i3 = i2 + QK_ROPE
    i4 = i3 + D_MODEL
    return p[..., :i0], p[..., i0:i1], p[..., i1:i2], p[..., i2:i3], p[..., i3:i4], p[..., i4:]


def _mla_keys(c_kv, k_pe, w_uk, k_norm_g):
    k_nope = jnp.einsum('...tc,chd->...thd', c_kv, w_uk)
    k_pe_h = jnp.broadcast_to(k_pe[..., None, :], k_nope.shape[:-1] + (QK_ROPE,))
    return _head_norm(jnp.concatenate([k_nope, k_pe_h], axis=-1), k_norm_g)


def _mla_prompt(q, c_kv, k_pe, w_uk, w_uv, k_norm_g):
    b, s = q.shape[0], q.shape[1]
    k = _mla_keys(c_kv, k_pe, w_uk, k_norm_g)
    v = jnp.einsum('btc,chd->bthd', c_kv, w_uv)
    nb = s // Q_BLOCK
    qb = q.reshape(b, nb, Q_BLOCK, N_HEADS, QK_HEAD).transpose(1, 0, 2, 3, 4)
    kpos = jnp.arange(s)
    scale = 1.0 / math.sqrt(QK_HEAD)

    def block(args):
        qi, i = args
        sc = jnp.einsum('bqhd,bkhd->bhqk', qi, k).astype(jnp.float32) * scale
        qpos = i * Q_BLOCK + jnp.arange(Q_BLOCK)
        sc = jnp.where(kpos[None, :] <= qpos[:, None], sc, -jnp.inf)
        p = jax.nn.softmax(sc, axis=-1).astype(v.dtype)
        return jnp.einsum('bhqk,bkhd->bqhd', p, v)

    o = lax.map(block, (qb, jnp.arange(nb)))
    return o.transpose(1, 0, 2, 3, 4).reshape(b, s, N_HEADS * V_HEAD)


def _mla_sample(q, c_kv, k_pe, cache_lat, cache_kpe, page_table, w_uk, w_uv, k_norm_g):
    n_pages = page_table.shape[1]
    past = n_pages * PAGE_SIZE
    t_new = q.shape[1]
    kpos = jnp.arange(past + t_new)
    qpos = past + jnp.arange(t_new)
    mask = kpos[None, :] <= qpos[:, None]
    scale = 1.0 / math.sqrt(QK_HEAD)

    def one(args):
        qi, ci, kpi, pt = args
        c_all = jnp.concatenate([cache_lat[pt].reshape(past, KV_LORA), ci], axis=0)
        kpe_all = jnp.concatenate([cache_kpe[pt].reshape(past, QK_ROPE), kpi], axis=0)
        k = _mla_keys(c_all, kpe_all, w_uk, k_norm_g)
        sc = jnp.einsum('qhd,khd->hqk', qi, k).astype(jnp.float32) * scale
        sc = jnp.where(mask[None], sc, -jnp.inf)
        p = jax.nn.softmax(sc, axis=-1).astype(c_all.dtype)
        o_lat = jnp.einsum('hqk,kc->qhc', p, c_all)
        return jnp.einsum('qhc,chd->qhd', o_lat, w_uv)

    o = lax.map(one, (q, c_kv, k_pe, page_table))
    return o.reshape(q.shape[0], t_new, N_HEADS * V_HEAD)


def _conv_branch(glu_in, conv_prev, conv_w, conv_b, ln_g, ln_b, w_conv_out):
    a, g = glu_in[..., :D_CONV], glu_in[..., D_CONV:]
    u = a * jax.nn.sigmoid(g)
    u_ext = jnp.concatenate([conv_prev.astype(u.dtype), u], axis=1)
    y = lax.conv_general_dilated(u_ext, conv_w[:, None, :].astype(u.dtype), window_strides=(1,),
                                 padding='VALID', dimension_numbers=('NWC', 'WIO', 'NWC'),
                                 feature_group_count=D_CONV) + conv_b
    y = jax.nn.silu(_layernorm(y, ln_g, ln_b))
    return y @ w_conv_out, u_ext[:, -(CONV_WIDTH - 1):]


def _layer(x, pos, conv_prev, attend, norm_mix_g, w_in, q_a_norm_g, w_uq, kv_a_norm_g, q_norm_g,
           w_o_mla, conv_w, conv_b, conv_ln_g, conv_ln_b, w_conv_out, w_out, norm_ffn_g,
           w_gate, w_up, w_down):
    n, t = x.shape[0], x.shape[1]
    h = _rmsnorm(x, norm_mix_g)
    glu_in, c_q, c_kv, k_pe, g_conv, g_mla = _split_in(h @ w_in)
    conv_out, conv_state = _conv_branch(glu_in, conv_prev, conv_w, conv_b, conv_ln_g, conv_ln_b, w_conv_out)
    cos, sin = _rope_angles(pos)
    q = (_rmsnorm(c_q, q_a_norm_g) @ w_uq).reshape(n, t, N_HEADS, QK_HEAD)
    q = jnp.concatenate([q[..., :QK_NOPE], _apply_rope(q[..., QK_NOPE:], cos[:, None, :], sin[:, None, :])], axis=-1)
    q = _head_norm(q, q_norm_g)
    c_kv = _rmsnorm(c_kv, kv_a_norm_g)
    k_pe = _apply_rope(k_pe, cos, sin)
    mla_out = attend(q, c_kv, k_pe) @ w_o_mla
    merged = jax.nn.sigmoid(g_conv) * conv_out + jax.nn.sigmoid(g_mla) * mla_out
    x = x + merged @ w_out
    h2 = _rmsnorm(x, norm_ffn_g)
    x = x + (jax.nn.silu(h2 @ w_gate) * (h2 @ w_up)) @ w_down
    return x, c_kv, k_pe, conv_state


def setup_inputs(seed: int = 0) -> dict:
    key = jax.random.key(seed)
    ks = jax.random.split(key, 32)
    n_pages = PAST_LEN // PAGE_SIZE
    n_used = DEC_BATCH * n_pages
    n_phys = n_used + n_used // 4
    f32 = jnp.float32

    def w(k, shape, fan_in):
        return jax.random.normal(k, shape, f32) * (fan_in ** -0.5)

    def gain(k, shape):
        return 1.0 + 0.05 * jax.random.normal(k, shape, f32)

    page_table = jax.random.permutation(ks[5], n_phys)[:n_used].reshape(DEC_BATCH, n_pages).astype(jnp.int32)
    return {
        "x_prompt": jax.random.normal(ks[0], (BATCH, SEQ, D_MODEL), f32),
        "x_sample": jax.random.normal(ks[1], (DEC_BATCH, DEC_SEQ, D_MODEL), f32),
        "cache_kv_latent": jax.random.normal(ks[2], (DEPTH, n_phys, PAGE_SIZE, KV_LORA), f32),
        "cache_k_rope": jax.random.normal(ks[3], (DEPTH, n_phys, PAGE_SIZE, QK_ROPE), f32),
        "state_conv": 0.5 * jax.random.normal(ks[4], (DEPTH, DEC_BATCH, CONV_WIDTH - 1, D_CONV), f32),
        "page_table": page_table,
        "norm_mix_g": gain(ks[6], (DEPTH, D_MODEL)),
        "w_in": w(ks[7], (DEPTH, D_MODEL, D_IN), D_MODEL),
        "q_a_norm_g": gain(ks[8], (DEPTH, Q_LORA)),
        "w_uq": w(ks[9], (DEPTH, Q_LORA, N_HEADS * QK_HEAD), Q_LORA),
        "kv_a_norm_g": gain(ks[10], (DEPTH, KV_LORA)),
        "w_uk": w(ks[11], (DEPTH, KV_LORA, N_HEADS, QK_NOPE), KV_LORA),
        "w_uv": w(ks[12], (DEPTH, KV_LORA, N_HEADS, V_HEAD), KV_LORA),
        "q_norm_g": gain(ks[13], (DEPTH, QK_NOPE + QK_ROPE // 2)),
        "k_norm_g": gain(ks[14], (DEPTH, QK_NOPE + QK_ROPE // 2)),
        "w_o_mla": w(ks[15], (DEPTH, N_HEADS * V_HEAD, D_MODEL), N_HEADS * V_HEAD),
        "conv_w": w(ks[16], (DEPTH, CONV_WIDTH, D_CONV), CONV_WIDTH),
        "conv_b": 0.02 * jax.random.normal(ks[17], (DEPTH, D_CONV), f32),
        "conv_ln_g": gain(ks[18], (DEPTH, D_CONV)),
        "conv_ln_b": 0.02 * jax.random.normal(ks[19], (DEPTH, D_CONV), f32),
        "w_conv_out": w(ks[20], (DEPTH, D_CONV, D_MODEL), D_CONV),
        "w_out": w(ks[21], (DEPTH, D_MODEL, D_MODEL), D_MODEL),
        "norm_ffn_g": gain(ks[22], (DEPTH, D_MODEL)),
        "w_gate": w(ks[23], (DEPTH, D_MODEL, D_FF), D_MODEL),
        "w_up": w(ks[24], (DEPTH, D_MODEL, D_FF), D_MODEL),
        "w_down": w(ks[25], (DEPTH, D_FF, D_MODEL), D_FF),
    }


def reference(x_prompt, x_sample, cache_kv_latent, cache_k_rope, state_conv, page_table,
              norm_mix_g, w_in, q_a_norm_g, w_uq, kv_a_norm_g, w_uk, w_uv, q_norm_g, k_norm_g,
              w_o_mla, conv_w, conv_b, conv_ln_g, conv_ln_b, w_conv_out, w_out, norm_ffn_g,
              w_gate, w_up, w_down):
    past = page_table.shape[1] * PAGE_SIZE
    pos_p = jnp.arange(x_prompt.shape[1])
    pos_s = past + jnp.arange(x_sample.shape[1])
    yp, ys = x_prompt, x_sample
    lat_p, kpe_p, conv_p, lat_s, kpe_s, conv_s = [], [], [], [], [], []
    for l in range(DEPTH):
        lw = (norm_mix_g[l], w_in[l], q_a_norm_g[l], w_uq[l], kv_a_norm_g[l], q_norm_g[l],
              w_o_mla[l], conv_w[l], conv_b[l], conv_ln_g[l], conv_ln_b[l], w_conv_out[l],
              w_out[l], norm_ffn_g[l], w_gate[l], w_up[l], w_down[l])
        attend_p = functools.partial(_mla_prompt, w_uk=w_uk[l], w_uv=w_uv[l], k_norm_g=k_norm_g[l])
        zeros_prev = jnp.zeros((yp.shape[0], CONV_WIDTH - 1, D_CONV), yp.dtype)
        yp, c1, k1, s1 = _layer(yp, pos_p, zeros_prev, attend_p, *lw)
        attend_s = functools.partial(_mla_sample, cache_lat=cache_kv_latent[l], cache_kpe=cache_k_rope[l],
                                     page_table=page_table, w_uk=w_uk[l], w_uv=w_uv[l], k_norm_g=k_norm_g[l])
        ys, c2, k2, s2 = _layer(ys, pos_s, state_conv[l], attend_s, *lw)
        lat_p.append(c1); kpe_p.append(k1); conv_p.append(s1)
        lat_s.append(c2); kpe_s.append(k2); conv_s.append(s2)
    return (yp, ys, jnp.stack(lat_p), jnp.stack(kpe_p), jnp.stack(conv_p),
            jnp.stack(lat_s), jnp.stack(kpe_s), jnp.stack(conv_s))
```

```cpp
#include <hip/hip_runtime.h>
#include <cstdio>
#include <cstdint>
#include <math.h>
#define MK_HAVE_ATTN 1
namespace pg8 {
#define PG8_LAS __attribute__((address_space(3)))
typedef unsigned short bf16_t;
typedef short bf16x8 __attribute__((ext_vector_type(8)));
typedef float f32x4 __attribute__((ext_vector_type(4)));
typedef unsigned u32x4 __attribute__((ext_vector_type(4)));
constexpr int BM = 256, BK = 64, HALF = 128, HTB = HALF * BK * 2  , STAGE_BYTES = 8 * HTB, NXCD = 8, WGM = 8;

__host__ __device__ __forceinline__ int lds_byte(int r, int c) { const int st = (r >> 4) * 2 + (c >> 5), rr = r & 15, cc = c & 31, ob = rr * 64 + cc * 2; return st * 1024 + (ob ^ (((ob >> 9) & 1) << 5)); }
__host__ __device__ __forceinline__ void stage_rc(int b, int& R, int& C) { const int st = b / 1024, sb = b % 1024, swz = sb ^ (((sb >> 9) & 1) << 5); R = (st >> 1) * 16 + swz / 64; C = (st & 1) * 32 + (swz % 64) / 2; }
__host__ __device__ __forceinline__ int perm32(int rho) { const int n = rho >> 4, i = rho & 15; return 8 * (i >> 2) + 4 * n + (i & 3); }

struct Unit { int pm, pn; };
struct Gemm { const bf16_t* A; const bf16_t* Bt; int M, N, K; };

struct StaticOrder {
    int nM, nN, nwg, G, c;
    __host__ __device__ void init(int M, int N, int G_, int c_) { nM = M / BM; nN = N / BM; nwg = nM * nN; G = G_; c = c_; }
    __host__ __device__ bool next(int i, Unit& u) const {
        const long L = (long)i * G + c; if (L >= nwg) return false;
        int wgid = (int)L; { const int q = nwg / NXCD, r = nwg % NXCD, xcd = wgid % NXCD, off = wgid / NXCD; wgid = (xcd < r ? xcd * (q + 1) : r * (q + 1) + (xcd - r) * q) + off; }
        const int nig = WGM * nN, gid = wgid / nig, fm = gid * WGM, gsz = (nM - fm) < WGM ? (nM - fm) : WGM;
        u.pm = fm + ((wgid % nig) % gsz); u.pn = (wgid % nig) / gsz; return true;
    }
    __device__ __forceinline__ void a_ready(const Unit&) const {}
    __device__ __forceinline__ void done(const Unit&) const {}
};

__device__ __forceinline__ unsigned cvt_pk_bf16(float lo, float hi) { unsigned r; asm volatile("v_cvt_pk_bf16_f32 %0, %1, %2" : "=v"(r) : "v"(lo), "v"(hi)); return r; }
typedef float f32x2 __attribute__((ext_vector_type(2)));
__device__ __forceinline__ f32x2 gelu_pk(f32x2 v) {
    const f32x2 av = __builtin_elementwise_abs(v), d = av * 0.2316418882f + 1.0f;
    f32x2 t; t.x = __builtin_amdgcn_rcpf(d.x); t.y = __builtin_amdgcn_rcpf(d.y);
    f32x2 q = t * 0.5307027145f + (-0.7265760135f); q = q * t + 0.7107068705f; q = q * t + (-0.142248368f); q = q * t + 0.127414796f; q = q * t;
    const f32x2 s = (v * v) * (-0.72134752044f);
    f32x2 e; e.x = __builtin_amdgcn_exp2f(s.x); e.y = __builtin_amdgcn_exp2f(s.y);
    const f32x2 m = v * (q * e), r = v - m;
    f32x2 o; o.x = v.x < 0.f ? m.x : r.x; o.y = v.y < 0.f ? m.y : r.y; return o;
}

template <int ACT  > struct EpiBf16 {
    static constexpr bool PERM = true, AFTER_DRAIN = false; static_assert(ACT == 0 || ACT == 1, "EpiBf16: ACT is 0 (none) or 1 (gelu_pk)");
    bf16_t* O; int ldc; const float* bias; int split_cols; size_t split_stride; float scale0;
    __device__ __forceinline__ void operator()(const f32x4 (&acc)[2][2][4][2], const Unit& u, int wr, int wc, int fr, int fq) const {
        const int row0 = u.pm * BM + wr * 64 + fr; int colt = u.pn * BM; bf16_t* base = O;
        float sc = 1.f; if (split_cols) { const int t = colt / split_cols; base += (size_t)t * split_stride; colt -= t * split_cols; if (t == 0) sc = scale0; }
        const int col0 = colt + wc * 32 + 8 * fq, bcol0 = u.pn * BM + wc * 32 + 8 * fq;
        f32x4 bv[2][2];
#pragma unroll
        for (int bj = 0; bj < 2; ++bj)
#pragma unroll
            for (int n = 0; n < 2; ++n) bv[bj][n] = bias ? *(const f32x4*)(bias + bcol0 + bj * HALF + 4 * n) : (f32x4){0.f, 0.f, 0.f, 0.f};
#pragma unroll
        for (int ai = 0; ai < 2; ++ai)
#pragma unroll
            for (int m = 0; m < 4; ++m) { bf16_t* rowp = base + (size_t)(row0 + ai * HALF + m * 16) * ldc + col0;
#pragma unroll
                for (int bj = 0; bj < 2; ++bj) { f32x4 v0 = acc[ai][bj][m][0] + bv[bj][0], v1 = acc[ai][bj][m][1] + bv[bj][1];
                    if (ACT == 1) { f32x2 a = gelu_pk((f32x2){v0[0], v0[1]}), b = gelu_pk((f32x2){v0[2], v0[3]}), c = gelu_pk((f32x2){v1[0], v1[1]}), d = gelu_pk((f32x2){v1[2], v1[3]});
                        v0 = (f32x4){a.x, a.y, b.x, b.y}; v1 = (f32x4){c.x, c.y, d.x, d.y}; }
                    v0 = v0 * sc; v1 = v1 * sc; u32x4 w; w.x = cvt_pk_bf16(v0[0], v0[1]); w.y = cvt_pk_bf16(v0[2], v0[3]); w.z = cvt_pk_bf16(v1[0], v1[1]); w.w = cvt_pk_bf16(v1[2], v1[3]);
                    *(u32x4*)(rowp + bj * HALF) = w; } }
    }
};

template <class Epi, class Sched, bool ALIGN_EPI = false, bool SP2 = false>
__device__ __forceinline__ void gemm_phase(PG8_LAS unsigned char* lds, const Gemm g, const Sched& S, const Epi& E) {
    int tid_ = threadIdx.x; asm volatile("" : "+v"(tid_));
    const int tid = tid_, wid = __builtin_amdgcn_readfirstlane(tid >> 6), lane = tid & 63, wr = wid >> 2, wc = wid & 3, fr = lane & 15, fq = lane >> 4;
    const int K = g.K, nt = K / BK;
    unsigned voffA[2], voffB[2];
#pragma unroll
    for (int i = 0; i < 2; ++i) { int R, C; stage_rc(tid * 16 + i * 8192, R, C); const int Rb = Epi::PERM ? ((R & ~31) + perm32(R & 31)) : R;
        voffA[i] = (unsigned)(R * K + C) * 2u; voffB[i] = (unsigned)(Rb * K + C) * 2u; }
    const size_t kstep = (size_t)(BK * 2);
    const size_t hstep = (size_t)HALF * K * 2;
    const size_t tstep = 2 * hstep;
    const unsigned ldsw = (unsigned)wid * 1024u;
    const int aoff = lds_byte(wr * 64 + fr, fq * 8), boff = lds_byte(wc * 32 + fr, fq * 8);
#define PG8_SA(b, h) (((b) * 2 + (h)) * HTB)
#define PG8_SB(b, h) ((4 + (b) * 2 + (h)) * HTB)
#define PG8_STAGE(bufoff, gbase, voff) do { _Pragma("unroll") for (int _i = 0; _i < 2; ++_i) \
        __builtin_amdgcn_global_load_lds((const unsigned*)((const char*)(gbase) + (voff)[_i]), (PG8_LAS unsigned*)(lds + (bufoff) + ldsw + _i * 8192), 16, 0, 0); } while (0)
#define PG8_LDA(dst, b, h) do { _Pragma("unroll") for (int m = 0; m < 4; ++m) _Pragma("unroll") for (int k = 0; k < 2; ++k) dst[m][k] = *(const PG8_LAS bf16x8*)(lds + PG8_SA(b, h) + aoff + m * 2048 + k * 1024); } while (0)
#define PG8_LDB(dst, b, h) do { _Pragma("unroll") for (int n = 0; n < 2; ++n) _Pragma("unroll") for (int k = 0; k < 2; ++k) dst[n][k] = *(const PG8_LAS bf16x8*)(lds + PG8_SB(b, h) + boff + n * 2048 + k * 1024); } while (0)
#define PG8_MMA(ai, bj, At, Bt) do { __builtin_amdgcn_s_setprio(1); _Pragma("unroll") for (int m = 0; m < 4; ++m) _Pragma("unroll") for (int n = 0; n < 2; ++n) _Pragma("unroll") for (int k = 0; k < 2; ++k) \
        acc[ai][bj][m][n] = __builtin_amdgcn_mfma_f32_16x16x32_bf16(Bt[n][k], At[m][k], acc[ai][bj][m][n], 0, 0, 0); __builtin_amdgcn_s_setprio(0); } while (0)
#define PG8_WAIT_V(n) asm volatile("s_waitcnt vmcnt(" #n ")" ::: "memory")
#define PG8_WAIT_L(n) asm volatile("s_waitcnt lgkmcnt(" #n ")" ::: "memory")
#define PG8_BAR __builtin_amdgcn_s_barrier()
#define PG8_SCHED __builtin_amdgcn_sched_barrier(0)
    Unit cur, nxt; int ui = 0;
    if (!S.next(0, cur)) return;
    f32x4 acc[2][2][4][2];
#pragma unroll
    for (int a = 0; a < 2; ++a)
#pragma unroll
        for (int b = 0; b < 2; ++b)
#pragma unroll
            for (int m = 0; m < 4; ++m)
#pragma unroll
                for (int n = 0; n < 2; ++n) acc[a][b][m][n] = (f32x4){0.f, 0.f, 0.f, 0.f};
    bf16x8 At[4][2], B0[2][2], B1[2][2];
    const char* cA = (const char*)g.A + (size_t)cur.pm * tstep; const char* cB = (const char*)g.Bt + (size_t)cur.pn * tstep;
    S.a_ready(cur);
    if constexpr (SP2) {
        PG8_STAGE(PG8_SB(0, 0), cB, voffB); PG8_STAGE(PG8_SB(0, 1), cB + hstep, voffB); PG8_STAGE(PG8_SA(0, 0), cA, voffA); PG8_STAGE(PG8_SA(0, 1), cA + hstep, voffA);
        if (wr == 1) PG8_BAR;
        PG8_WAIT_V(2); PG8_BAR;
        PG8_STAGE(PG8_SB(1, 0), cB + kstep, voffB); PG8_STAGE(PG8_SA(1, 0), cA + kstep, voffA); PG8_STAGE(PG8_SB(1, 1), cB + hstep + kstep, voffB);
        PG8_WAIT_V(6); PG8_BAR;
    } else {
        PG8_STAGE(PG8_SB(0, 0), cB, voffB); PG8_STAGE(PG8_SA(0, 0), cA, voffA); PG8_STAGE(PG8_SB(0, 1), cB + hstep, voffB); PG8_STAGE(PG8_SA(0, 1), cA + hstep, voffA);
        if (wr == 1) PG8_BAR;
        PG8_WAIT_V(4); PG8_BAR;
        PG8_STAGE(PG8_SB(1, 0), cB + kstep, voffB); PG8_STAGE(PG8_SA(1, 0), cA + kstep, voffA); PG8_STAGE(PG8_SB(1, 1), cB + hstep + kstep, voffB);
        PG8_WAIT_V(6); PG8_BAR;
    }
    for (;;) {
        const bool has_next = S.next(ui + 1, nxt);
        const char* nA = has_next ? (const char*)g.A + (size_t)nxt.pm * tstep : cA; const char* nB = has_next ? (const char*)g.Bt + (size_t)nxt.pn * tstep : cB;
        for (int t = 0; t < nt; t += 2) {
            const bool last = (t == nt - 2);
            const char* a1 = cA + (size_t)(t + 1) * kstep;
            const char* a2 = last ? nA : cA + (size_t)(t + 2) * kstep; const char* b2 = last ? nB : cB + (size_t)(t + 2) * kstep;
            const char* a3 = a2 + kstep; const char* b3 = b2 + kstep;
            if (last && has_next) S.a_ready(nxt);
            if constexpr (SP2) {
            PG8_LDB(B0, 0, 0); PG8_LDB(B1, 0, 1); PG8_SCHED; PG8_LDA(At, 0, 0); PG8_STAGE(PG8_SA(1, 1), a1 + hstep, voffA);
            PG8_WAIT_V(8); PG8_WAIT_L(0); PG8_BAR; PG8_MMA(0, 0, At, B0); PG8_MMA(0, 1, At, B1); PG8_BAR; PG8_SCHED;
            PG8_LDA(At, 0, 1); PG8_STAGE(PG8_SB(0, 0), b2, voffB); PG8_STAGE(PG8_SB(0, 1), b2 + hstep, voffB); PG8_STAGE(PG8_SA(0, 0), a2, voffA);
            PG8_WAIT_V(8); PG8_WAIT_L(0); PG8_BAR; PG8_MMA(1, 0, At, B0); PG8_MMA(1, 1, At, B1); PG8_BAR; PG8_SCHED;
            PG8_LDB(B0, 1, 0); PG8_LDB(B1, 1, 1); PG8_SCHED; PG8_LDA(At, 1, 0); PG8_STAGE(PG8_SA(0, 1), a2 + hstep, voffA);
            PG8_WAIT_V(8); PG8_WAIT_L(0); PG8_BAR; PG8_MMA(0, 0, At, B0); PG8_MMA(0, 1, At, B1); PG8_BAR; PG8_SCHED;
            PG8_LDA(At, 1, 1); PG8_STAGE(PG8_SB(1, 0), b3, voffB); PG8_STAGE(PG8_SB(1, 1), b3 + hstep, voffB); PG8_STAGE(PG8_SA(1, 0), a3, voffA);
            PG8_WAIT_V(8); PG8_WAIT_L(0); PG8_BAR; PG8_MMA(1, 0, At, B0); PG8_MMA(1, 1, At, B1); PG8_BAR; PG8_SCHED;
            } else {
            PG8_LDB(B0, 0, 0); PG8_SCHED; PG8_LDA(At, 0, 0); PG8_STAGE(PG8_SA(1, 1), a1 + hstep, voffA);
            PG8_WAIT_L(8); PG8_BAR; PG8_WAIT_L(0); PG8_MMA(0, 0, At, B0); PG8_BAR; PG8_SCHED;
            PG8_LDB(B1, 0, 1); PG8_STAGE(PG8_SB(0, 0), b2, voffB);
            PG8_BAR; PG8_WAIT_L(0); PG8_MMA(0, 1, At, B1); PG8_BAR;
            PG8_LDA(At, 0, 1); PG8_STAGE(PG8_SA(0, 0), a2, voffA);
            PG8_BAR; PG8_WAIT_L(0); PG8_MMA(1, 0, At, B0); PG8_BAR; PG8_SCHED;
            PG8_STAGE(PG8_SB(0, 1), b2 + hstep, voffB);
            PG8_WAIT_V(6); PG8_BAR; PG8_MMA(1, 1, At, B1); PG8_BAR;
            PG8_LDB(B0, 1, 0); PG8_SCHED; PG8_LDA(At, 1, 0); PG8_STAGE(PG8_SA(0, 1), a2 + hstep, voffA);
            PG8_WAIT_L(8); PG8_BAR; PG8_WAIT_L(0); PG8_MMA(0, 0, At, B0); PG8_BAR; PG8_SCHED;
            PG8_LDB(B1, 1, 1); PG8_STAGE(PG8_SB(1, 0), b3, voffB);
            PG8_BAR; PG8_WAIT_L(0); PG8_MMA(0, 1, At, B1); PG8_BAR;
            PG8_LDA(At, 1, 1); PG8_STAGE(PG8_SA(1, 0), a3, voffA);
            PG8_BAR; PG8_WAIT_L(0); PG8_MMA(1, 0, At, B0); PG8_BAR; PG8_SCHED;
            PG8_STAGE(PG8_SB(1, 1), b3 + hstep, voffB);
            PG8_WAIT_V(6); PG8_BAR; PG8_MMA(1, 1, At, B1); PG8_BAR;
            }
        }
        if constexpr (ALIGN_EPI) { if (wr == 0) PG8_BAR; }
        if constexpr (!Epi::AFTER_DRAIN) { E(acc, cur, wr, wc, fr, fq); S.done(cur); }
        if (!has_next) break;
#pragma unroll
        for (int a = 0; a < 2; ++a)
#pragma unroll
            for (int b = 0; b < 2; ++b)
#pragma unroll
                for (int m = 0; m < 4; ++m)
#pragma unroll
                    for (int n = 0; n < 2; ++n) acc[a][b][m][n] = (f32x4){0.f, 0.f, 0.f, 0.f};
        cur = nxt; cA = nA; cB = nB; ++ui;
        if constexpr (ALIGN_EPI) { if (wr == 1) PG8_BAR; }
    }
    PG8_WAIT_V(0);
    if constexpr (!ALIGN_EPI) { if (wr == 0) PG8_BAR; }
    PG8_BAR;
    if constexpr (Epi::AFTER_DRAIN) { E.fused(acc, cur, wr, wc, fr, fq, lds, wid, lane); S.done(cur); }
#undef PG8_SA
#undef PG8_SB
#undef PG8_STAGE
#undef PG8_LDA
#undef PG8_LDB
#undef PG8_MMA
#undef PG8_WAIT_V
#undef PG8_WAIT_L
#undef PG8_BAR
#undef PG8_SCHED
}
}
#define GAS __attribute__((address_space(1)))
#define LAS __attribute__((address_space(3)))
typedef unsigned short bf16;
typedef unsigned v4u __attribute__((ext_vector_type(4)));
typedef float f32x4 __attribute__((ext_vector_type(4)));
typedef short bf16x8 __attribute__((ext_vector_type(8)));
typedef GAS unsigned gu32;
typedef GAS unsigned long long gu64;
#define RLX_AGENT __ATOMIC_RELAXED, __HIP_MEMORY_SCOPE_AGENT
#define LDS_WAIT() asm volatile("s_waitcnt lgkmcnt(0)" ::: "memory")
#define VM_WAIT() asm volatile("s_waitcnt vmcnt(0)" ::: "memory")
__device__ __forceinline__ unsigned long long rt() { return __builtin_amdgcn_s_memrealtime(); }
__device__ __forceinline__ unsigned f2bf(float f) { unsigned u = __builtin_bit_cast(unsigned, f); return (u + 0x7fffu + ((u >> 16) & 1u)) >> 16; }
__device__ __forceinline__ unsigned pk2(float lo, float hi) { return f2bf(lo) | (f2bf(hi) << 16); }

#define XB_TMO      128
#define XB_XCNT(j)  (256  + 64 * (j))
#define XB_XSUB(j)  (1280 + 64 * (j))
#define XB_XGEN(j)  (2304 + 64 * (j))
#define XB_TOP      3328
#define XB_TOPGEN   3392
#define XCD_BAR_WORDS 3456
#define XB_SPIN_CAP (1u << 18)

__device__ __forceinline__ unsigned xb_ld(unsigned* p)              { return __hip_atomic_load(p, __ATOMIC_RELAXED, __HIP_MEMORY_SCOPE_AGENT); }
__device__ __forceinline__ unsigned xb_add(unsigned* p, unsigned v) { return __hip_atomic_fetch_add(p, v, __ATOMIC_RELAXED, __HIP_MEMORY_SCOPE_AGENT); }
__device__ __forceinline__ unsigned xb_xcc_id() { return (unsigned)__builtin_amdgcn_s_getreg((3 << 11) | 20) & 0xFu; }
#define XB_SPIN(cond, bar) do { unsigned _sp = 0; while (cond) { __builtin_amdgcn_s_sleep(1); \
    if ((++_sp & 255u) == 0u) { if (xb_ld(&(bar)[XB_TMO])) break; if (_sp > XB_SPIN_CAP) { atomicAdd(&(bar)[XB_TMO], 1u); break; } } } } while (0)

struct XcdBarrier {
    unsigned* bar; unsigned x;
    volatile LAS unsigned* st;
};

__device__ __forceinline__ XcdBarrier xcd_barrier_post(unsigned* bar, volatile LAS unsigned* st) {
    XcdBarrier b; b.bar = bar; b.x = xb_xcc_id(); b.st = st;
    if (threadIdx.x == 0) (void)xb_add(&bar[XB_XCNT(b.x)], 1u);
    return b;
}
__device__ __forceinline__ void xcd_barrier_complete(unsigned* bar, unsigned x, unsigned& nloc, unsigned& nx) {
    const unsigned G = gridDim.x * gridDim.y * gridDim.z;
    unsigned sum, cnt, mine, sp = 0u;
    for (;;) {
        sum = 0u; cnt = 0u; mine = 0u;
#pragma unroll
        for (unsigned j = 0; j < 16; ++j) { const unsigned c = xb_ld(&bar[XB_XCNT(j)]); sum += c; cnt += (c > 0u) ? 1u : 0u; mine = (j == x) ? c : mine; }
        if (sum == G) break;
        __builtin_amdgcn_s_sleep(1);
        if ((++sp & 255u) == 0u) { if (xb_ld(&bar[XB_TMO])) break; if (sp > XB_SPIN_CAP) { atomicAdd(&bar[XB_TMO], 1u); break; } }
    }
    nloc = mine > 0u ? mine : 1u; nx = cnt > 0u ? cnt : 1u;
}

__device__ __forceinline__ void xcd_barrier(const XcdBarrier& b) {
    asm volatile("s_waitcnt vmcnt(0)" ::: "memory");
    __syncthreads();
    if (threadIdx.x == 0) {
        unsigned* bar = b.bar;
        __builtin_amdgcn_s_waitcnt(0);
        unsigned nloc = b.st[0], nx = b.st[1];
        if (nloc == 0u) { xcd_barrier_complete(bar, b.x, nloc, nx); b.st[0] = nloc; b.st[1] = nx; }
        const unsigned old = xb_add(&bar[XB_XSUB(b.x)], 1u);
        const unsigned gen = old / nloc;
        if (old + 1u == (gen + 1u) * nloc) {
            __builtin_amdgcn_fence(__ATOMIC_RELEASE, "agent");
            asm volatile("s_waitcnt vmcnt(0)" ::: "memory");
            const unsigned og = xb_add(&bar[XB_TOP], 1u);
            const unsigned tg = og / nx;
            if (og + 1u == (tg + 1u) * nx) xb_add(&bar[XB_TOPGEN], 1u);
            else XB_SPIN(xb_ld(&bar[XB_TOPGEN]) == tg, bar);
            __builtin_amdgcn_fence(__ATOMIC_ACQUIRE, "agent");
            xb_add(&bar[XB_XGEN(b.x)], 1u);
            asm volatile("s_waitcnt vmcnt(0)" ::: "memory");
        } else {
            XB_SPIN(xb_ld(&bar[XB_XGEN(b.x)]) == gen, bar);
            __builtin_amdgcn_fence(__ATOMIC_ACQUIRE, "agent");
            asm volatile("s_waitcnt vmcnt(0)" ::: "memory");
        }
    }
    __syncthreads();
}
namespace mk {
constexpr int D_MODEL = 1024, BATCH = 4, SEQ = 4096, DEC_BATCH = 128, DEC_SEQ = 4, PAST = 8192, PAGE = 128, NPAGES = 64;
constexpr int NH = 8, NOPE = 64, ROPE = 32, QKH = 96, VH = 64, QLORA = 384, KVLORA = 256;
constexpr int DCONV = 512, CW = 31, DFF = 2816, DIN = 3744;
constexpr int MP = BATCH * SEQ, MS = DEC_BATCH * DEC_SEQ, M = MP + MS;
constexpr float EPS = 1e-6f;
constexpr float LOG2E = 1.4426950408889634f;
constexpr float QSCALE = 0.10206207261596577f * LOG2E;
constexpr size_t O_YP = 0, O_YS = O_YP + (size_t)MP * 1024, O_LATP = O_YS + (size_t)MS * 1024, O_KRP = O_LATP + (size_t)MP * 256,
                 O_CSP = O_KRP + (size_t)MP * 32, O_LATS = O_CSP + (size_t)BATCH * 30 * 512, O_KRS = O_LATS + (size_t)MS * 256,
                 O_CSS = O_KRS + (size_t)MS * 32, O_END = O_CSS + (size_t)DEC_BATCH * 30 * 512;
constexpr int NIN = 3840;
constexpr int NQP = 1024;
constexpr int NGU = 2 * DFF;
constexpr int NPOS = SEQ + DEC_SEQ;

constexpr size_t al(size_t x) { return (x + 4095) / 4096 * 4096; }
constexpr size_t WS_CTL = 0, CTL_ZERO_BYTES = 1u << 20;
constexpr size_t WS_WIN = CTL_ZERO_BYTES;
constexpr size_t WS_WUQ = WS_WIN + al((size_t)NIN * 1024 * 2);
constexpr size_t WS_WKV = WS_WUQ + al((size_t)NQP * 384 * 2);
constexpr size_t WS_WC = WS_WKV + al((size_t)1024 * 256 * 2);
constexpr size_t WS_WO = WS_WC + al((size_t)1024 * 512 * 2);
constexpr size_t WS_WOUT = WS_WO + al((size_t)1024 * 512 * 2);
constexpr size_t WS_WGU = WS_WOUT + al((size_t)1024 * 1024 * 2);
constexpr size_t WS_WD = WS_WGU + al((size_t)NGU * 1024 * 2);
constexpr size_t WS_TAB = WS_WD + al((size_t)1024 * DFF * 2);
constexpr size_t WS_H = WS_TAB + al((size_t)NPOS * 32 * 4);
constexpr size_t WS_U = WS_H + al((size_t)M * 1024 * 2);
constexpr size_t WS_G = WS_U + al((size_t)M * 512 * 2);
constexpr size_t WS_RAW = WS_G + al((size_t)M * 2048 * 2);
constexpr size_t WS_CKV = WS_RAW + al((size_t)M * 768 * 4);
constexpr size_t WS_CQN = WS_CKV + al((size_t)M * 256 * 2);
constexpr size_t WS_KPE = WS_CQN + al((size_t)M * 384 * 2);
constexpr size_t WS_T = WS_KPE + al((size_t)M * 32 * 4);
constexpr size_t WS_QRAW = WS_T + al((size_t)M * 512 * 2);
constexpr size_t WS_KN = WS_QRAW + al((size_t)M * 1024 * 4);
constexpr size_t WS_V = WS_KN + al((size_t)M * 512 * 4);
constexpr size_t WS_Q = WS_V + al((size_t)M * 512 * 2);
constexpr size_t WS_K = WS_Q + al((size_t)M * 768 * 2);
constexpr size_t WS_O = WS_K + al((size_t)M * 768 * 2);
constexpr size_t WS_CONVO = WS_O + al((size_t)M * 512 * 2);
constexpr size_t WS_MERGED = WS_CONVO + al((size_t)M * 1024 * 2);
constexpr size_t WS_X1B = WS_MERGED + al((size_t)M * 1024 * 2);
constexpr size_t WS_SSQ2 = WS_X1B + al((size_t)M * 1024 * 2);
constexpr size_t WS_ACT = WS_SSQ2 + al((size_t)M * 16 * 4);
constexpr size_t WS_QLAT = WS_ACT + al((size_t)M * DFF * 2);
constexpr size_t WS_SPART = WS_QLAT + al((size_t)DEC_BATCH * 32 * 288 * 2);
constexpr int SA_UNITS_PER_SEQ = 8;
constexpr int SA_PART_STRIDE = 32 * 256 + 32;
constexpr size_t WS_END = WS_SPART + al((size_t)DEC_BATCH * SA_UNITS_PER_SEQ * SA_PART_STRIDE * 4);
constexpr int CW_BAR = 4096;

constexpr int NWAVES = 8, NTHREADS = 512;
constexpr int RING_OFF = 0, RING_BYTES = 131072;
constexpr int LDSCTL_OFF = RING_BYTES, MISC_OFF = LDSCTL_OFF + 320;
constexpr int LDS_BYTES = 147456;

typedef unsigned u32x2 __attribute__((ext_vector_type(2)));
typedef float f32x2 __attribute__((ext_vector_type(2)));

__device__ __forceinline__ float bf2f(bf16 b) { return __uint_as_float((unsigned)b << 16); }
__device__ __forceinline__ float sigm(float x) { return __builtin_amdgcn_rcpf(1.0f + __builtin_amdgcn_exp2f(-x * LOG2E)); }
__device__ __forceinline__ float wave_sum(float v) {
#pragma unroll
    for (int o = 1; o < 64; o <<= 1) v += __shfl_xor(v, o);
    return v;
}
typedef __bf16 bf16x2_t __attribute__((ext_vector_type(2)));
__device__ __forceinline__ unsigned cvtpk(float lo, float hi) { f32x2 v = {lo, hi}; bf16x2_t b = __builtin_convertvector(v, bf16x2_t); return __builtin_bit_cast(unsigned, b); }
__device__ __forceinline__ v4u pack8(const f32x4 a, const f32x4 b) { v4u w; w.x = cvtpk(a[0], a[1]); w.y = cvtpk(a[2], a[3]); w.z = cvtpk(b[0], b[1]); w.w = cvtpk(b[2], b[3]); return w; }

struct Frame {
    LAS unsigned char* lds;
    volatile LAS unsigned* MISC;
    gu32* ctl;
    int tid, lane, wave, G;
    const float* in[26];
    float* out;
    unsigned char* ws;
};
#define INP(i) (F.in[i])
enum { I_XP = 0, I_XS, I_CLAT, I_CKPE, I_SCONV, I_PT, I_NMG, I_WIN, I_QAG, I_WUQ, I_KVG, I_WUK, I_WUV, I_QNG, I_KNG, I_WOM, I_CVW, I_CVB, I_LNG, I_LNB, I_WCO, I_WOUT, I_NFG, I_WG, I_WU, I_WDN };
template <class T> __device__ __forceinline__ T* wsp(const Frame& F, size_t off) { return (T*)(F.ws + off); }

__device__ __forceinline__ void tr_item(const float* Wc0, int ldw, const float* kscale, bf16* WTr0, int K, int k0, LAS float* scr, int lane) {
#pragma unroll 8
    for (int i = 0; i < 32; ++i) { const int kk = 2 * i + (lane >> 5); float w = 0.f;
        if (Wc0) { w = Wc0[(size_t)(k0 + kk) * ldw + (lane & 31)]; if (kscale) w *= kscale[k0 + kk]; }
        scr[kk * 33 + (lane & 31)] = w; }
    LDS_WAIT(); asm volatile("" ::: "memory");
    const int c = lane & 7;
#pragma unroll
    for (int j = 0; j < 4; ++j) { const int n = (lane >> 3) + 8 * j; const LAS float* s = scr + (8 * c) * 33 + n;
        v4u o; o.x = pk2(s[0 * 33], s[1 * 33]); o.y = pk2(s[2 * 33], s[3 * 33]); o.z = pk2(s[4 * 33], s[5 * 33]); o.w = pk2(s[6 * 33], s[7 * 33]);
        *(GAS v4u*)(WTr0 + (size_t)n * K + k0 + 8 * c) = o; }
    LDS_WAIT(); asm volatile("" ::: "memory");
}
__device__ __forceinline__ int win_src_col(int n0) {
    if (n0 < 1024) { const int t = n0 >> 8, j = n0 & 255; return (j < 128) ? 128 * t + j : 512 + 128 * t + (j - 128); }
    if (n0 < 2048) return 1696 + (n0 - 1024);
    if (n0 < 3072) return 2720 + (n0 - 2048);
    if (n0 < 3328) return 1408 + (n0 - 3072);
    if (n0 < 3584) return 1024 + (n0 - 3328);
    if (n0 < 3712) return 1280 + (n0 - 3584);
    if (n0 < 3744) return 1664 + (n0 - 3712);
    return -1;
}
__device__ __forceinline__ void p0_prologue(Frame& F) {
    LAS float* scr = (LAS float*)(F.lds + RING_OFF + F.wave * 16384);
    const int gw = blockIdx.x * NWAVES + F.wave, NGW = F.G * NWAVES, lane = F.lane;
    constexpr int I_A = 120 * 16, I_B = 32 * 6, I_C = 32 * 4, I_D = 32 * 8, I_E = 32 * 8, I_F = 32 * 16, I_G = 176 * 16, I_H = 32 * 44;
    constexpr int NITEMS = I_A + I_B + I_C + I_D + I_E + I_F + I_G + I_H;
    for (int it = gw; it < NITEMS; it += NGW) {
        int r = it;
        if (r < I_A) { const int g = r / 16, kb = r % 16; const int sc = win_src_col(32 * g);
            tr_item(sc >= 0 ? INP(I_WIN) + sc : nullptr, DIN, INP(I_NMG), wsp<bf16>(F, WS_WIN) + (size_t)(32 * g) * 1024, 1024, 64 * kb, scr, lane); continue; } r -= I_A;
        if (r < I_B) { const int g = r / 6, kb = r % 6; const int h = g >> 2, part = g & 3;
            tr_item(part < 3 ? INP(I_WUQ) + 96 * h + 32 * part : nullptr, 768, INP(I_QAG), wsp<bf16>(F, WS_WUQ) + (size_t)(32 * g) * 384, 384, 64 * kb, scr, lane); continue; } r -= I_B;
        if (r < I_C) { const int g = r / 4, kb = r % 4;
            tr_item(g < 16 ? INP(I_WUK) + 32 * g : INP(I_WUV) + 32 * (g - 16), 512, nullptr, wsp<bf16>(F, WS_WKV) + (size_t)(32 * g) * 256, 256, 64 * kb, scr, lane); continue; } r -= I_C;
        if (r < I_D) { const int g = r / 8, kb = r % 8;
            tr_item(INP(I_WCO) + 32 * g, 1024, nullptr, wsp<bf16>(F, WS_WC) + (size_t)(32 * g) * 512, 512, 64 * kb, scr, lane); continue; } r -= I_D;
        if (r < I_E) { const int g = r / 8, kb = r % 8;
            tr_item(INP(I_WOM) + 32 * g, 1024, nullptr, wsp<bf16>(F, WS_WO) + (size_t)(32 * g) * 512, 512, 64 * kb, scr, lane); continue; } r -= I_E;
        if (r < I_F) { const int g = r / 16, kb = r % 16;
            tr_item(INP(I_WOUT) + 32 * g, 1024, nullptr, wsp<bf16>(F, WS_WOUT) + (size_t)(32 * g) * 1024, 1024, 64 * kb, scr, lane); continue; } r -= I_F;
        if (r < I_G) { const int g = r / 16, kb = r % 16; const int n0 = 32 * g, t = n0 >> 8, j = n0 & 255;
            tr_item(j < 128 ? INP(I_WG) + 128 * t + j : INP(I_WU) + 128 * t + (j - 128), DFF, INP(I_NFG), wsp<bf16>(F, WS_WGU) + (size_t)n0 * 1024, 1024, 64 * kb, scr, lane); continue; } r -= I_G;
        { const int g = r / 44, kb = r % 44;
            tr_item(INP(I_WDN) + 32 * g, 1024, nullptr, wsp<bf16>(F, WS_WD) + (size_t)(32 * g) * DFF, DFF, 64 * kb, scr, lane); }
    }
    bf16* H = wsp<bf16>(F, WS_H);
    for (int m = gw; m < M; m += NGW) {
        const float* xrow = (m < MP) ? INP(I_XP) + (size_t)m * 1024 : INP(I_XS) + (size_t)(m - MP) * 1024;
        const GAS f32x4* xr = (const GAS f32x4*)xrow + lane;
        f32x4 v[4]; float s = 0.f;
#pragma unroll
        for (int j = 0; j < 4; ++j) { v[j] = xr[64 * j]; s += (v[j].x * v[j].x + v[j].y * v[j].y) + (v[j].z * v[j].z + v[j].w * v[j].w); }
        const float rinv = 1.0f / sqrtf(wave_sum(s) * (1.0f / 1024.0f) + EPS);
        GAS unsigned long long* o8 = (GAS unsigned long long*)(H + (size_t)m * 1024) + lane;
#pragma unroll
        for (int j = 0; j < 4; ++j) o8[64 * j] = (unsigned long long)pk2(v[j].x * rinv, v[j].y * rinv) | ((unsigned long long)pk2(v[j].z * rinv, v[j].w * rinv) << 32);
    }
    float* TAB = wsp<float>(F, WS_TAB);
    for (int idx = blockIdx.x * NTHREADS + F.tid; idx < NPOS * 16; idx += F.G * NTHREADS) {
        const int p = idx >> 4, j = idx & 15; const int pos = (p < SEQ) ? p : PAST + (p - SEQ);
        const float invf = 1.0f / powf(10000.0f, (float)(2 * j) / 32.0f);
        const float angf = (float)pos * invf;
        TAB[p * 32 + j] = (float)cos((double)angf); TAB[p * 32 + 16 + j] = (float)sin((double)angf);
    }
    { const f32x4* src = (const f32x4*)INP(I_SCONV); f32x4* dst = (f32x4*)(F.out + O_CSS);
      for (int idx = blockIdx.x * NTHREADS + F.tid; idx < DEC_BATCH * 26 * 128; idx += F.G * NTHREADS) {
          const int db = idx / (26 * 128), rem = idx % (26 * 128); dst[(size_t)db * 30 * 128 + rem] = src[(size_t)db * 30 * 128 + 4 * 128 + rem]; } }
}

#define EPI_FOR_ROWS _Pragma("unroll") for (int ai = 0; ai < 2; ++ai) _Pragma("unroll") for (int m = 0; m < 4; ++m)
#define EPI_ROW (u.pm * 256 + ai * 128 + wr * 64 + m * 16 + fr)
struct EpiInProj {
    static constexpr bool PERM = true, AFTER_DRAIN = false;
    bf16* U; bf16* G; float* RAW; float* out;
    __device__ __forceinline__ void operator()(const f32x4 (&acc)[2][2][4][2], const pg8::Unit& u, int wr, int wc, int fr, int fq) const {
        const int cb = wc * 32 + 8 * fq;
        if (u.pn < 4) {
            const int ch = 128 * u.pn + cb;
            EPI_FOR_ROWS { const int row = EPI_ROW;
                f32x4 r0, r1;
#pragma unroll
                for (int e = 0; e < 4; ++e) { r0[e] = acc[ai][0][m][0][e] * sigm(acc[ai][1][m][0][e]); r1[e] = acc[ai][0][m][1][e] * sigm(acc[ai][1][m][1][e]); }
                *(v4u*)(U + (size_t)row * 512 + ch) = pack8(r0, r1);
                float* cs = nullptr;
                if (row < MP) { const int t = row & (SEQ - 1); if (t >= SEQ - 30) cs = out + O_CSP + ((size_t)(row >> 12) * 30 + (t - (SEQ - 30))) * 512 + ch; }
                else { const int rs = row - MP; cs = out + O_CSS + ((size_t)(rs >> 2) * 30 + 26 + (rs & 3)) * 512 + ch; }
                if (cs) { *(f32x4*)cs = r0; *(f32x4*)(cs + 4) = r1; }
            }
        } else if (u.pn < 12) {
            const int col = 256 * (u.pn - 4) + cb;
            EPI_FOR_ROWS { const int row = EPI_ROW;
#pragma unroll
                for (int bj = 0; bj < 2; ++bj) { f32x4 r0, r1;
#pragma unroll
                    for (int e = 0; e < 4; ++e) { r0[e] = sigm(acc[ai][bj][m][0][e]); r1[e] = sigm(acc[ai][bj][m][1][e]); }
                    *(v4u*)(G + (size_t)row * 2048 + col + 128 * bj) = pack8(r0, r1); }
            }
        } else {
            const int col = 256 * (u.pn - 12) + cb;
            EPI_FOR_ROWS { const int row = EPI_ROW;
#pragma unroll
                for (int bj = 0; bj < 2; ++bj) { float* p = RAW + (size_t)row * 768 + col + 128 * bj; *(f32x4*)p = acc[ai][bj][m][0]; *(f32x4*)(p + 4) = acc[ai][bj][m][1]; }
            }
        }
    }
};
struct EpiF32 {
    static constexpr bool PERM = true, AFTER_DRAIN = false;
    float* C; int ldc;
    __device__ __forceinline__ void operator()(const f32x4 (&acc)[2][2][4][2], const pg8::Unit& u, int wr, int wc, int fr, int fq) const {
        const int col = 256 * u.pn + wc * 32 + 8 * fq;
        EPI_FOR_ROWS { const int row = EPI_ROW;
#pragma unroll
            for (int bj = 0; bj < 2; ++bj) { float* p = C + (size_t)row * ldc + col + 128 * bj; *(f32x4*)p = acc[ai][bj][m][0]; *(f32x4*)(p + 4) = acc[ai][bj][m][1]; }
        }
    }
};
struct EpiKV {
    static constexpr bool PERM = true, AFTER_DRAIN = false;
    float* KN; bf16* V;
    __device__ __forceinline__ void operator()(const f32x4 (&acc)[2][2][4][2], const pg8::Unit& u, int wr, int wc, int fr, int fq) const {
        const int col = 256 * (u.pn & 1) + wc * 32 + 8 * fq;
        if (u.pn < 2) {
            EPI_FOR_ROWS { const int row = EPI_ROW;
#pragma unroll
                for (int bj = 0; bj < 2; ++bj) { float* p = KN + (size_t)row * 512 + col + 128 * bj; *(f32x4*)p = acc[ai][bj][m][0]; *(f32x4*)(p + 4) = acc[ai][bj][m][1]; }
            }
        } else {
            EPI_FOR_ROWS { const int row = EPI_ROW;
#pragma unroll
                for (int bj = 0; bj < 2; ++bj) *(v4u*)(V + (size_t)row * 512 + col + 128 * bj) = pack8(acc[ai][bj][m][0], acc[ai][bj][m][1]);
            }
        }
    }
};
__device__ __forceinline__ void unpack8(const v4u w, float (&f)[8]) {
    f[0] = __uint_as_float(w.x << 16); f[1] = __uint_as_float(w.x & 0xffff0000u); f[2] = __uint_as_float(w.y << 16); f[3] = __uint_as_float(w.y & 0xffff0000u);
    f[4] = __uint_as_float(w.z << 16); f[5] = __uint_as_float(w.z & 0xffff0000u); f[6] = __uint_as_float(w.w << 16); f[7] = __uint_as_float(w.w & 0xffff0000u);
}
struct EpiConv {
    static constexpr bool PERM = true, AFTER_DRAIN = false;
    const bf16* G; bf16* CONVO;
    __device__ __forceinline__ void operator()(const f32x4 (&acc)[2][2][4][2], const pg8::Unit& u, int wr, int wc, int fr, int fq) const {
        const int col = 256 * u.pn + wc * 32 + 8 * fq;
        EPI_FOR_ROWS { const int row = EPI_ROW;
#pragma unroll
            for (int bj = 0; bj < 2; ++bj) { float g[8]; unpack8(*(const v4u*)(G + (size_t)row * 2048 + col + 128 * bj), g);
                f32x4 r0, r1;
#pragma unroll
                for (int e = 0; e < 4; ++e) { r0[e] = acc[ai][bj][m][0][e] * g[e]; r1[e] = acc[ai][bj][m][1][e] * g[4 + e]; }
                *(v4u*)(CONVO + (size_t)row * 1024 + col + 128 * bj) = pack8(r0, r1); }
        }
    }
};
struct EpiMerge {
    static constexpr bool PERM = true, AFTER_DRAIN = false;
    const bf16* G; const bf16* CONVO; bf16* MERGED;
    __device__ __forceinline__ void operator()(const f32x4 (&acc)[2][2][4][2], const pg8::Unit& u, int wr, int wc, int fr, int fq) const {
        const int col = 256 * u.pn + wc * 32 + 8 * fq;
        EPI_FOR_ROWS { const int row = EPI_ROW;
#pragma unroll
            for (int bj = 0; bj < 2; ++bj) { float g[8], cv[8]; unpack8(*(const v4u*)(G + (size_t)row * 2048 + 1024 + col + 128 * bj), g); unpack8(*(const v4u*)(CONVO + (size_t)row * 1024 + col + 128 * bj), cv);
                f32x4 r0, r1;
#pragma unroll
                for (int e = 0; e < 4; ++e) { r0[e] = cv[e] + acc[ai][bj][m][0][e] * g[e]; r1[e] = cv[4 + e] + acc[ai][bj][m][1][e] * g[4 + e]; }
                *(v4u*)(MERGED + (size_t)row * 1024 + col + 128 * bj) = pack8(r0, r1); }
        }
    }
};
struct EpiOut {
    static constexpr bool PERM = true, AFTER_DRAIN = false;
    const float* xp; const float* xs; float* Y; bf16* X1B; float* SSQ2;
    __device__ __forceinline__ void operator()(const f32x4 (&acc)[2][2][4][2], const pg8::Unit& u, int wr, int wc, int fr, int fq) const {
        const int col = 256 * u.pn + wc * 32 + 8 * fq;
        EPI_FOR_ROWS { const int row = EPI_ROW;
            const float* xrow = (row < MP) ? xp + (size_t)row * 1024 : xs + (size_t)(row - MP) * 1024;
            float ss = 0.f;
#pragma unroll
            for (int bj = 0; bj < 2; ++bj) { const f32x4 x0 = *(const f32x4*)(xrow + col + 128 * bj), x1 = *(const f32x4*)(xrow + col + 128 * bj + 4);
                const f32x4 r0 = x0 + acc[ai][bj][m][0], r1 = x1 + acc[ai][bj][m][1];
                float* yp = Y + (size_t)row * 1024 + col + 128 * bj; *(f32x4*)yp = r0; *(f32x4*)(yp + 4) = r1;
                *(v4u*)(X1B + (size_t)row * 1024 + col + 128 * bj) = pack8(r0, r1);
                ss += (r0[0] * r0[0] + r0[1] * r0[1]) + (r0[2] * r0[2] + r0[3] * r0[3]) + (r1[0] * r1[0] + r1[1] * r1[1]) + (r1[2] * r1[2] + r1[3] * r1[3]); }
            ss += __shfl_xor(ss, 16); ss += __shfl_xor(ss, 32);
            if (fq == 0) SSQ2[(size_t)row * 16 + 4 * u.pn + wc] = ss;
        }
    }
};
struct EpiGateUp {
    static constexpr bool PERM = true, AFTER_DRAIN = false;
    const float* SSQ2; bf16* ACT;
    __device__ __forceinline__ void operator()(const f32x4 (&acc)[2][2][4][2], const pg8::Unit& u, int wr, int wc, int fr, int fq) const {
        const int ch = 128 * u.pn + wc * 32 + 8 * fq;
        EPI_FOR_ROWS { const int row = EPI_ROW;
            const f32x4* sp = (const f32x4*)(SSQ2 + (size_t)row * 16); const f32x4 s0 = sp[0], s1 = sp[1], s2 = sp[2], s3 = sp[3];
            const float ss = ((s0[0] + s0[1]) + (s0[2] + s0[3])) + ((s1[0] + s1[1]) + (s1[2] + s1[3])) + ((s2[0] + s2[1]) + (s2[2] + s2[3])) + ((s3[0] + s3[1]) + (s3[2] + s3[3]));
            const float rinv = 1.0f / sqrtf(ss * (1.0f / 1024.0f) + EPS);
            f32x4 r0, r1;
#pragma unroll
            for (int e = 0; e < 4; ++e) { const float g0 = acc[ai][0][m][0][e] * rinv, u0 = acc[ai][1][m][0][e] * rinv, g1 = acc[ai][0][m][1][e] * rinv, u1 = acc[ai][1][m][1][e] * rinv;
                r0[e] = g0 * sigm(g0) * u0; r1[e] = g1 * sigm(g1) * u1; }
            *(v4u*)(ACT + (size_t)row * DFF + ch) = pack8(r0, r1);
        }
    }
};
struct EpiDown {
    static constexpr bool PERM = true, AFTER_DRAIN = false;
    float* Y;
    __device__ __forceinline__ void operator()(const f32x4 (&acc)[2][2][4][2], const pg8::Unit& u, int wr, int wc, int fr, int fq) const {
        const int col = 256 * u.pn + wc * 32 + 8 * fq;
        EPI_FOR_ROWS { const int row = EPI_ROW;
#pragma unroll
            for (int bj = 0; bj < 2; ++bj) { float* yp = Y + (size_t)row * 1024 + col + 128 * bj; const f32x4 a = *(const f32x4*)yp, b = *(const f32x4*)(yp + 4);
                *(f32x4*)yp = a + acc[ai][bj][m][0]; *(f32x4*)(yp + 4) = b + acc[ai][bj][m][1]; }
        }
    }
};

__device__ __forceinline__ int pos_index(int row) { return row < MP ? (row & (SEQ - 1)) : SEQ + ((row - MP) & 3); }
__device__ __forceinline__ void p2a_row(Frame& F, int row) {
    const int lane = F.lane;
    const float* raw = wsp<float>(F, WS_RAW) + (size_t)row * 768;
    {
        const f32x4 v = *(const f32x4*)(raw + 4 * lane);
        const float ss = wave_sum((v.x * v.x + v.y * v.y) + (v.z * v.z + v.w * v.w));
        const float rinv = 1.0f / sqrtf(ss * (1.0f / 256.0f) + EPS);
        const f32x4 g = *(const f32x4*)(INP(I_KVG) + 4 * lane);
        const f32x4 o = v * rinv * g;
        float* lat = (row < MP) ? F.out + O_LATP + (size_t)row * 256 : F.out + O_LATS + (size_t)(row - MP) * 256;
        *(f32x4*)(lat + 4 * lane) = o;
        *(u32x2*)(wsp<bf16>(F, WS_CKV) + (size_t)row * 256 + 4 * lane) = (u32x2){pk2(o.x, o.y), pk2(o.z, o.w)};
    }
    {
        f32x2 q[3]; float ss = 0.f;
#pragma unroll
        for (int i = 0; i < 3; ++i) { q[i] = *(const f32x2*)(raw + 256 + 2 * lane + 128 * i); ss += q[i].x * q[i].x + q[i].y * q[i].y; }
        const float rinv = 1.0f / sqrtf(wave_sum(ss) * (1.0f / 384.0f) + EPS);
#pragma unroll
        for (int i = 0; i < 3; ++i) *(unsigned*)(wsp<bf16>(F, WS_CQN) + (size_t)row * 384 + 2 * lane + 128 * i) = pk2(q[i].x * rinv, q[i].y * rinv);
    }
    if (lane < 32) {
        const int j = lane & 15; const float x1 = raw[640 + j], x2 = raw[656 + j];
        const float* tb = wsp<float>(F, WS_TAB) + pos_index(row) * 32; const float c = tb[j], s = tb[16 + j];
        const float o = (lane < 16) ? (x1 * c - x2 * s) : (x2 * c + x1 * s);
        float* kr = (row < MP) ? F.out + O_KRP + (size_t)row * 32 : F.out + O_KRS + (size_t)(row - MP) * 32;
        kr[lane] = o; wsp<float>(F, WS_KPE)[(size_t)row * 32 + lane] = o;
    }
}
__device__ __forceinline__ void q_head(Frame& F, int row, int h, float& qn, float& qr) {
    const int lane = F.lane; const float* q = wsp<float>(F, WS_QRAW) + (size_t)row * 1024 + h * 128;
    const float v = q[lane]; float vr = 0.f;
    if (lane < 32) { const int j = lane & 15; const float x1 = q[64 + j], x2 = q[80 + j]; const float* tb = wsp<float>(F, WS_TAB) + pos_index(row) * 32; const float c = tb[j], s = tb[16 + j];
        vr = (lane < 16) ? (x1 * c - x2 * s) : (x2 * c + x1 * s); }
    const float rinv = 1.0f / sqrtf(wave_sum(v * v + vr * vr) * (1.0f / 96.0f) + EPS);
    const float* gq = INP(I_QNG);
    qn = v * rinv * gq[lane] * QSCALE; qr = vr * rinv * gq[64 + (lane & 15)] * QSCALE;
}
__device__ __forceinline__ void p2c_row(Frame& F, int row) {
    const int lane = F.lane; const float* gk = INP(I_KNG);
    bf16* Q = wsp<bf16>(F, WS_Q) + (size_t)row * 768; bf16* K = wsp<bf16>(F, WS_K) + (size_t)row * 768;
    for (int h = 0; h < NH; ++h) {
        float qn, qr; q_head(F, row, h, qn, qr);
        Q[h * 96 + lane] = (bf16)f2bf(qn); if (lane < 32) Q[h * 96 + 64 + lane] = (bf16)f2bf(qr);
        const float kv = wsp<float>(F, WS_KN)[(size_t)row * 512 + h * 64 + lane]; const float kr = (lane < 32) ? wsp<float>(F, WS_KPE)[(size_t)row * 32 + lane] : 0.f;
        const float rinv = 1.0f / sqrtf(wave_sum(kv * kv + kr * kr) * (1.0f / 96.0f) + EPS);
        K[h * 96 + lane] = (bf16)f2bf(kv * rinv * gk[lane]); if (lane < 32) K[h * 96 + 64 + lane] = (bf16)f2bf(kr * rinv * gk[64 + (lane & 15)]);
    }
}
__device__ __forceinline__ void qlat_job(Frame& F, int rs, int h) {
    const int lane = F.lane, row = MP + rs, db = rs >> 2, qi = rs & 3; const float* gk = INP(I_KNG);
    float qn, qr; q_head(F, row, h, qn, qr);
    const float a = qn * gk[lane], ar = qr * gk[64 + (lane & 15)];
    const bf16* W = wsp<bf16>(F, WS_WKV) + (size_t)(h * 64) * 256;
    float acc[4] = {0.f, 0.f, 0.f, 0.f};
    for (int d = 0; d < 64; ++d) { const float ad = __uint_as_float(__builtin_amdgcn_readlane(__float_as_uint(a), d));
#pragma unroll
        for (int i = 0; i < 4; ++i) acc[i] += ad * bf2f(W[(size_t)d * 256 + lane + 64 * i]); }
    bf16* o = wsp<bf16>(F, WS_QLAT) + ((size_t)db * 32 + h * 4 + qi) * 288;
#pragma unroll
    for (int i = 0; i < 4; ++i) o[lane + 64 * i] = (bf16)f2bf(acc[i]);
    if (lane < 32) o[256 + lane] = (bf16)f2bf(ar);
}

constexpr int CONV_ITEMS = BATCH * (SEQ / 32) + DEC_BATCH;
__device__ __forceinline__ void conv_item(Frame& F, int item) {
    const int c = F.tid, lane = F.lane;
    const bf16* U = wsp<bf16>(F, WS_U);
    float cw[CW];
#pragma unroll
    for (int w = 0; w < CW; ++w) cw[w] = INP(I_CVW)[w * 512 + c];
    float win[62]; int rowbase, nrows;
    if (item < BATCH * (SEQ / 32)) {
        const int seq = item >> 7, t0 = (item & 127) * 32; rowbase = seq * SEQ + t0; nrows = 32;
#pragma unroll
        for (int j = 0; j < 62; ++j) { const int tt = t0 - 30 + j; win[j] = (tt >= 0) ? bf2f(U[(size_t)(seq * SEQ + tt) * 512 + c]) : 0.f; }
    } else {
        const int db = item - BATCH * (SEQ / 32); rowbase = MP + db * 4; nrows = 4;
#pragma unroll
        for (int j = 0; j < 62; ++j) win[j] = (j < 30) ? INP(I_SCONV)[((size_t)db * 30 + j) * 512 + c] : ((j < 34) ? bf2f(U[(size_t)(MP + db * 4 + (j - 30)) * 512 + c]) : 0.f);
    }
    const float bias = INP(I_CVB)[c];
    LAS float* Y = (LAS float*)(F.lds + RING_OFF);
#pragma unroll
    for (int i = 0; i < 32; ++i) { float y = bias;
#pragma unroll
        for (int w = 0; w < CW; ++w) y += cw[w] * win[i + w];
        Y[i * 512 + c] = y; }
    __syncthreads();
    const f32x4 lg0 = *(const f32x4*)(INP(I_LNG) + 8 * lane), lg1 = *(const f32x4*)(INP(I_LNG) + 8 * lane + 4), lb0 = *(const f32x4*)(INP(I_LNB) + 8 * lane), lb1 = *(const f32x4*)(INP(I_LNB) + 8 * lane + 4);
#pragma unroll
    for (int rr = 0; rr < 4; ++rr) { const int i = 4 * F.wave + rr;
        if (i < nrows) {
            f32x4 a = *(const LAS f32x4*)(Y + i * 512 + 8 * lane), b = *(const LAS f32x4*)(Y + i * 512 + 8 * lane + 4);
            const float mean = wave_sum(((a.x + a.y) + (a.z + a.w)) + ((b.x + b.y) + (b.z + b.w))) * (1.0f / 512.0f);
            a = a - mean; b = b - mean;
            const float var = wave_sum(((a.x * a.x + a.y * a.y) + (a.z * a.z + a.w * a.w)) + ((b.x * b.x + b.y * b.y) + (b.z * b.z + b.w * b.w))) * (1.0f / 512.0f);
            const float rstd = 1.0f / sqrtf(var + EPS);
            f32x4 r0 = a * rstd * lg0 + lb0, r1 = b * rstd * lg1 + lb1;
#pragma unroll
            for (int e = 0; e < 4; ++e) { r0[e] = r0[e] * sigm(r0[e]); r1[e] = r1[e] * sigm(r1[e]); }
            *(v4u*)(wsp<bf16>(F, WS_T) + (size_t)(rowbase + i) * 512 + 8 * lane) = pack8(r0, r1);
        } }
    __syncthreads();
}
}
namespace mk {
typedef float f32x16 __attribute__((ext_vector_type(16)));
typedef short s16x4 __attribute__((ext_vector_type(4)));
typedef short v4i16_t __attribute__((ext_vector_type(4)));
__device__ __forceinline__ int crow(int r, int hi) { return (r & 3) + 8 * (r >> 2) + 4 * hi; }
__device__ __forceinline__ s16x4 tr_read(const LAS unsigned char* p) { return __builtin_bit_cast(s16x4, __builtin_amdgcn_ds_read_tr16_b64_v4i16((LAS v4i16_t*)p)); }
__device__ __forceinline__ bf16x8 lds_b128(const LAS unsigned char* p) { return *(const LAS bf16x8*)p; }

__device__ __forceinline__ float attn_bound(Frame& F) {
    const int lane = F.lane;
    float gq = fabsf(INP(I_QNG)[lane]), gk = fabsf(INP(I_KNG)[lane]);
    if (lane < 16) { gq = fmaxf(gq, fabsf(INP(I_QNG)[64 + lane])); gk = fmaxf(gk, fabsf(INP(I_KNG)[64 + lane])); }
#pragma unroll
    for (int o = 1; o < 64; o <<= 1) { gq = fmaxf(gq, __shfl_xor(gq, o)); gk = fmaxf(gk, __shfl_xor(gk, o)); }
    return 9.7979589711f * gq * gk * LOG2E * 1.02f + 0.05f;
}

constexpr int PA_KP = 208, PA_VP = 144;
constexpr int PA_KB = 0, PA_KBSZ = 64 * PA_KP, PA_VB = 2 * PA_KBSZ, PA_VBSZ = 64 * PA_VP, PA_LW = PA_VB + 2 * PA_VBSZ;
__device__ __forceinline__ void attn_prompt_unit(Frame& F, int b, int h, int qb, float B2) {
    const int tid = F.tid, lane = F.lane, wave = F.wave, r32 = lane & 31, hi = lane >> 5;
    const bf16* Qg = wsp<bf16>(F, WS_Q); const bf16* Kg = wsp<bf16>(F, WS_K); const bf16* Vg = wsp<bf16>(F, WS_V); bf16* Og = wsp<bf16>(F, WS_O);
    const size_t rowbase = (size_t)b * SEQ;
    const int q0 = qb * 256 + wave * 32;
    LAS unsigned char* ring = F.lds + RING_OFF;
    bf16x8 qr[6];
#pragma unroll
    for (int s = 0; s < 6; ++s) qr[s] = *(const bf16x8*)(Qg + (rowbase + q0 + r32) * 768 + h * 96 + 16 * s + 8 * hi);
    f32x16 o0, o1;
#pragma unroll
    for (int r = 0; r < 16; ++r) { o0[r] = 0.f; o1[r] = 0.f; }
    float lsum = 0.f;
    const int NT = 4 * qb + 4;
    const int kc0 = tid, kc1 = tid + 512;
    const int kkey0 = kc0 / 12, kpart0 = kc0 % 12, kkey1 = kc1 / 12, kpart1 = kc1 % 12, vkey = tid >> 3, vpart = tid & 7;
    const bf16* ksrc0 = Kg + (rowbase + kkey0) * 768 + h * 96 + 8 * kpart0;
    const bf16* ksrc1 = Kg + (rowbase + kkey1) * 768 + h * 96 + 8 * kpart1;
    const bf16* vsrc = Vg + (rowbase + vkey) * 512 + h * 64 + 8 * vpart;
    const int kdst0 = PA_KB + kkey0 * PA_KP + kpart0 * 16, kdst1 = PA_KB + kkey1 * PA_KP + kpart1 * 16, vdst = PA_VB + vkey * PA_VP + vpart * 16;
    v4u kreg0, kreg1 = (v4u){0u, 0u, 0u, 0u}, vreg;
#define PA_LOAD(t) do { kreg0 = *(const v4u*)(ksrc0 + (size_t)(t) * 64 * 768); if (tid < 256) kreg1 = *(const v4u*)(ksrc1 + (size_t)(t) * 64 * 768); vreg = *(const v4u*)(vsrc + (size_t)(t) * 64 * 512); } while (0)
#define PA_STORE(buf) do { *(LAS v4u*)(ring + (buf) * PA_KBSZ + kdst0) = kreg0; if (tid < 256) *(LAS v4u*)(ring + (buf) * PA_KBSZ + kdst1) = kreg1; *(LAS v4u*)(ring + (buf) * PA_VBSZ + vdst) = vreg; } while (0)
    PA_LOAD(0);
    const int tl = lane & 15, g4 = lane >> 4;
    const int vtr_off = (4 * hi + (tl >> 2)) * PA_VP + (16 * (g4 & 1) + 4 * (tl & 3)) * 2;
    for (int t = 0; t < NT; ++t) {
        const int buf = t & 1;
        PA_STORE(buf);
        __syncthreads();
        if (t + 1 < NT) PA_LOAD(t + 1);
        const LAS unsigned char* kb = ring + PA_KB + buf * PA_KBSZ + r32 * PA_KP + hi * 16;
        f32x16 p0, p1;
#pragma unroll
        for (int r = 0; r < 16; ++r) { p0[r] = -B2; p1[r] = -B2; }
#pragma unroll
        for (int s = 0; s < 6; ++s) {
            const bf16x8 a0 = lds_b128(kb + s * 32), a1 = lds_b128(kb + 32 * PA_KP + s * 32);
            p0 = __builtin_amdgcn_mfma_f32_32x32x16_bf16(a0, qr[s], p0, 0, 0, 0);
            p1 = __builtin_amdgcn_mfma_f32_32x32x16_bf16(a1, qr[s], p1, 0, 0, 0);
        }
#pragma unroll
        for (int r = 0; r < 16; ++r) { p0[r] = __builtin_amdgcn_exp2f(p0[r]); p1[r] = __builtin_amdgcn_exp2f(p1[r]); }
        if (t >= 4 * qb) {
            const int qq = q0 + r32, k0 = 64 * t + 4 * hi;
#pragma unroll
            for (int r = 0; r < 16; ++r) { const int kk = k0 + (r & 3) + 8 * (r >> 2); if (kk > qq) p0[r] = 0.f; if (kk + 32 > qq) p1[r] = 0.f; }
        }
        float sacc = 0.f;
#pragma unroll
        for (int r = 0; r < 16; ++r) sacc += p0[r] + p1[r];
        lsum += sacc;
        const LAS unsigned char* vb = ring + PA_VB + buf * PA_VBSZ + vtr_off;
#pragma unroll
        for (int mt = 0; mt < 2; ++mt)
#pragma unroll
            for (int s = 0; s < 2; ++s) {
                const f32x16& p = mt ? p1 : p0;
                v4u pw; pw.x = cvtpk(p[8 * s + 0], p[8 * s + 1]); pw.y = cvtpk(p[8 * s + 2], p[8 * s + 3]); pw.z = cvtpk(p[8 * s + 4], p[8 * s + 5]); pw.w = cvtpk(p[8 * s + 6], p[8 * s + 7]);
                const bf16x8 pa = __builtin_bit_cast(bf16x8, pw);
                const LAS unsigned char* vk = vb + (32 * mt + 16 * s) * PA_VP;
#pragma unroll
                for (int d0 = 0; d0 < 2; ++d0) {
                    const s16x4 lo = tr_read(vk + d0 * 64), h4 = tr_read(vk + d0 * 64 + 8 * PA_VP);
                    const bf16x8 vf = (bf16x8){lo[0], lo[1], lo[2], lo[3], h4[0], h4[1], h4[2], h4[3]};
                    if (d0 == 0) o0 = __builtin_amdgcn_mfma_f32_32x32x16_bf16(pa, vf, o0, 0, 0, 0); else o1 = __builtin_amdgcn_mfma_f32_32x32x16_bf16(pa, vf, o1, 0, 0, 0);
                }
            }
    }
#undef PA_LOAD
#undef PA_STORE
    lsum += __shfl_xor(lsum, 32);
    LAS float* lw = (LAS float*)(ring + PA_LW) + wave * 32;
    if (hi == 0) lw[r32] = lsum;
    LDS_WAIT(); asm volatile("" ::: "memory");
    bf16* orow = Og + (rowbase + q0) * 512 + h * 64 + r32;
#pragma unroll
    for (int r = 0; r < 16; ++r) { const int q = crow(r, hi); const float inv = 1.0f / lw[q];
        orow[(size_t)q * 512] = (bf16)f2bf(o0[r] * inv); orow[(size_t)q * 512 + 32] = (bf16)f2bf(o1[r] * inv); }
    LDS_WAIT(); asm volatile("" ::: "memory");
}
__device__ __forceinline__ void attn_prompt_phase(Frame& F) {
    const float B2 = attn_bound(F);
    for (int p = blockIdx.x; p < BATCH * NH * 8; p += F.G) {
        const int bh = p >> 3, s = p & 7;
        attn_prompt_unit(F, bh >> 3, bh & 7, s, B2);
        attn_prompt_unit(F, bh >> 3, bh & 7, 15 - s, B2);
    }
    __syncthreads();
}

constexpr int SA_CP = 592;
constexpr int SA_CB = 0, SA_CBSZ = 64 * SA_CP, SA_PB = 2 * SA_CBSZ, SA_PP = 144, SA_PSSQ = SA_PB + 16 * SA_PP, SA_QL = SA_PSSQ + 8 * 64 * 4, SA_LSW = SA_QL + 16 * SA_CP, SA_END = SA_LSW + 4 * 16 * 4;
static_assert(SA_END <= RING_BYTES, "sample attention LDS");
constexpr int SA_NUNITS = DEC_BATCH * SA_UNITS_PER_SEQ * 2;
constexpr int SA_PSTRIDE = 16 * 256 + 16;
static_assert((size_t)SA_NUNITS * SA_PSTRIDE == (size_t)DEC_BATCH * SA_UNITS_PER_SEQ * SA_PART_STRIDE, "partials size");
__device__ __forceinline__ void attn_sample_phase(Frame& F) {
    const int tid = F.tid, lane = F.lane, wave = F.wave, r32 = lane & 31, hi = lane >> 5, tl = lane & 15, g4 = lane >> 4;
    const float B2 = attn_bound(F);
    LAS unsigned char* ring = F.lds + RING_OFF;
    const float* clat = INP(I_CLAT); const float* ckpe = INP(I_CKPE); const int* ptab = (const int*)INP(I_PT);
    LAS float* PSSQ = (LAS float*)(ring + SA_PSSQ);
    LAS float* LSW = (LAS float*)(ring + SA_LSW);
    const int hl = wave >> 1, dh = wave & 1;
    const int bx = blockIdx.x; const bool paired = (F.G % 16) == 0;
    const int slot = paired ? (bx >> 4) * 8 + (bx & 7) : bx, hh_fixed = paired ? ((bx >> 3) & 1) : 0, nslots = paired ? F.G / 2 : F.G;
    for (int it = slot; it < (paired ? DEC_BATCH * SA_UNITS_PER_SEQ : SA_NUNITS); it += nslots) {
        const int pairid = paired ? it : (it >> 1), hh = paired ? hh_fixed : (it & 1);
        const int db = pairid >> 3, u = pairid & 7, unit = pairid * 2 + hh;
        bf16x8 wa[16];
        { const bf16* W = wsp<bf16>(F, WS_WKV) + (size_t)((4 * hh + hl) * 64 + 32 * dh + r32) * 256 + 8 * hi;
#pragma unroll
          for (int s = 0; s < 16; ++s) wa[s] = *(const bf16x8*)(W + 16 * s); }
        __syncthreads();
        {
            const bf16* src = wsp<bf16>(F, WS_QLAT) + ((size_t)db * 32 + 16 * hh) * 288;
#pragma unroll
            for (int j = 0; j < 2; ++j) { const int id = tid + 512 * j; if (id < 576) { const int row = id / 36, part = id % 36; *(LAS v4u*)(ring + SA_QL + row * SA_CP + part * 16) = *(const v4u*)(src + row * 288 + 8 * part); } }
        }
        f32x4 oacc0 = (f32x4){0.f, 0.f, 0.f, 0.f}, oacc1 = (f32x4){0.f, 0.f, 0.f, 0.f};
        float lsum[4] = {0.f, 0.f, 0.f, 0.f};
        f32x4 pre[9];
#define SA_LOAD(i) do { const int page_ = 8 * u + ((i) >> 1); const int phys_ = ptab[db * NPAGES + page_]; \
            const float* lat_ = clat + ((size_t)phys_ * PAGE + ((i) & 1) * 64) * KVLORA; const float* kp_ = ckpe + ((size_t)phys_ * PAGE + ((i) & 1) * 64) * ROPE; \
            _Pragma("unroll") for (int j_ = 0; j_ < 8; ++j_) pre[j_] = *(const f32x4*)(lat_ + 4 * (tid + 512 * j_)); \
            pre[8] = *(const f32x4*)(kp_ + 4 * tid); } while (0)
#define SA_STORE(buf) do { LAS unsigned char* cb_ = ring + SA_CB + (buf) * SA_CBSZ; \
            _Pragma("unroll") for (int j_ = 0; j_ < 8; ++j_) { const int id_ = tid + 512 * j_; *(LAS u32x2*)(cb_ + (id_ >> 6) * SA_CP + (id_ & 63) * 8) = (u32x2){cvtpk(pre[j_][0], pre[j_][1]), cvtpk(pre[j_][2], pre[j_][3])}; } \
            *(LAS u32x2*)(cb_ + (tid >> 3) * SA_CP + 512 + (tid & 7) * 8) = (u32x2){cvtpk(pre[8][0], pre[8][1]), cvtpk(pre[8][2], pre[8][3])}; } while (0)
        SA_LOAD(0);
        SA_STORE(0);
        SA_LOAD(1);
        __syncthreads();
        for (int i = 0; i < 16; ++i) {
            const int buf = i & 1;
            const LAS unsigned char* cb = ring + SA_CB + buf * SA_CBSZ;
#pragma unroll
            for (int kt = 0; kt < 2; ++kt) {
                const LAS unsigned char* crow_p = cb + (32 * kt + r32) * SA_CP + hi * 16;
                f32x16 a0;
#pragma unroll
                for (int r = 0; r < 16; ++r) a0[r] = 0.f;
#pragma unroll
                for (int s = 0; s < 16; ++s) a0 = __builtin_amdgcn_mfma_f32_32x32x16_bf16(wa[s], lds_b128(crow_p + s * 32), a0, 0, 0, 0);
                float ssq = 0.f;
#pragma unroll
                for (int r = 0; r < 16; ++r) ssq += a0[r] * a0[r];
                if (dh == 0) { float kf[8]; unpack8(*(const LAS v4u*)(cb + (32 * kt + r32) * SA_CP + 512 + hi * 32), kf);
#pragma unroll
                  for (int e = 0; e < 8; ++e) ssq += kf[e] * kf[e];
                  unpack8(*(const LAS v4u*)(cb + (32 * kt + r32) * SA_CP + 512 + hi * 32 + 16), kf);
#pragma unroll
                  for (int e = 0; e < 8; ++e) ssq += kf[e] * kf[e]; }
                ssq += __shfl_xor(ssq, 32);
                if (hi == 0) PSSQ[wave * 64 + 32 * kt + r32] = ssq;
            }
            f32x4 sc = (f32x4){0.f, 0.f, 0.f, 0.f};
            if (wave < 4) {
#pragma unroll
                for (int ks = 0; ks < 9; ++ks) {
                    const bf16x8 af = lds_b128(ring + SA_QL + tl * SA_CP + (32 * ks + 8 * g4) * 2);
                    const bf16x8 bfr = lds_b128(cb + (16 * wave + tl) * SA_CP + (32 * ks + 8 * g4) * 2);
                    sc = __builtin_amdgcn_mfma_f32_16x16x32_bf16(af, bfr, sc, 0, 0, 0);
                }
            }
            __syncthreads();
            if (wave < 4) {
                const int key = 16 * wave + tl;
                const float rinv = 1.0f / sqrtf((PSSQ[(2 * g4) * 64 + key] + PSSQ[(2 * g4 + 1) * 64 + key]) * (1.0f / 96.0f) + EPS);
#pragma unroll
                for (int q = 0; q < 4; ++q) { const float p = __builtin_amdgcn_exp2f(sc[q] * rinv - B2); lsum[q] += p;
                    *(LAS bf16*)(ring + SA_PB + (4 * g4 + q) * SA_PP + key * 2) = (bf16)f2bf(p); }
            }
            if (i + 1 < 16) { SA_STORE(buf ^ 1); if (i + 2 < 16) SA_LOAD(i + 2); }
            __syncthreads();
#pragma unroll
            for (int ks = 0; ks < 2; ++ks) {
                const bf16x8 pa = lds_b128(ring + SA_PB + tl * SA_PP + (32 * ks + 8 * g4) * 2);
                const LAS unsigned char* vb = cb + (32 * ks + 8 * g4 + (tl >> 2)) * SA_CP + (32 * wave + 4 * (tl & 3)) * 2;
                { const s16x4 lo = tr_read(vb), h4 = tr_read(vb + 4 * SA_CP);
                  oacc0 = __builtin_amdgcn_mfma_f32_16x16x32_bf16(pa, (bf16x8){lo[0], lo[1], lo[2], lo[3], h4[0], h4[1], h4[2], h4[3]}, oacc0, 0, 0, 0); }
                { const s16x4 lo = tr_read(vb + 32), h4 = tr_read(vb + 32 + 4 * SA_CP);
                  oacc1 = __builtin_amdgcn_mfma_f32_16x16x32_bf16(pa, (bf16x8){lo[0], lo[1], lo[2], lo[3], h4[0], h4[1], h4[2], h4[3]}, oacc1, 0, 0, 0); }
            }
        }
#undef SA_LOAD
#undef SA_STORE
        float* part = wsp<float>(F, WS_SPART) + (size_t)unit * SA_PSTRIDE;
#pragma unroll
        for (int r = 0; r < 4; ++r) { part[(4 * g4 + r) * 256 + 32 * wave + tl] = oacc0[r]; part[(4 * g4 + r) * 256 + 32 * wave + 16 + tl] = oacc1[r]; }
        if (wave < 4) {
#pragma unroll
            for (int q = 0; q < 4; ++q) { float v = lsum[q]; v += __shfl_xor(v, 1); v += __shfl_xor(v, 2); v += __shfl_xor(v, 4); v += __shfl_xor(v, 8); if (tl == 0) LSW[wave * 16 + g4 * 4 + q] = v; }
        }
        __syncthreads();
        if (tid < 16) part[16 * 256 + tid] = (LSW[tid] + LSW[16 + tid]) + (LSW[32 + tid] + LSW[48 + tid]);
    }
    __syncthreads();
}

__device__ __forceinline__ void attn_combine_phase(Frame& F) {
    const int lane = F.lane, wave = F.wave;
    const float B2 = attn_bound(F);
    const int gw = blockIdx.x * NWAVES + wave, NGW = F.G * NWAVES;
    LAS float* LO = (LAS float*)(F.lds + RING_OFF) + wave * 1024;
    const bf16* Qg = wsp<bf16>(F, WS_Q); const bf16* Kg = wsp<bf16>(F, WS_K); const bf16* CKV = wsp<bf16>(F, WS_CKV);
    const float* wuv = INP(I_WUV);
    for (int j = gw; j < DEC_BATCH * NH; j += NGW) {
        const int db = j >> 3, h = j & 7;
        float ol[4][4], l[4];
#pragma unroll
        for (int q = 0; q < 4; ++q) { l[q] = 0.f;
#pragma unroll
            for (int i = 0; i < 4; ++i) ol[q][i] = 0.f; }
        for (int u = 0; u < SA_UNITS_PER_SEQ; ++u) {
            const float* part = wsp<float>(F, WS_SPART) + (size_t)((db * SA_UNITS_PER_SEQ + u) * 2 + (h >> 2)) * SA_PSTRIDE;
#pragma unroll
            for (int q = 0; q < 4; ++q) { l[q] += part[16 * 256 + 4 * (h & 3) + q];
#pragma unroll
                for (int i = 0; i < 4; ++i) ol[q][i] += part[(4 * (h & 3) + q) * 256 + lane + 64 * i]; }
        }
#pragma unroll
        for (int jn = 0; jn < 4; ++jn) {
            const size_t rk = (size_t)(MP + db * 4 + jn);
            const float kn = bf2f(Kg[rk * 768 + h * 96 + lane]); const float kr = (lane < 32) ? bf2f(Kg[rk * 768 + h * 96 + 64 + lane]) : 0.f;
            float c4[4];
#pragma unroll
            for (int i = 0; i < 4; ++i) c4[i] = bf2f(CKV[rk * 256 + lane + 64 * i]);
#pragma unroll
            for (int q = 0; q < 4; ++q) if (q >= jn) {
                const size_t rq = (size_t)(MP + db * 4 + q);
                const float qn = bf2f(Qg[rq * 768 + h * 96 + lane]); const float qr = (lane < 32) ? bf2f(Qg[rq * 768 + h * 96 + 64 + lane]) : 0.f;
                const float s = wave_sum(qn * kn + qr * kr); const float p = __builtin_amdgcn_exp2f(s - B2);
                l[q] += p;
#pragma unroll
                for (int i = 0; i < 4; ++i) ol[q][i] += p * c4[i];
            }
        }
#pragma unroll
        for (int q = 0; q < 4; ++q)
#pragma unroll
            for (int i = 0; i < 4; ++i) LO[q * 256 + lane + 64 * i] = ol[q][i];
        LDS_WAIT(); asm volatile("" ::: "memory");
        float o[4] = {0.f, 0.f, 0.f, 0.f};
        for (int c = 0; c < KVLORA; ++c) { const float w = wuv[(size_t)c * 512 + h * 64 + lane];
#pragma unroll
            for (int q = 0; q < 4; ++q) o[q] += LO[q * 256 + c] * w; }
#pragma unroll
        for (int q = 0; q < 4; ++q) wsp<bf16>(F, WS_O)[(size_t)(MP + db * 4 + q) * 512 + h * 64 + lane] = (bf16)f2bf(o[q] / l[q]);
        LDS_WAIT(); asm volatile("" ::: "memory");
    }
}
}
namespace mk {
struct Args { const float* in[26]; float* out; unsigned char* ws; int ph_lo, ph_hi, li, pad; };
enum { PH_PRO = 0, PH_INPROJ, PH_ROWA, PH_QKV, PH_ROWC, PH_ATTN, PH_COMB, PH_MERGE, PH_OUT, PH_GU, PH_DOWN, PH_N };

__global__ void __launch_bounds__(NTHREADS, 2) fused_fwd(Args args) {
    extern __shared__ __attribute__((aligned(16))) unsigned char lds[];
    Frame F;
    F.lds = (LAS unsigned char*)lds;
    F.MISC = (volatile LAS unsigned*)(F.lds + MISC_OFF);
    F.tid = threadIdx.x; F.lane = F.tid & 63; F.wave = __builtin_amdgcn_readfirstlane(F.tid >> 6);
    F.G = gridDim.x;
#pragma unroll
    for (int i = 0; i < 26; ++i) F.in[i] = args.in[i];
    F.out = args.out; F.ws = args.ws; F.ctl = (gu32*)(args.ws + WS_CTL);
    for (int u = F.tid; u < (LDS_BYTES - LDSCTL_OFF) / 4; u += NTHREADS) ((LAS unsigned*)(F.lds + LDSCTL_OFF))[u] = 0u;
    __syncthreads();
    XcdBarrier bar = xcd_barrier_post((unsigned*)(F.ctl + CW_BAR) + args.li * XCD_BAR_WORDS, F.MISC + 8);
    const int lo = args.ph_lo, hi = args.ph_hi;
#define IN(k) (lo <= (k) && (k) < hi)
#define SEAM(k) do { if (IN(k) && IN((k) + 1)) xcd_barrier(bar); } while (0)
    const int gw = blockIdx.x * NWAVES + F.wave, NGW = F.G * NWAVES;
    LAS unsigned char* ring = F.lds + RING_OFF;

    if (IN(PH_PRO)) { p0_prologue(F); }
    SEAM(PH_PRO);
    if (IN(PH_INPROJ)) {
        pg8::Gemm g{wsp<bf16>(F, WS_H), wsp<bf16>(F, WS_WIN), M, NIN, 1024}; pg8::StaticOrder S; S.init(M, NIN, F.G, (int)blockIdx.x);
        EpiInProj E{wsp<bf16>(F, WS_U), wsp<bf16>(F, WS_G), wsp<float>(F, WS_RAW), F.out};
        pg8::gemm_phase<EpiInProj, pg8::StaticOrder, true, true>(ring, g, S, E);
    }
    SEAM(PH_INPROJ);
    if (IN(PH_ROWA)) {
        for (int m = gw; m < M; m += NGW) p2a_row(F, m);
        for (int it = blockIdx.x; it < CONV_ITEMS; it += F.G) conv_item(F, it);
    }
    SEAM(PH_ROWA);
    if (IN(PH_QKV)) {
        { pg8::Gemm g{wsp<bf16>(F, WS_CQN), wsp<bf16>(F, WS_WUQ), M, NQP, 384}; pg8::StaticOrder S; S.init(M, NQP, F.G, (int)blockIdx.x);
          EpiF32 E{wsp<float>(F, WS_QRAW), NQP}; pg8::gemm_phase<EpiF32, pg8::StaticOrder, true, true>(ring, g, S, E); }
        { pg8::Gemm g{wsp<bf16>(F, WS_CKV), wsp<bf16>(F, WS_WKV), M, 1024, 256}; pg8::StaticOrder S; S.init(M, 1024, F.G, (int)blockIdx.x);
          EpiKV E{wsp<float>(F, WS_KN), wsp<bf16>(F, WS_V)}; pg8::gemm_phase<EpiKV, pg8::StaticOrder, true, true>(ring, g, S, E); }
        { pg8::Gemm g{wsp<bf16>(F, WS_T), wsp<bf16>(F, WS_WC), M, 1024, 512}; pg8::StaticOrder S; S.init(M, 1024, F.G, (int)blockIdx.x);
          EpiConv E{wsp<bf16>(F, WS_G), wsp<bf16>(F, WS_CONVO)}; pg8::gemm_phase<EpiConv, pg8::StaticOrder, true, true>(ring, g, S, E); }
    }
    SEAM(PH_QKV);
    if (IN(PH_ROWC)) {
        for (int m = gw; m < M; m += NGW) p2c_row(F, m);
        for (int j = gw; j < MS * NH; j += NGW) qlat_job(F, j >> 3, j & 7);
    }
    SEAM(PH_ROWC);
    if (IN(PH_ATTN)) {
#if MK_HAVE_ATTN
        attn_prompt_phase(F);
        attn_sample_phase(F);
#endif
    }
    SEAM(PH_ATTN);
    if (IN(PH_COMB)) {
#if MK_HAVE_ATTN
        attn_combine_phase(F);
#endif
    }
    SEAM(PH_COMB);
    if (IN(PH_MERGE)) {
        pg8::Gemm g{wsp<bf16>(F, WS_O), wsp<bf16>(F, WS_WO), M, 1024, 512}; pg8::StaticOrder S; S.init(M, 1024, F.G, (int)blockIdx.x);
        EpiMerge E{wsp<bf16>(F, WS_G), wsp<bf16>(F, WS_CONVO), wsp<bf16>(F, WS_MERGED)}; pg8::gemm_phase<EpiMerge, pg8::StaticOrder, true, true>(ring, g, S, E);
    }
    SEAM(PH_MERGE);
    if (IN(PH_OUT)) {
        pg8::Gemm g{wsp<bf16>(F, WS_MERGED), wsp<bf16>(F, WS_WOUT), M, 1024, 1024}; pg8::StaticOrder S; S.init(M, 1024, F.G, (int)blockIdx.x);
        EpiOut E{INP(I_XP), INP(I_XS), F.out + O_YP, wsp<bf16>(F, WS_X1B), wsp<float>(F, WS_SSQ2)}; pg8::gemm_phase<EpiOut, pg8::StaticOrder, true, true>(ring, g, S, E);
    }
    SEAM(PH_OUT);
    if (IN(PH_GU)) {
        pg8::Gemm g{wsp<bf16>(F, WS_X1B), wsp<bf16>(F, WS_WGU), M, NGU, 1024}; pg8::StaticOrder S; S.init(M, NGU, F.G, (int)blockIdx.x);
        EpiGateUp E{wsp<float>(F, WS_SSQ2), wsp<bf16>(F, WS_ACT)}; pg8::gemm_phase<EpiGateUp, pg8::StaticOrder, true, true>(ring, g, S, E);
    }
    SEAM(PH_GU);
    if (IN(PH_DOWN)) {
        pg8::Gemm g{wsp<bf16>(F, WS_ACT), wsp<bf16>(F, WS_WD), M, 1024, DFF}; pg8::StaticOrder S; S.init(M, 1024, F.G, (int)blockIdx.x);
        EpiDown E{F.out + O_YP}; pg8::gemm_phase<EpiDown, pg8::StaticOrder, true, true>(ring, g, S, E);
    }
#undef IN
#undef SEAM
}

static int g_grid = 0;
inline bool setup_once() {
    if (g_grid == 0) {
        int dev = 0, cus = 0, per_cu = 0;
        if (hipGetDevice(&dev) != hipSuccess || hipDeviceGetAttribute(&cus, hipDeviceAttributeMultiprocessorCount, dev) != hipSuccess) { g_grid = -1; return false; }
        if (hipFuncSetAttribute((const void*)fused_fwd, hipFuncAttributeMaxDynamicSharedMemorySize, LDS_BYTES) != hipSuccess) { g_grid = -1; return false; }
        if (hipOccupancyMaxActiveBlocksPerMultiprocessor(&per_cu, (const void*)fused_fwd, NTHREADS, LDS_BYTES) != hipSuccess || per_cu < 1) { fprintf(stderr, "occupancy query says %d\n", per_cu); }
        (void)hipGetLastError();
        g_grid = cus;
    }
    return g_grid > 0;
}
inline void launch_phases(void* const* d_in, void* d_out, void* d_ws, hipStream_t stream, int lo, int hi, int li) {
    Args a{};
    for (int i = 0; i < 26; ++i) a.in[i] = (const float*)d_in[i];
    a.out = (float*)d_out; a.ws = (unsigned char*)d_ws; a.ph_lo = lo; a.ph_hi = hi; a.li = li; a.pad = 0;
    hipLaunchKernelGGL(fused_fwd, dim3(g_grid), dim3(NTHREADS), LDS_BYTES, stream, a);
}
}
extern "C" void kernel_launch(void* const* d_in, const int* in_sizes, int n_in, void* d_out, int out_size, void* d_ws, size_t ws_size, hipStream_t stream) {
    if (!mk::setup_once()) return;
    if (n_in != 26 || (size_t)out_size != mk::O_END || ws_size < mk::WS_END) { fprintf(stderr, "kernel_launch: unexpected shapes\n"); return; }
    if (hipMemsetAsync((char*)d_ws + mk::WS_CTL, 0, mk::CTL_ZERO_BYTES, stream) != hipSuccess) return;
    mk::launch_phases(d_in, d_out, d_ws, stream, 0, mk::PH_N, 0);
}
```

```cpp
#include <hip/hip_runtime.h>
#include <cstdio>
#include <cstdint>
#include <math.h>
#define MK_HAVE_ATTN 1
namespace pg8 {
#define PG8_LAS __attribute__((address_space(3)))
typedef unsigned short bf16_t;
typedef short bf16x8 __attribute__((ext_vector_type(8)));
typedef float f32x4 __attribute__((ext_vector_type(4)));
typedef unsigned u32x4 __attribute__((ext_vector_type(4)));
constexpr int BM = 256, BK = 64, HALF = 128, HTB = HALF * BK * 2  , STAGE_BYTES = 8 * HTB, NXCD = 8, WGM = 4;

__host__ __device__ __forceinline__ int lds_byte(int r, int c) { const int st = (r >> 4) * 2 + (c >> 5), rr = r & 15, cc = c & 31, ob = rr * 64 + cc * 2; return st * 1024 + (ob ^ (((ob >> 9) & 1) << 5)); }
__host__ __device__ __forceinline__ void stage_rc(int b, int& R, int& C) { const int st = b / 1024, sb = b % 1024, swz = sb ^ (((sb >> 9) & 1) << 5); R = (st >> 1) * 16 + swz / 64; C = (st & 1) * 32 + (swz % 64) / 2; }
__host__ __device__ __forceinline__ int perm32(int rho) { const int n = rho >> 4, i = rho & 15; return 8 * (i >> 2) + 4 * n + (i & 3); }

struct Unit { int pm, pn; };
struct Gemm { const bf16_t* A; const bf16_t* Bt; int M, N, K; int lda = 0, ldb = 0; };

struct StaticOrder {
    int nM, nN, nwg, G, c;
    __host__ __device__ void init(int M, int N, int G_, int c_) { nM = M / BM; nN = N / BM; nwg = nM * nN; G = G_; c = c_; }
    __host__ __device__ bool next(int i, Unit& u) const {
        const long L = (long)i * G + c; if (L >= nwg) return false;
        int wgid = (int)L; { const int q = nwg / NXCD, r = nwg % NXCD, xcd = wgid % NXCD, off = wgid / NXCD; wgid = (xcd < r ? xcd * (q + 1) : r * (q + 1) + (xcd - r) * q) + off; }
        const int nig = WGM * nN, gid = wgid / nig, fm = gid * WGM, gsz = (nM - fm) < WGM ? (nM - fm) : WGM;
        u.pm = fm + ((wgid % nig) % gsz); u.pn = (wgid % nig) / gsz; return true;
    }
    __device__ __forceinline__ void a_ready(const Unit&) const {}
    __device__ __forceinline__ void done(const Unit&) const {}
};

__device__ __forceinline__ unsigned cvt_pk_bf16(float lo, float hi) { unsigned r; asm volatile("v_cvt_pk_bf16_f32 %0, %1, %2" : "=v"(r) : "v"(lo), "v"(hi)); return r; }
typedef float f32x2 __attribute__((ext_vector_type(2)));
__device__ __forceinline__ f32x2 gelu_pk(f32x2 v) {
    const f32x2 av = __builtin_elementwise_abs(v), d = av * 0.2316418882f + 1.0f;
    f32x2 t; t.x = __builtin_amdgcn_rcpf(d.x); t.y = __builtin_amdgcn_rcpf(d.y);
    f32x2 q = t * 0.5307027145f + (-0.7265760135f); q = q * t + 0.7107068705f; q = q * t + (-0.142248368f); q = q * t + 0.127414796f; q = q * t;
    const f32x2 s = (v * v) * (-0.72134752044f);
    f32x2 e; e.x = __builtin_amdgcn_exp2f(s.x); e.y = __builtin_amdgcn_exp2f(s.y);
    const f32x2 m = v * (q * e), r = v - m;
    f32x2 o; o.x = v.x < 0.f ? m.x : r.x; o.y = v.y < 0.f ? m.y : r.y; return o;
}

template <int ACT  > struct EpiBf16 {
    static constexpr bool PERM = true, AFTER_DRAIN = false; static_assert(ACT == 0 || ACT == 1, "EpiBf16: ACT is 0 (none) or 1 (gelu_pk)");
    bf16_t* O; int ldc; const float* bias; int split_cols; size_t split_stride; float scale0;
    __device__ __forceinline__ void operator()(const f32x4 (&acc)[2][2][4][2], const Unit& u, int wr, int wc, int fr, int fq) const {
        const int row0 = u.pm * BM + wr * 64 + fr; int colt = u.pn * BM; bf16_t* base = O;
        float sc = 1.f; if (split_cols) { const int t = colt / split_cols; base += (size_t)t * split_stride; colt -= t * split_cols; if (t == 0) sc = scale0; }
        const int col0 = colt + wc * 32 + 8 * fq, bcol0 = u.pn * BM + wc * 32 + 8 * fq;
        f32x4 bv[2][2];
#pragma unroll
        for (int bj = 0; bj < 2; ++bj)
#pragma unroll
            for (int n = 0; n < 2; ++n) bv[bj][n] = bias ? *(const f32x4*)(bias + bcol0 + bj * HALF + 4 * n) : (f32x4){0.f, 0.f, 0.f, 0.f};
#pragma unroll
        for (int ai = 0; ai < 2; ++ai)
#pragma unroll
            for (int m = 0; m < 4; ++m) { bf16_t* rowp = base + (size_t)(row0 + ai * HALF + m * 16) * ldc + col0;
#pragma unroll
                for (int bj = 0; bj < 2; ++bj) { f32x4 v0 = acc[ai][bj][m][0] + bv[bj][0], v1 = acc[ai][bj][m][1] + bv[bj][1];
                    if (ACT == 1) { f32x2 a = gelu_pk((f32x2){v0[0], v0[1]}), b = gelu_pk((f32x2){v0[2], v0[3]}), c = gelu_pk((f32x2){v1[0], v1[1]}), d = gelu_pk((f32x2){v1[2], v1[3]});
                        v0 = (f32x4){a.x, a.y, b.x, b.y}; v1 = (f32x4){c.x, c.y, d.x, d.y}; }
                    v0 = v0 * sc; v1 = v1 * sc; u32x4 w; w.x = cvt_pk_bf16(v0[0], v0[1]); w.y = cvt_pk_bf16(v0[2], v0[3]); w.z = cvt_pk_bf16(v1[0], v1[1]); w.w = cvt_pk_bf16(v1[2], v1[3]);
                    *(u32x4*)(rowp + bj * HALF) = w; } }
    }
};

template <class Epi, class Sched, bool ALIGN_EPI = false, bool SP2 = false>
__device__ __forceinline__ void gemm_phase(PG8_LAS unsigned char* lds, const Gemm g, const Sched& S, const Epi& E, const int wave_in  ) {
    int tid_; asm volatile("v_mbcnt_lo_u32_b32 %0, -1, 0\n\tv_mbcnt_hi_u32_b32 %0, -1, %0" : "=v"(tid_)); tid_ += 64 * wave_in;
    const int tid = tid_, wid = __builtin_amdgcn_readfirstlane(tid >> 6), lane = tid & 63, wr = wid >> 2, wc = wid & 3, fr = lane & 15, fq = lane >> 4;
    const int K = g.K, nt = K / BK, lda = g.lda ? g.lda : K, ldb = g.ldb ? g.ldb : K;
    unsigned voffA[2], voffB[2];
#pragma unroll
    for (int i = 0; i < 2; ++i) { int R, C; stage_rc(tid * 16 + i * 8192, R, C); const int Rb = Epi::PERM ? ((R & ~31) + perm32(R & 31)) : R;
        voffA[i] = (unsigned)(R * lda + C) * 2u; voffB[i] = (unsigned)(Rb * ldb + C) * 2u; }
    const size_t kstep = (size_t)(BK * 2);
    const size_t hstepA = (size_t)HALF * lda * 2, hstepB = (size_t)HALF * ldb * 2;
    const size_t tstepA = 2 * hstepA, tstepB = 2 * hstepB;
    const unsigned ldsw = (unsigned)wid * 1024u;
    const int aoff = lds_byte(wr * 64 + fr, fq * 8), boff = lds_byte(wc * 32 + fr, fq * 8);
#define PG8_SA(b, h) (((b) * 2 + (h)) * HTB)
#define PG8_SB(b, h) ((4 + (b) * 2 + (h)) * HTB)
#define PG8_STAGE(bufoff, gbase, voff) do { _Pragma("unroll") for (int _i = 0; _i < 2; ++_i) \
        __builtin_amdgcn_global_load_lds((const unsigned*)((const char*)(gbase) + (voff)[_i]), (PG8_LAS unsigned*)(lds + (bufoff) + ldsw + _i * 8192), 16, 0, 0); } while (0)
#define PG8_LDA(dst, b, h) do { _Pragma("unroll") for (int m = 0; m < 4; ++m) _Pragma("unroll") for (int k = 0; k < 2; ++k) dst[m][k] = *(const PG8_LAS bf16x8*)(lds + PG8_SA(b, h) + aoff + m * 2048 + k * 1024); } while (0)
#define PG8_LDB(dst, b, h) do { _Pragma("unroll") for (int n = 0; n < 2; ++n) _Pragma("unroll") for (int k = 0; k < 2; ++k) dst[n][k] = *(const PG8_LAS bf16x8*)(lds + PG8_SB(b, h) + boff + n * 2048 + k * 1024); } while (0)
#define PG8_MMA(ai, bj, At, Bt) do { __builtin_amdgcn_s_setprio(1); _Pragma("unroll") for (int m = 0; m < 4; ++m) _Pragma("unroll") for (int n = 0; n < 2; ++n) _Pragma("unroll") for (int k = 0; k < 2; ++k) \
        acc[ai][bj][m][n] = __builtin_amdgcn_mfma_f32_16x16x32_bf16(Bt[n][k], At[m][k], acc[ai][bj][m][n], 0, 0, 0); __builtin_amdgcn_s_setprio(0); } while (0)
#define PG8_WAIT_V(n) asm volatile("s_waitcnt vmcnt(" #n ")" ::: "memory")
#define PG8_WAIT_L(n) asm volatile("s_waitcnt lgkmcnt(" #n ")" ::: "memory")
#define PG8_BAR __builtin_amdgcn_s_barrier()
#define PG8_SCHED __builtin_amdgcn_sched_barrier(0)
    Unit cur, nxt; int ui = 0;
    if (!S.next(0, cur)) return;
    f32x4 acc[2][2][4][2];
#pragma unroll
    for (int a = 0; a < 2; ++a)
#pragma unroll
        for (int b = 0; b < 2; ++b)
#pragma unroll
            for (int m = 0; m < 4; ++m)
#pragma unroll
                for (int n = 0; n < 2; ++n) acc[a][b][m][n] = (f32x4){0.f, 0.f, 0.f, 0.f};
    bf16x8 At[4][2], B0[2][2], B1[2][2];
    const char* cA = (const char*)g.A + (size_t)cur.pm * tstepA; const char* cB = (const char*)g.Bt + (size_t)cur.pn * tstepB;
    S.a_ready(cur);
    if constexpr (SP2) {
        PG8_STAGE(PG8_SB(0, 0), cB, voffB); PG8_STAGE(PG8_SB(0, 1), cB + hstepB, voffB); PG8_STAGE(PG8_SA(0, 0), cA, voffA); PG8_STAGE(PG8_SA(0, 1), cA + hstepA, voffA);
        if (wr == 1) PG8_BAR;
        PG8_WAIT_V(2); PG8_BAR;
        PG8_STAGE(PG8_SB(1, 0), cB + kstep, voffB); PG8_STAGE(PG8_SA(1, 0), cA + kstep, voffA); PG8_STAGE(PG8_SB(1, 1), cB + hstepB + kstep, voffB);
        PG8_WAIT_V(6); PG8_BAR;
    } else {
        PG8_STAGE(PG8_SB(0, 0), cB, voffB); PG8_STAGE(PG8_SA(0, 0), cA, voffA); PG8_STAGE(PG8_SB(0, 1), cB + hstepB, voffB); PG8_STAGE(PG8_SA(0, 1), cA + hstepA, voffA);
        if (wr == 1) PG8_BAR;
        PG8_WAIT_V(4); PG8_BAR;
        PG8_STAGE(PG8_SB(1, 0), cB + kstep, voffB); PG8_STAGE(PG8_SA(1, 0), cA + kstep, voffA); PG8_STAGE(PG8_SB(1, 1), cB + hstepB + kstep, voffB);
        PG8_WAIT_V(6); PG8_BAR;
    }
    for (;;) {
        const bool has_next = S.next(ui + 1, nxt);
        const char* nA = has_next ? (const char*)g.A + (size_t)nxt.pm * tstepA : cA; const char* nB = has_next ? (const char*)g.Bt + (size_t)nxt.pn * tstepB : cB;
        for (int t = 0; t < nt; t += 2) {
            const bool last = (t == nt - 2);
            const char* a1 = cA + (size_t)(t + 1) * kstep;
            const char* a2 = last ? nA : cA + (size_t)(t + 2) * kstep; const char* b2 = last ? nB : cB + (size_t)(t + 2) * kstep;
            const char* a3 = a2 + kstep; const char* b3 = b2 + kstep;
            if (last && has_next) S.a_ready(nxt);
            if constexpr (SP2) {
            PG8_LDB(B0, 0, 0); PG8_LDB(B1, 0, 1); PG8_SCHED; PG8_LDA(At, 0, 0); PG8_STAGE(PG8_SA(1, 1), a1 + hstepA, voffA);
            PG8_WAIT_V(8); PG8_WAIT_L(0); PG8_BAR; PG8_MMA(0, 0, At, B0); PG8_MMA(0, 1, At, B1); PG8_BAR; PG8_SCHED;
            PG8_LDA(At, 0, 1); PG8_STAGE(PG8_SB(0, 0), b2, voffB); PG8_STAGE(PG8_SB(0, 1), b2 + hstepB, voffB); PG8_STAGE(PG8_SA(0, 0), a2, voffA);
            PG8_WAIT_V(8); PG8_WAIT_L(0); PG8_BAR; PG8_MMA(1, 0, At, B0); PG8_MMA(1, 1, At, B1); PG8_BAR; PG8_SCHED;
            PG8_LDB(B0, 1, 0); PG8_LDB(B1, 1, 1); PG8_SCHED; PG8_LDA(At, 1, 0); PG8_STAGE(PG8_SA(0, 1), a2 + hstepA, voffA);
            PG8_WAIT_V(8); PG8_WAIT_L(0); PG8_BAR; PG8_MMA(0, 0, At, B0); PG8_MMA(0, 1, At, B1); PG8_BAR; PG8_SCHED;
            PG8_LDA(At, 1, 1); PG8_STAGE(PG8_SB(1, 0), b3, voffB); PG8_STAGE(PG8_SB(1, 1), b3 + hstepB, voffB); PG8_STAGE(PG8_SA(1, 0), a3, voffA);
            PG8_WAIT_V(8); PG8_WAIT_L(0); PG8_BAR; PG8_MMA(1, 0, At, B0); PG8_MMA(1, 1, At, B1); PG8_BAR; PG8_SCHED;
            } else {
            PG8_LDB(B0, 0, 0); PG8_SCHED; PG8_LDA(At, 0, 0); PG8_STAGE(PG8_SA(1, 1), a1 + hstepA, voffA);
            PG8_WAIT_L(8); PG8_BAR; PG8_WAIT_L(0); PG8_MMA(0, 0, At, B0); PG8_BAR; PG8_SCHED;
            PG8_LDB(B1, 0, 1); PG8_STAGE(PG8_SB(0, 0), b2, voffB);
            PG8_BAR; PG8_WAIT_L(0); PG8_MMA(0, 1, At, B1); PG8_BAR;
            PG8_LDA(At, 0, 1); PG8_STAGE(PG8_SA(0, 0), a2, voffA);
            PG8_BAR; PG8_WAIT_L(0); PG8_MMA(1, 0, At, B0); PG8_BAR; PG8_SCHED;
            PG8_STAGE(PG8_SB(0, 1), b2 + hstepB, voffB);
            PG8_WAIT_V(6); PG8_BAR; PG8_MMA(1, 1, At, B1); PG8_BAR;
            PG8_LDB(B0, 1, 0); PG8_SCHED; PG8_LDA(At, 1, 0); PG8_STAGE(PG8_SA(0, 1), a2 + hstepA, voffA);
            PG8_WAIT_L(8); PG8_BAR; PG8_WAIT_L(0); PG8_MMA(0, 0, At, B0); PG8_BAR; PG8_SCHED;
            PG8_LDB(B1, 1, 1); PG8_STAGE(PG8_SB(1, 0), b3, voffB);
            PG8_BAR; PG8_WAIT_L(0); PG8_MMA(0, 1, At, B1); PG8_BAR;
            PG8_LDA(At, 1, 1); PG8_STAGE(PG8_SA(1, 0), a3, voffA);
            PG8_BAR; PG8_WAIT_L(0); PG8_MMA(1, 0, At, B0); PG8_BAR; PG8_SCHED;
            PG8_STAGE(PG8_SB(1, 1), b3 + hstepB, voffB);
            PG8_WAIT_V(6); PG8_BAR; PG8_MMA(1, 1, At, B1); PG8_BAR;
            }
        }
        if constexpr (ALIGN_EPI) { if (wr == 0) PG8_BAR; }
        if constexpr (!Epi::AFTER_DRAIN) { E(acc, cur, wr, wc, fr, fq); S.done(cur); }
        if (!has_next) break;
#pragma unroll
        for (int a = 0; a < 2; ++a)
#pragma unroll
            for (int b = 0; b < 2; ++b)
#pragma unroll
                for (int m = 0; m < 4; ++m)
#pragma unroll
                    for (int n = 0; n < 2; ++n) acc[a][b][m][n] = (f32x4){0.f, 0.f, 0.f, 0.f};
        cur = nxt; cA = nA; cB = nB; ++ui;
        if constexpr (ALIGN_EPI) { if (wr == 1) PG8_BAR; }
    }
    PG8_WAIT_V(0);
    if constexpr (!ALIGN_EPI) { if (wr == 0) PG8_BAR; }
    PG8_BAR;
    if constexpr (Epi::AFTER_DRAIN) { E.fused(acc, cur, wr, wc, fr, fq, lds, wid, lane); S.done(cur); }
#undef PG8_SA
#undef PG8_SB
#undef PG8_STAGE
#undef PG8_LDA
#undef PG8_LDB
#undef PG8_MMA
#undef PG8_WAIT_V
#undef PG8_WAIT_L
#undef PG8_BAR
#undef PG8_SCHED
}
}
#define GAS __attribute__((address_space(1)))
#define LAS __attribute__((address_space(3)))
typedef unsigned short bf16;
typedef unsigned v4u __attribute__((ext_vector_type(4)));
typedef float f32x4 __attribute__((ext_vector_type(4)));
typedef short bf16x8 __attribute__((ext_vector_type(8)));
typedef GAS unsigned gu32;
typedef GAS unsigned long long gu64;
#define RLX_AGENT __ATOMIC_RELAXED, __HIP_MEMORY_SCOPE_AGENT
#define LDS_WAIT() asm volatile("s_waitcnt lgkmcnt(0)" ::: "memory")
#define VM_WAIT() asm volatile("s_waitcnt vmcnt(0)" ::: "memory")
__device__ __forceinline__ unsigned long long rt() { return __builtin_amdgcn_s_memrealtime(); }
__device__ __forceinline__ unsigned f2bf(float f) { unsigned u = __builtin_bit_cast(unsigned, f); return (u + 0x7fffu + ((u >> 16) & 1u)) >> 16; }
__device__ __forceinline__ unsigned pk2(float lo, float hi) { return f2bf(lo) | (f2bf(hi) << 16); }

#define XB_TMO      128
#define XB_XCNT(j)  (256  + 64 * (j))
#define XB_XSUB(j)  (1280 + 64 * (j))
#define XB_XGEN(j)  (2304 + 64 * (j))
#define XB_TOP      3328
#define XB_TOPGEN   3392
#define XCD_BAR_WORDS 3456
#define XB_SPIN_CAP (1u << 18)

__device__ __forceinline__ unsigned xb_ld(unsigned* p)              { return __hip_atomic_load(p, __ATOMIC_RELAXED, __HIP_MEMORY_SCOPE_AGENT); }
__device__ __forceinline__ unsigned xb_add(unsigned* p, unsigned v) { return __hip_atomic_fetch_add(p, v, __ATOMIC_RELAXED, __HIP_MEMORY_SCOPE_AGENT); }
__device__ __forceinline__ unsigned xb_xcc_id() { return (unsigned)__builtin_amdgcn_s_getreg((3 << 11) | 20) & 0xFu; }
#define XB_SPIN(cond, bar) do { unsigned _sp = 0; while (cond) { __builtin_amdgcn_s_sleep(1); \
    if ((++_sp & 255u) == 0u) { if (xb_ld(&(bar)[XB_TMO])) break; if (_sp > XB_SPIN_CAP) { atomicAdd(&(bar)[XB_TMO], 1u); break; } } } } while (0)

struct XcdBarrier {
    unsigned* bar; unsigned x;
    volatile LAS unsigned* st;
};

__device__ __forceinline__ XcdBarrier xcd_barrier_post(unsigned* bar, volatile LAS unsigned* st) {
    XcdBarrier b; b.bar = bar; b.x = xb_xcc_id(); b.st = st;
    if (threadIdx.x == 0) (void)xb_add(&bar[XB_XCNT(b.x)], 1u);
    return b;
}
__device__ __forceinline__ void xcd_barrier_complete(unsigned* bar, unsigned x, unsigned& nloc, unsigned& nx) {
    const unsigned G = gridDim.x * gridDim.y * gridDim.z;
    unsigned sum, cnt, mine, sp = 0u;
    for (;;) {
        sum = 0u; cnt = 0u; mine = 0u;
#pragma unroll
        for (unsigned j = 0; j < 16; ++j) { const unsigned c = xb_ld(&bar[XB_XCNT(j)]); sum += c; cnt += (c > 0u) ? 1u : 0u; mine = (j == x) ? c : mine; }
        if (sum == G) break;
        __builtin_amdgcn_s_sleep(1);
        if ((++sp & 255u) == 0u) { if (xb_ld(&bar[XB_TMO])) break; if (sp > XB_SPIN_CAP) { atomicAdd(&bar[XB_TMO], 1u); break; } }
    }
    nloc = mine > 0u ? mine : 1u; nx = cnt > 0u ? cnt : 1u;
}

__device__ __forceinline__ void xcd_barrier(const XcdBarrier& b) {
    asm volatile("s_waitcnt vmcnt(0)" ::: "memory");
    __syncthreads();
    if (threadIdx.x == 0) {
        unsigned* bar = b.bar;
        __builtin_amdgcn_s_waitcnt(0);
        unsigned nloc = b.st[0], nx = b.st[1];
        if (nloc == 0u) { xcd_barrier_complete(bar, b.x, nloc, nx); b.st[0] = nloc; b.st[1] = nx; }
        const unsigned old = xb_add(&bar[XB_XSUB(b.x)], 1u);
        const unsigned gen = old / nloc;
        if (old + 1u == (gen + 1u) * nloc) {
            __builtin_amdgcn_fence(__ATOMIC_RELEASE, "agent");
            asm volatile("s_waitcnt vmcnt(0)" ::: "memory");
            const unsigned og = xb_add(&bar[XB_TOP], 1u);
            const unsigned tg = og / nx;
            if (og + 1u == (tg + 1u) * nx) xb_add(&bar[XB_TOPGEN], 1u);
            else XB_SPIN(xb_ld(&bar[XB_TOPGEN]) == tg, bar);
            __builtin_amdgcn_fence(__ATOMIC_ACQUIRE, "agent");
            xb_add(&bar[XB_XGEN(b.x)], 1u);
            asm volatile("s_waitcnt vmcnt(0)" ::: "memory");
        } else {
            XB_SPIN(xb_ld(&bar[XB_XGEN(b.x)]) == gen, bar);
            __builtin_amdgcn_fence(__ATOMIC_ACQUIRE, "agent");
            asm volatile("s_waitcnt vmcnt(0)" ::: "memory");
        }
    }
    __syncthreads();
}
namespace mk {
constexpr int D_MODEL = 1024, BATCH = 4, SEQ = 4096, DEC_BATCH = 128, DEC_SEQ = 4, PAST = 8192, PAGE = 128, NPAGES = 64;
constexpr int NH = 8, NOPE = 64, ROPE = 32, QKH = 96, VH = 64, QLORA = 384, KVLORA = 256;
constexpr int DCONV = 512, CW = 31, DFF = 2816, DIN = 3744;
constexpr int MP = BATCH * SEQ, MS = DEC_BATCH * DEC_SEQ, M = MP + MS;
constexpr float EPS = 1e-6f;
constexpr float LOG2E = 1.4426950408889634f;
constexpr float QSCALE = 0.10206207261596577f * LOG2E;
constexpr size_t O_YP = 0, O_YS = O_YP + (size_t)MP * 1024, O_LATP = O_YS + (size_t)MS * 1024, O_KRP = O_LATP + (size_t)MP * 256,
                 O_CSP = O_KRP + (size_t)MP * 32, O_LATS = O_CSP + (size_t)BATCH * 30 * 512, O_KRS = O_LATS + (size_t)MS * 256,
                 O_CSS = O_KRS + (size_t)MS * 32, O_END = O_CSS + (size_t)DEC_BATCH * 30 * 512;
constexpr int NIN = 3840;
constexpr int NQP = 768;
constexpr int NGU = 2 * DFF;
constexpr int NPOS = SEQ + DEC_SEQ;

constexpr size_t al(size_t x) { return (x + 4095) / 4096 * 4096; }
constexpr size_t WS_CTL = 0, CTL_ZERO_BYTES = 1u << 20;
constexpr size_t WS_WIN = CTL_ZERO_BYTES;
constexpr size_t WS_WUQ = WS_WIN + al((size_t)NIN * 1024 * 2);
constexpr size_t WS_WKV = WS_WUQ + al((size_t)NQP * 384 * 2);
constexpr size_t WS_WC = WS_WKV + al((size_t)1024 * 256 * 2);
constexpr size_t WS_WO = WS_WC + al((size_t)1024 * 512 * 2);
constexpr size_t WS_WOUT = WS_WO + al((size_t)1024 * 512 * 2);
constexpr size_t WS_WGU = WS_WOUT + al((size_t)1024 * 1024 * 2);
constexpr size_t WS_WD = WS_WGU + al((size_t)NGU * 1024 * 2);
constexpr size_t WS_TAB = WS_WD + al((size_t)1024 * DFF * 2);
constexpr size_t WS_H = WS_TAB + al((size_t)NPOS * 32 * 4);
constexpr size_t WS_U = WS_H + al((size_t)M * 1024 * 2);
constexpr size_t WS_G = WS_U + al((size_t)M * 512 * 2);
constexpr size_t WS_RAW = WS_G + al((size_t)M * 2048 * 2);
constexpr size_t WS_CKV = WS_RAW + al((size_t)M * 768 * 4);
constexpr size_t WS_CQN = WS_CKV + al((size_t)M * 256 * 2);
constexpr size_t WS_KPE = WS_CQN + al((size_t)M * 384 * 2);
constexpr size_t WS_T = WS_KPE + al((size_t)M * 32 * 4);
constexpr size_t WS_QRAW = WS_T + al((size_t)M * 512 * 2);
constexpr size_t WS_KN = WS_QRAW + al((size_t)M * 1024 * 4);
constexpr size_t WS_V = WS_KN + al((size_t)M * 512 * 4);
constexpr size_t WS_Q = WS_V + al((size_t)M * 512 * 2);
constexpr size_t WS_K = WS_Q + al((size_t)M * 768 * 2);
constexpr size_t WS_O = WS_K + al((size_t)M * 768 * 2);
constexpr size_t WS_CONVO = WS_O + al((size_t)M * 512 * 2);
constexpr size_t WS_MERGED = WS_CONVO + al((size_t)M * 1024 * 2);
constexpr size_t WS_X1B = WS_MERGED + al((size_t)M * 1024 * 2);
constexpr size_t WS_SSQ2 = WS_X1B + al((size_t)M * 1024 * 2);
constexpr size_t WS_ACT = WS_SSQ2 + al((size_t)M * 16 * 4);
constexpr size_t WS_QLAT = WS_ACT + al((size_t)M * DFF * 2);
constexpr size_t WS_SPART = WS_QLAT + al((size_t)DEC_BATCH * 2 * 32 * 288 * 2);
constexpr size_t WS_WUK8_DECL = 0;
constexpr int SA_UNITS_PER_SEQ = 2; static_assert(SA_UNITS_PER_SEQ == 2, "WS_QLAT is sized for two units per sequence");
constexpr int SA_PART_STRIDE = 32 * 256 + 32;
constexpr size_t WS_WUK8 = WS_SPART + al((size_t)DEC_BATCH * SA_UNITS_PER_SEQ * SA_PART_STRIDE * 4);
constexpr size_t WS_PARTK = WS_WUK8 + al((size_t)512 * 256);
constexpr size_t WS_KPESSQ = WS_PARTK + al((size_t)11 * 512 * 1024 * 4);
constexpr size_t WS_SSQQ = WS_KPESSQ + al((size_t)M * 4);
constexpr size_t WS_GG = WS_SSQQ + al((size_t)M * 16 * 4);
constexpr size_t WS_RINVF = WS_GG + al(96 * 4);
constexpr size_t WS_END = WS_RINVF + al((size_t)M * 4);
constexpr int CW_BAR = 4096;
constexpr int CW_QFLAG = 64;

constexpr int NWAVES = 8, NTHREADS = 512;
constexpr int RING_OFF = 0, RING_BYTES = 155648;
constexpr int LDSCTL_OFF = RING_BYTES, MISC_OFF = LDSCTL_OFF + 320;
constexpr int LDS_BYTES = 163840;

typedef unsigned u32x2 __attribute__((ext_vector_type(2)));
typedef float f32x2 __attribute__((ext_vector_type(2)));

__device__ __forceinline__ float bf2f(bf16 b) { return __uint_as_float((unsigned)b << 16); }
__device__ __forceinline__ float sigm(float x) { return __builtin_amdgcn_rcpf(1.0f + __builtin_amdgcn_exp2f(-x * LOG2E)); }
__device__ __forceinline__ float wave_sum(float v) {
#pragma unroll
    for (int o = 1; o < 64; o <<= 1) v += __shfl_xor(v, o);
    return v;
}
typedef __bf16 bf16x2_t __attribute__((ext_vector_type(2)));
__device__ __forceinline__ unsigned cvtpk(float lo, float hi) { f32x2 v = {lo, hi}; bf16x2_t b = __builtin_convertvector(v, bf16x2_t); return __builtin_bit_cast(unsigned, b); }
__device__ __forceinline__ v4u pack8(const f32x4 a, const f32x4 b) { v4u w; w.x = cvtpk(a[0], a[1]); w.y = cvtpk(a[2], a[3]); w.z = cvtpk(b[0], b[1]); w.w = cvtpk(b[2], b[3]); return w; }

struct Frame {
    LAS unsigned char* lds;
    volatile LAS unsigned* MISC;
    gu32* ctl;
    int tid, lane, wave, G;
    const float* in[26];
    float* out;
    unsigned char* ws;
};
#define INP(i) (F.in[i])
enum { I_XP = 0, I_XS, I_CLAT, I_CKPE, I_SCONV, I_PT, I_NMG, I_WIN, I_QAG, I_WUQ, I_KVG, I_WUK, I_WUV, I_QNG, I_KNG, I_WOM, I_CVW, I_CVB, I_LNG, I_LNB, I_WCO, I_WOUT, I_NFG, I_WG, I_WU, I_WDN };
template <class T> __device__ __forceinline__ T* wsp(const Frame& F, size_t off) { return (T*)(F.ws + off); }

__device__ __forceinline__ void tr_item(const float* Wc0, int ldw, const float* kscale, bf16* WTr0, int K, int k0, LAS float* scr, int lane) {
    float wv[32];
#pragma unroll
    for (int i = 0; i < 32; ++i) { const int kk = 2 * i + (lane >> 5); wv[i] = Wc0 ? Wc0[(size_t)(k0 + kk) * ldw + (lane & 31)] : 0.f; }
    if (kscale) {
#pragma unroll
        for (int i = 0; i < 32; ++i) wv[i] *= kscale[k0 + 2 * i + (lane >> 5)]; }
#pragma unroll
    for (int i = 0; i < 32; ++i) scr[(2 * i + (lane >> 5)) * 33 + (lane & 31)] = wv[i];
    LDS_WAIT(); asm volatile("" ::: "memory");
    const int c = lane & 7;
#pragma unroll
    for (int j = 0; j < 4; ++j) { const int n = (lane >> 3) + 8 * j; const LAS float* s = scr + (8 * c) * 33 + n;
        v4u o; o.x = pk2(s[0 * 33], s[1 * 33]); o.y = pk2(s[2 * 33], s[3 * 33]); o.z = pk2(s[4 * 33], s[5 * 33]); o.w = pk2(s[6 * 33], s[7 * 33]);
        *(GAS v4u*)(WTr0 + (size_t)n * K + k0 + 8 * c) = o; }
    LDS_WAIT(); asm volatile("" ::: "memory");
}
__device__ __forceinline__ int wuk_src_col(int n0) { const int t = n0 >> 8, bj = (n0 >> 7) & 1, wc = (n0 >> 5) & 3; return (4 * t + wc) * 64 + 32 * bj; }
__device__ __forceinline__ int wuq_src_col(int n0) { const int t = n0 >> 8, bj = (n0 >> 7) & 1, wc = (n0 >> 5) & 3;
    return (t < 2) ? (4 * t + wc) * 96 + 32 * bj : (2 * wc + bj) * 96 + 64; }
__device__ __forceinline__ int wkvt_row(int h, int d) { return 256 * (h >> 2) + 128 * (d >> 5) + 32 * (h & 3) + (d & 31); }
__device__ __forceinline__ int win_src_col(int n0) {
    if (n0 < 1024) { const int t = n0 >> 8, j = n0 & 255; return (j < 128) ? 128 * t + j : 512 + 128 * t + (j - 128); }
    if (n0 < 2048) return 1696 + (n0 - 1024);
    if (n0 < 3072) return 2720 + (n0 - 2048);
    if (n0 < 3328) return 1408 + (n0 - 3072);
    if (n0 < 3584) return 1024 + (n0 - 3328);
    if (n0 < 3712) return 1280 + (n0 - 3584);
    if (n0 < 3744) return 1664 + (n0 - 3712);
    return -1;
}
template <int SET> __device__ __forceinline__ void convert_weights(Frame& F, int gwl, int ngw) {
    LAS float* scr = (LAS float*)(F.lds + RING_OFF + F.wave * 16384);
    const int lane = F.lane;
    constexpr int I_A = 120 * 16, I_B = 24 * 6, I_C = 32 * 4, I_D = 32 * 8, I_E = 32 * 8, I_F = 32 * 16, I_G = 176 * 16, I_H = 32 * 44;
    if (SET == 0) {
        for (int it = gwl; it < I_A; it += ngw) { const int g = it / 16, kb = it % 16; const int sc = win_src_col(32 * g);
            tr_item(sc >= 0 ? INP(I_WIN) + sc : nullptr, DIN, INP(I_NMG), wsp<bf16>(F, WS_WIN) + (size_t)(32 * g) * 1024, 1024, 64 * kb, scr, lane); }
    } else if (SET == 3) {
        for (int it = gwl; it < I_B + I_C + I_D; it += ngw) {
            int r = it;
            if (r < I_B) { const int g = r / 6, kb = r % 6;
                tr_item(INP(I_WUQ) + wuq_src_col(32 * g), 768, INP(I_QAG), wsp<bf16>(F, WS_WUQ) + (size_t)(32 * g) * 384, 384, 64 * kb, scr, lane); continue; } r -= I_B;
            if (r < I_C) { const int g = r / 4, kb = r % 4;
                tr_item(g < 16 ? INP(I_WUK) + wuk_src_col(32 * g) : INP(I_WUV) + 32 * (g - 16), 512, nullptr, wsp<bf16>(F, WS_WKV) + (size_t)(32 * g) * 256, 256, 64 * kb, scr, lane); continue; } r -= I_C;
            { const int g = r / 8, kb = r % 8;
                tr_item(INP(I_WCO) + 32 * g, 1024, nullptr, wsp<bf16>(F, WS_WC) + (size_t)(32 * g) * 512, 512, 64 * kb, scr, lane); }
        }
    } else if (SET == 1) {
        for (int it = gwl; it < I_E + I_F; it += ngw) {
            int r = it;
            if (r < I_E) { const int g = r / 8, kb = r % 8;
                tr_item(INP(I_WOM) + 32 * g, 1024, nullptr, wsp<bf16>(F, WS_WO) + (size_t)(32 * g) * 512, 512, 64 * kb, scr, lane); continue; } r -= I_E;
            { const int g = r / 16, kb = r % 16;
                tr_item(INP(I_WOUT) + 32 * g, 1024, nullptr, wsp<bf16>(F, WS_WOUT) + (size_t)(32 * g) * 1024, 1024, 64 * kb, scr, lane); }
        }
    } else {
        for (int it = gwl; it < I_G + I_H; it += ngw) {
            int r = it;
            if (r < I_G) { const int g = r / 16, kb = r % 16; const int n0 = 32 * g, t = n0 >> 8, j = n0 & 255;
                tr_item(j < 128 ? INP(I_WG) + 128 * t + j : INP(I_WU) + 128 * t + (j - 128), DFF, INP(I_NFG), wsp<bf16>(F, WS_WGU) + (size_t)n0 * 1024, 1024, 64 * kb, scr, lane); continue; } r -= I_G;
            { const int g = r / 44, kb = r % 44;
                tr_item(INP(I_WDN) + 32 * g, 1024, nullptr, wsp<bf16>(F, WS_WD) + (size_t)(32 * g) * DFF, DFF, 64 * kb, scr, lane); }
        }
    }
}
__device__ __forceinline__ void css_copy(Frame& F, int first, int T) {
    const f32x4* src = (const f32x4*)INP(I_SCONV); f32x4* dst = (f32x4*)(F.out + O_CSS);
    const int total = DEC_BATCH * 26 * 128;
#pragma unroll 1
    for (int i0 = first; i0 < total; i0 += 4 * T) {
        f32x4 v[4];
#pragma unroll
        for (int k = 0; k < 4; ++k) { const int idx = i0 + k * T; if (idx < total) { const int db = idx / (26 * 128), rem = idx % (26 * 128); v[k] = src[(size_t)db * 30 * 128 + 4 * 128 + rem]; } }
#pragma unroll
        for (int k = 0; k < 4; ++k) { const int idx = i0 + k * T; if (idx < total) { const int db = idx / (26 * 128), rem = idx % (26 * 128); dst[(size_t)db * 30 * 128 + rem] = v[k]; } } }
}
__device__ __forceinline__ void p0_late(Frame& F, int gwl, int ngw, int t0, int nt);
__device__ __forceinline__ void p0_prologue(Frame& F, bool late_elsewhere) {
    const int gw = blockIdx.x * NWAVES + F.wave, NGW = F.G * NWAVES, lane = F.lane;
    convert_weights<0>(F, gw, NGW);
    bf16* H = wsp<bf16>(F, WS_H);
#pragma unroll 1
    for (int m0 = gw; m0 < M; m0 += 5 * NGW) {
        f32x4 v[5][4]; int mr[5];
#pragma unroll
        for (int k = 0; k < 5; ++k) { const int mk = m0 + k * NGW; mr[k] = (mk < M) ? mk : m0;
            const float* x = (mr[k] < MP) ? INP(I_XP) + (size_t)mr[k] * 1024 : INP(I_XS) + (size_t)(mr[k] - MP) * 1024;
#pragma unroll
            for (int j = 0; j < 4; ++j) v[k][j] = ((const GAS f32x4*)x)[lane + 64 * j]; }
#pragma unroll
        for (int k = 0; k < 5; ++k) {
            float s = 0.f;
#pragma unroll
            for (int j = 0; j < 4; ++j) s += (v[k][j].x * v[k][j].x + v[k][j].y * v[k][j].y) + (v[k][j].z * v[k][j].z + v[k][j].w * v[k][j].w);
#pragma unroll
            for (int o = 1; o < 64; o <<= 1) s += __shfl_xor(s, o);
            const float r = 1.0f / sqrtf(s * (1.0f / 1024.0f) + EPS);
            if (m0 + k * NGW < M) { GAS unsigned long long* op = (GAS unsigned long long*)(H + (size_t)mr[k] * 1024) + lane;
#pragma unroll
                for (int j = 0; j < 4; ++j) op[64 * j] = (unsigned long long)pk2(v[k][j].x * r, v[k][j].y * r) | ((unsigned long long)pk2(v[k][j].z * r, v[k][j].w * r) << 32); }
        }
    }
    if (!late_elsewhere) p0_late(F, gw, NGW, blockIdx.x * NTHREADS + F.tid, F.G * NTHREADS);
}
__device__ __forceinline__ void p0_late(Frame& F, int gwl, int ngw, int t0, int nt) {
    convert_weights<3>(F, gwl, ngw);
    { unsigned* W8 = wsp<unsigned>(F, WS_WUK8);
      for (int idx = t0; idx < 64 * 512; idx += nt) { const int cg = idx >> 9, n = idx & 511; const float* w = INP(I_WUK) + (size_t)(4 * cg) * 512 + n;
          int p = 0; p = __builtin_amdgcn_cvt_pk_fp8_f32(16.0f * w[0], 16.0f * w[512], p, false); p = __builtin_amdgcn_cvt_pk_fp8_f32(16.0f * w[1024], 16.0f * w[1536], p, true);
          W8[n * 64 + cg] = (unsigned)p; } }
    if (t0 < 96) { const int dm = (t0 < 64) ? t0 : 64 + ((t0 - 64) & 15); wsp<float>(F, WS_GG)[t0] = INP(I_QNG)[dm] * INP(I_KNG)[dm] * QSCALE; }
    float* TAB = wsp<float>(F, WS_TAB);
    for (int idx = t0; idx < NPOS * 16; idx += nt) {
        const int p = idx >> 4, j = idx & 15; const int pos = (p < SEQ) ? p : PAST + (p - SEQ);
        const float invf = 1.0f / powf(10000.0f, (float)(2 * j) / 32.0f);
        const float angf = (float)pos * invf;
        float sn_, cs_; sincosf(angf, &sn_, &cs_);
        TAB[p * 32 + j] = cs_; TAB[p * 32 + 16 + j] = sn_;
    }
}

__device__ __forceinline__ int pos_index(int row) { return row < MP ? (row & (SEQ - 1)) : SEQ + ((row - MP) & 3); }
#define EPI_FOR_ROWS _Pragma("unroll") for (int ai = 0; ai < 2; ++ai) _Pragma("unroll") for (int m = 0; m < 4; ++m)
#define EPI_ROW (row0 + u.pm * 256 + ai * 128 + wr * 64 + m * 16 + fr)
#define EPI_ROW_OPAQUE (rbase + ai * 128 + wr * 64 + m * 16 + fr)
struct EpiInProj {
    static constexpr bool PERM = true, AFTER_DRAIN = false;
    bf16* U; bf16* G; bf16* RAW; float* out; int row0 = 0;
    __device__ __forceinline__ void operator()(const f32x4 (&acc)[2][2][4][2], const pg8::Unit& u, int wr, int wc, int fr, int fq) const {
        const int cb = wc * 32 + 8 * fq;
        if (u.pn < 4) {
            const int ch = 128 * u.pn + cb;
            EPI_FOR_ROWS { const int row = EPI_ROW;
                f32x4 r0, r1;
#pragma unroll
                for (int e = 0; e < 4; ++e) { r0[e] = acc[ai][0][m][0][e] * sigm(acc[ai][1][m][0][e]); r1[e] = acc[ai][0][m][1][e] * sigm(acc[ai][1][m][1][e]); }
                *(v4u*)(U + (size_t)row * 512 + ch) = pack8(r0, r1);
                float* cs = nullptr;
                if (row < MP) { const int t = row & (SEQ - 1); if (t >= SEQ - 30) cs = out + O_CSP + ((size_t)(row >> 12) * 30 + (t - (SEQ - 30))) * 512 + ch; }
                else { const int rs = row - MP; cs = out + O_CSS + ((size_t)(rs >> 2) * 30 + 26 + (rs & 3)) * 512 + ch; }
                if (cs) { *(f32x4*)cs = r0; *(f32x4*)(cs + 4) = r1; }
            }
        } else if (u.pn < 12) {
            const int col = 256 * (u.pn - 4) + cb;
            EPI_FOR_ROWS { const int row = EPI_ROW;
#pragma unroll
                for (int bj = 0; bj < 2; ++bj) { f32x4 r0, r1;
#pragma unroll
                    for (int e = 0; e < 4; ++e) { r0[e] = sigm(acc[ai][bj][m][0][e]); r1[e] = sigm(acc[ai][bj][m][1][e]); }
                    *(v4u*)(G + (size_t)row * 2048 + col + 128 * bj) = pack8(r0, r1); }
            }
        } else {
            const int col = 256 * (u.pn - 12) + cb;
            EPI_FOR_ROWS { const int row = EPI_ROW;
#pragma unroll
                for (int bj = 0; bj < 2; ++bj) *(v4u*)(RAW + (size_t)row * 768 + col + 128 * bj) = pack8(acc[ai][bj][m][0], acc[ai][bj][m][1]);
            }
        }
    }
};
struct EpiF32 {
    static constexpr bool PERM = true, AFTER_DRAIN = false;
    float* C; int ldc; int row0 = 0;
    __device__ __forceinline__ void operator()(const f32x4 (&acc)[2][2][4][2], const pg8::Unit& u, int wr, int wc, int fr, int fq) const {
        const int col = 256 * u.pn + wc * 32 + 8 * fq;
        EPI_FOR_ROWS { const int row = EPI_ROW;
#pragma unroll
            for (int bj = 0; bj < 2; ++bj) { float* p = C + (size_t)row * ldc + col + 128 * bj; *(f32x4*)p = acc[ai][bj][m][0]; *(f32x4*)(p + 4) = acc[ai][bj][m][1]; }
        }
    }
};
struct EpiKV {
    static constexpr bool PERM = true, AFTER_DRAIN = false;
    float* KN; bf16* V; int row0 = 0;
    __device__ __forceinline__ void operator()(const f32x4 (&acc)[2][2][4][2], const pg8::Unit& u, int wr, int wc, int fr, int fq) const {
        const int col = 256 * (u.pn & 1) + wc * 32 + 8 * fq;
        if (u.pn < 2) {
            EPI_FOR_ROWS { const int row = EPI_ROW;
#pragma unroll
                for (int bj = 0; bj < 2; ++bj) { float* p = KN + (size_t)row * 512 + col + 128 * bj; *(f32x4*)p = acc[ai][bj][m][0]; *(f32x4*)(p + 4) = acc[ai][bj][m][1]; }
            }
        } else {
            EPI_FOR_ROWS { const int row = EPI_ROW;
#pragma unroll
                for (int bj = 0; bj < 2; ++bj) *(v4u*)(V + (size_t)row * 512 + col + 128 * bj) = pack8(acc[ai][bj][m][0], acc[ai][bj][m][1]);
            }
        }
    }
};
__device__ __forceinline__ void unpack8(const v4u w, float (&f)[8]) {
    f[0] = __uint_as_float(w.x << 16); f[1] = __uint_as_float(w.x & 0xffff0000u); f[2] = __uint_as_float(w.y << 16); f[3] = __uint_as_float(w.y & 0xffff0000u);
    f[4] = __uint_as_float(w.z << 16); f[5] = __uint_as_float(w.z & 0xffff0000u); f[6] = __uint_as_float(w.w << 16); f[7] = __uint_as_float(w.w & 0xffff0000u);
}
struct EpiConv {
    static constexpr bool PERM = true, AFTER_DRAIN = false;
    const bf16* G; bf16* CONVO; int row0 = 0;
    __device__ __forceinline__ void operator()(const f32x4 (&acc)[2][2][4][2], const pg8::Unit& u, int wr, int wc, int fr, int fq) const {
        const int col = 256 * u.pn + wc * 32 + 8 * fq;
        v4u gw[2][4][2];
        EPI_FOR_ROWS { const int row = EPI_ROW;
#pragma unroll
            for (int bj = 0; bj < 2; ++bj) gw[ai][m][bj] = *(const v4u*)(G + (size_t)row * 2048 + col + 128 * bj); }
        EPI_FOR_ROWS { const int row = EPI_ROW;
#pragma unroll
            for (int bj = 0; bj < 2; ++bj) { float g[8]; unpack8(gw[ai][m][bj], g);
                f32x4 r0, r1;
#pragma unroll
                for (int e = 0; e < 4; ++e) { r0[e] = acc[ai][bj][m][0][e] * g[e]; r1[e] = acc[ai][bj][m][1][e] * g[4 + e]; }
                *(v4u*)(CONVO + (size_t)row * 1024 + col + 128 * bj) = pack8(r0, r1); }
        }
    }
};
struct EpiMerge {
    static constexpr bool PERM = true, AFTER_DRAIN = false;
    const bf16* G; const bf16* CONVO; bf16* MERGED; int row0 = 0;
    __device__ __forceinline__ void operator()(const f32x4 (&acc)[2][2][4][2], const pg8::Unit& u, int wr, int wc, int fr, int fq) const {
        const int col = 256 * u.pn + wc * 32 + 8 * fq;
#pragma unroll
        for (int ai = 0; ai < 2; ++ai) {
            v4u gw[4][2], cw[4][2];
#pragma unroll
            for (int m = 0; m < 4; ++m) { const int row = EPI_ROW;
#pragma unroll
                for (int bj = 0; bj < 2; ++bj) { gw[m][bj] = *(const v4u*)(G + (size_t)row * 2048 + 1024 + col + 128 * bj); cw[m][bj] = *(const v4u*)(CONVO + (size_t)row * 1024 + col + 128 * bj); } }
#pragma unroll
            for (int m = 0; m < 4; ++m) { const int row = EPI_ROW;
#pragma unroll
                for (int bj = 0; bj < 2; ++bj) { float g[8], cv[8]; unpack8(gw[m][bj], g); unpack8(cw[m][bj], cv);
                    f32x4 r0, r1;
#pragma unroll
                    for (int e = 0; e < 4; ++e) { r0[e] = cv[e] + acc[ai][bj][m][0][e] * g[e]; r1[e] = cv[4 + e] + acc[ai][bj][m][1][e] * g[4 + e]; }
                    *(v4u*)(MERGED + (size_t)row * 1024 + col + 128 * bj) = pack8(r0, r1); } }
        }
    }
};
struct EpiOut {
    static constexpr bool PERM = true, AFTER_DRAIN = false;
    const float* xp; const float* xs; float* Y; bf16* X1B; float* SSQ2; int row0 = 0;
    __device__ __forceinline__ void operator()(const f32x4 (&acc)[2][2][4][2], const pg8::Unit& u, int wr, int wc, int fr, int fq) const {
        const int col = 256 * u.pn + wc * 32 + 8 * fq;
#pragma unroll
        for (int ai = 0; ai < 2; ++ai) {
            f32x4 xv[4][2][2];
#pragma unroll
            for (int m = 0; m < 4; ++m) { const int row = EPI_ROW;
                const float* xrow = (row < MP) ? xp + (size_t)row * 1024 : xs + (size_t)(row - MP) * 1024;
#pragma unroll
                for (int bj = 0; bj < 2; ++bj) { xv[m][bj][0] = *(const f32x4*)(xrow + col + 128 * bj); xv[m][bj][1] = *(const f32x4*)(xrow + col + 128 * bj + 4); } }
#pragma unroll
            for (int m = 0; m < 4; ++m) { const int row = EPI_ROW;
                float ss = 0.f;
#pragma unroll
                for (int bj = 0; bj < 2; ++bj) {
                    const f32x4 r0 = xv[m][bj][0] + acc[ai][bj][m][0], r1 = xv[m][bj][1] + acc[ai][bj][m][1];
                    *(v4u*)(X1B + (size_t)row * 1024 + col + 128 * bj) = pack8(r0, r1);
                    ss += (r0[0] * r0[0] + r0[1] * r0[1]) + (r0[2] * r0[2] + r0[3] * r0[3]) + (r1[0] * r1[0] + r1[1] * r1[1]) + (r1[2] * r1[2] + r1[3] * r1[3]); }
                ss += __shfl_xor(ss, 16); ss += __shfl_xor(ss, 32);
                if (fq == 0) SSQ2[(size_t)row * 16 + 4 * u.pn + wc] = ss;
            }
        }
    }
};
struct EpiGateUp {
    static constexpr bool PERM = true, AFTER_DRAIN = false;
    const float* RINVF; bf16* ACT; int row0 = 0;
    __device__ __forceinline__ void operator()(const f32x4 (&acc)[2][2][4][2], const pg8::Unit& u, int wr, int wc, int fr, int fq) const {
        const int ch = 128 * u.pn + wc * 32 + 8 * fq;
        float rv[2][4];
        EPI_FOR_ROWS { const int row = EPI_ROW; rv[ai][m] = RINVF[row]; }
        EPI_FOR_ROWS { const int row = EPI_ROW;
            const float rinv = rv[ai][m];
            f32x4 r0, r1;
#pragma unroll
            for (int e = 0; e < 4; ++e) { const float g0 = acc[ai][0][m][0][e] * rinv, u0 = acc[ai][1][m][0][e] * rinv, g1 = acc[ai][0][m][1][e] * rinv, u1 = acc[ai][1][m][1][e] * rinv;
                r0[e] = g0 * sigm(g0) * u0; r1[e] = g1 * sigm(g1) * u1; }
            *(v4u*)(ACT + (size_t)row * DFF + ch) = pack8(r0, r1);
        }
    }
};
struct EpiDown {
    static constexpr bool PERM = true, AFTER_DRAIN = false;
    float* Y; const bf16* X1B; int row0 = 0;
    __device__ __forceinline__ void operator()(const f32x4 (&acc)[2][2][4][2], const pg8::Unit& u, int wr, int wc, int fr, int fq) const {
        const int col = 256 * u.pn + wc * 32 + 8 * fq;
        v4u xw[2][4][2];
        EPI_FOR_ROWS { const int row = EPI_ROW;
#pragma unroll
            for (int bj = 0; bj < 2; ++bj) xw[ai][m][bj] = *(const v4u*)(X1B + (size_t)row * 1024 + col + 128 * bj); }
        EPI_FOR_ROWS { const int row = EPI_ROW;
#pragma unroll
            for (int bj = 0; bj < 2; ++bj) { float* yp = Y + (size_t)row * 1024 + col + 128 * bj; float f[8]; unpack8(xw[ai][m][bj], f);
                *(f32x4*)yp = (f32x4){f[0], f[1], f[2], f[3]} + acc[ai][bj][m][0]; *(f32x4*)(yp + 4) = (f32x4){f[4], f[5], f[6], f[7]} + acc[ai][bj][m][1]; }
        }
    }
};

__device__ __forceinline__ float sum_fq(float v) {
    v += __uint_as_float(__builtin_amdgcn_ds_swizzle(__float_as_uint(v), 0x401F));
    const auto r = __builtin_amdgcn_permlane32_swap(__float_as_uint(v), __float_as_uint(v), false, false);
    return __uint_as_float(r[0]) + __uint_as_float(r[1]);
}
__device__ __forceinline__ float other_half(float v, bool upper) {
    const auto r = __builtin_amdgcn_permlane32_swap(__float_as_uint(v), __float_as_uint(v), false, false);
    return __uint_as_float(upper ? r[0] : r[1]);
}
struct EpiQ3 {
    static constexpr bool PERM = true, AFTER_DRAIN = false;
    bf16* Q; float* SSQQ; const float* TAB; int row0 = 0;
    __device__ __forceinline__ void operator()(const f32x4 (&acc)[2][2][4][2], const pg8::Unit& u, int wr, int wc, int fr_in, int fq_in) const {
        int ln_; asm volatile("v_mbcnt_lo_u32_b32 %0, -1, 0\n\tv_mbcnt_hi_u32_b32 %0, -1, %0" : "=v"(ln_)); const int fr = ln_ & 15, fq = ln_ >> 4; (void)fr_in; (void)fq_in;
        int rbase = row0 + u.pm * 256; asm volatile("" : "+s"(rbase));
        if (u.pn < 2) {
            const int head = 4 * u.pn + wc;
            EPI_FOR_ROWS { const int row = EPI_ROW_OPAQUE;
                float ss = 0.f;
#pragma unroll
                for (int bj = 0; bj < 2; ++bj) { const f32x4 a = acc[ai][bj][m][0], b = acc[ai][bj][m][1];
                    ss += ((a[0] * a[0] + a[1] * a[1]) + (a[2] * a[2] + a[3] * a[3])) + ((b[0] * b[0] + b[1] * b[1]) + (b[2] * b[2] + b[3] * b[3]));
                    *(v4u*)((char*)Q + (unsigned)(__mul24(row, 1536) + (head * 96 + 32 * bj + 8 * fq) * 2)) = pack8(a, b); }
                ss = sum_fq(ss);
                if (fq == 0) *(float*)((char*)SSQQ + (unsigned)(row * 64 + head * 4)) = ss;
                asm volatile("" ::: "memory"); __builtin_amdgcn_sched_barrier(0);
            }
        } else {
            const int e0 = 8 * (fq & 1);
#pragma unroll
            for (int ai = 0; ai < 2; ++ai) {
                f32x4 tc0[4], tc1[4], ts0[4], ts1[4];
#pragma unroll
                for (int m = 0; m < 4; ++m) { const int row = EPI_ROW_OPAQUE;
                    const float* tb = (const float*)((const char*)TAB + (unsigned)(pos_index(row) * 128 + e0 * 4));
                    tc0[m] = *(const f32x4*)tb; tc1[m] = *(const f32x4*)(tb + 4); ts0[m] = *(const f32x4*)(tb + 16); ts1[m] = *(const f32x4*)(tb + 20); }
#pragma unroll
                for (int m = 0; m < 4; ++m) { const int row = EPI_ROW_OPAQUE;
                    const f32x4 c0 = tc0[m], c1 = tc1[m], s0 = ts0[m], s1 = ts1[m];
#pragma unroll
                    for (int bj = 0; bj < 2; ++bj) { f32x4 a = acc[ai][bj][m][0], b = acc[ai][bj][m][1];
                        float ss = ((a[0] * a[0] + a[1] * a[1]) + (a[2] * a[2] + a[3] * a[3])) + ((b[0] * b[0] + b[1] * b[1]) + (b[2] * b[2] + b[3] * b[3]));
                        ss = sum_fq(ss);
                        if (fq == 0) *(float*)((char*)SSQQ + (unsigned)(row * 64 + (8 + 2 * wc + bj) * 4)) = ss;
                        f32x4 oa, ob;
#pragma unroll
                        for (int e = 0; e < 4; ++e) { oa[e] = other_half(a[e], fq >= 2); ob[e] = other_half(b[e], fq >= 2); }
                        if (fq < 2) { a = a * c0 - oa * s0; b = b * c1 - ob * s1; } else { a = a * c0 + oa * s0; b = b * c1 + ob * s1; }
                        *(v4u*)((char*)Q + (unsigned)(__mul24(row, 1536) + ((2 * wc + bj) * 96 + 64 + 8 * fq) * 2)) = pack8(a, b); }
                }
                asm volatile("" ::: "memory"); __builtin_amdgcn_sched_barrier(0);
            }
        }
    }
};
struct EpiKV3 {
    static constexpr bool PERM = true, AFTER_DRAIN = false;
    bf16* K; bf16* V; const float* KPE; const float* KPESSQ; int row0 = 0;
    __device__ __forceinline__ void operator()(const f32x4 (&acc)[2][2][4][2], const pg8::Unit& u, int wr, int wc, int fr_in, int fq_in) const {
        int ln_; asm volatile("v_mbcnt_lo_u32_b32 %0, -1, 0\n\tv_mbcnt_hi_u32_b32 %0, -1, %0" : "=v"(ln_)); const int fr = ln_ & 15, fq = ln_ >> 4; (void)fr_in; (void)fq_in;
        int rbase = row0 + u.pm * 256; asm volatile("" : "+s"(rbase));
        if (u.pn >= 2) {
            const int col = 256 * (u.pn & 1) + wc * 32 + 8 * fq;
            EPI_FOR_ROWS { const int row = EPI_ROW_OPAQUE;
#pragma unroll
                for (int bj = 0; bj < 2; ++bj) *(v4u*)((char*)V + (unsigned)(row * 1024 + (col + 128 * bj) * 2)) = pack8(acc[ai][bj][m][0], acc[ai][bj][m][1]);
            }
            return;
        }
        const int head = 4 * u.pn + wc;
#pragma unroll
        for (int ai = 0; ai < 2; ++ai) {
            float kq[4]; f32x4 kv0[4], kv1[4];
#pragma unroll
            for (int m = 0; m < 4; ++m) { const int row = EPI_ROW_OPAQUE;
                kq[m] = *(const float*)((const char*)KPESSQ + (unsigned)(row * 4));
                const float* kp = (const float*)((const char*)KPE + (unsigned)(row * 128 + 32 * fq)); kv0[m] = *(const f32x4*)kp; kv1[m] = *(const f32x4*)(kp + 4); }
#pragma unroll
            for (int m = 0; m < 4; ++m) { const int row = EPI_ROW_OPAQUE;
                float ss = 0.f;
#pragma unroll
                for (int bj = 0; bj < 2; ++bj) { const f32x4 a = acc[ai][bj][m][0], b = acc[ai][bj][m][1];
                    ss += ((a[0] * a[0] + a[1] * a[1]) + (a[2] * a[2] + a[3] * a[3])) + ((b[0] * b[0] + b[1] * b[1]) + (b[2] * b[2] + b[3] * b[3])); }
                ss = sum_fq(ss);
                const float rinv = 1.0f / sqrtf((ss + kq[m]) * (1.0f / 96.0f) + EPS);
#pragma unroll
                for (int bj = 0; bj < 2; ++bj) *(v4u*)((char*)K + (unsigned)(__mul24(row, 1536) + (head * 96 + 32 * bj + 8 * fq) * 2)) = pack8(acc[ai][bj][m][0] * rinv, acc[ai][bj][m][1] * rinv);
                *(v4u*)((char*)K + (unsigned)(__mul24(row, 1536) + (head * 96 + 64 + 8 * fq) * 2)) = pack8(kv0[m] * rinv, kv1[m] * rinv);
            }
            asm volatile("" ::: "memory"); __builtin_amdgcn_sched_barrier(0);
        }
    }
};
struct EpiPart {
    static constexpr bool PERM = true, AFTER_DRAIN = false;
    float* P; int row0 = 0;
    __device__ __forceinline__ void operator()(const f32x4 (&acc)[2][2][4][2], const pg8::Unit& u, int wr, int wc, int fr, int fq) const {
        const int col = 256 * u.pn + wc * 32 + 8 * fq;
        EPI_FOR_ROWS { const int row = EPI_ROW;
#pragma unroll
            for (int bj = 0; bj < 2; ++bj) { float* p = P + (size_t)row * 1024 + col + 128 * bj; *(f32x4*)p = acc[ai][bj][m][0]; *(f32x4*)(p + 4) = acc[ai][bj][m][1]; }
        }
    }
};
struct ExtraOrder {
    pg8::StaticOrder S; int nstatic, extra, nN;
    __device__ __forceinline__ void init(int N, int G, int c, int extra_) { S.init(MP, N, G, c); nN = N / 256; const int nwg = (MP / 256) * nN; nstatic = (c < nwg) ? (nwg - c + G - 1) / G : 0; extra = extra_; }
    __device__ __forceinline__ bool next(int i, pg8::Unit& u) const { if (i < nstatic) return S.next(i, u); if (extra >= 0 && i == nstatic) { u.pm = MP / 256 + extra / nN; u.pn = extra % nN; return true; } return false; }
    __device__ __forceinline__ void a_ready(const pg8::Unit&) const {}
    __device__ __forceinline__ void done(const pg8::Unit&) const {}
};
struct QOrder {
    int c, G, nstatic, extra;
    __device__ __forceinline__ void init(int G_, int c_, int extra_) { c = c_; G = G_; nstatic = (c < 192) ? (192 - c + G - 1) / G : 0; extra = extra_; }
    __device__ __forceinline__ bool next(int i, pg8::Unit& u) const {
        if (i < nstatic) { const int L = i * G + c; u.pm = L & 63; u.pn = L >> 6; return true; }
        if (extra >= 0 && i == nstatic) { const int hi3 = (extra >= 3) ? 1 : 0; u.pm = MP / 256 + hi3; u.pn = extra - 3 * hi3; return true; }
        return false; }
    __device__ __forceinline__ void a_ready(const pg8::Unit&) const {}
    __device__ __forceinline__ void done(const pg8::Unit&) const {}
};
struct ListOrder {
    int id, nN, cnt;
    __device__ __forceinline__ bool next(int i, pg8::Unit& u) const { if (i >= cnt) return false; u.pm = (id + i) / nN; u.pn = (id + i) % nN; return true; }
    __device__ __forceinline__ void a_ready(const pg8::Unit&) const {}
    __device__ __forceinline__ void done(const pg8::Unit&) const {}
};
constexpr int OUT_SPLIT = 4, DOWN_SPLIT = 11;
__device__ __forceinline__ void fixup_out_row(Frame& F, int r) {
    const int lane = F.lane; const float* part = wsp<float>(F, WS_PARTK) + (size_t)r * 1024;
    const float* xrow = INP(I_XS) + (size_t)r * 1024; float* y = F.out + O_YS + (size_t)r * 1024; bf16* xb = wsp<bf16>(F, WS_X1B) + (size_t)(MP + r) * 1024;
    f32x4 xv[4], pv[4][OUT_SPLIT];
#pragma unroll
    for (int j = 0; j < 4; ++j) { const int col = 4 * lane + 256 * j; xv[j] = *(const f32x4*)(xrow + col);
#pragma unroll
        for (int ch = 0; ch < OUT_SPLIT; ++ch) pv[j][ch] = *(const f32x4*)(part + (size_t)ch * 512 * 1024 + col); }
    float ss = 0.f;
#pragma unroll
    for (int j = 0; j < 4; ++j) { const int col = 4 * lane + 256 * j; f32x4 v = xv[j];
#pragma unroll
        for (int ch = 0; ch < OUT_SPLIT; ++ch) v += pv[j][ch];
        *(f32x4*)(y + col) = v; *(u32x2*)(xb + col) = (u32x2){pk2(v.x, v.y), pk2(v.z, v.w)}; ss += (v.x * v.x + v.y * v.y) + (v.z * v.z + v.w * v.w); }
    ss = wave_sum(ss);
    if (lane == 0) wsp<float>(F, WS_RINVF)[MP + r] = 1.0f / sqrtf(ss * (1.0f / 1024.0f) + EPS);
}
__device__ __forceinline__ void rinvf_rows(Frame& F, int t0, int nt) {
    for (int r = t0; r < MP; r += nt) { const f32x4* sp = (const f32x4*)(wsp<float>(F, WS_SSQ2) + (size_t)r * 16); const f32x4 s0 = sp[0], s1 = sp[1], s2 = sp[2], s3 = sp[3];
        const float ss = ((s0[0] + s0[1]) + (s0[2] + s0[3])) + ((s1[0] + s1[1]) + (s1[2] + s1[3])) + ((s2[0] + s2[1]) + (s2[2] + s2[3])) + ((s3[0] + s3[1]) + (s3[2] + s3[3]));
        wsp<float>(F, WS_RINVF)[r] = 1.0f / sqrtf(ss * (1.0f / 1024.0f) + EPS); }
}
__device__ __forceinline__ void fixup_down_row(Frame& F, int r) {
    const int lane = F.lane; const float* part = wsp<float>(F, WS_PARTK) + (size_t)r * 1024; float* y = F.out + O_YS + (size_t)r * 1024;
#pragma unroll
    for (int jh = 0; jh < 2; ++jh) {
        f32x4 yv[2], pv[2][DOWN_SPLIT];
#pragma unroll
        for (int jj = 0; jj < 2; ++jj) { const int col = 4 * lane + 256 * (2 * jh + jj); yv[jj] = *(const f32x4*)(y + col);
#pragma unroll
            for (int ch = 0; ch < DOWN_SPLIT; ++ch) pv[jj][ch] = *(const f32x4*)(part + (size_t)ch * 512 * 1024 + col); }
#pragma unroll
        for (int jj = 0; jj < 2; ++jj) { const int col = 4 * lane + 256 * (2 * jh + jj); f32x4 v = yv[jj];
#pragma unroll
            for (int ch = 0; ch < DOWN_SPLIT; ++ch) v += pv[jj][ch];
            *(f32x4*)(y + col) = v; }
    }
}

struct P2aIn { u32x2 vw; unsigned qw[3]; unsigned short x1, x2; float cs, sn; };
__device__ __forceinline__ void p2a_load(Frame& F, int row, P2aIn& in) {
    const int lane = F.lane, j = lane & 15;
    const bf16* raw = wsp<bf16>(F, WS_RAW) + (size_t)row * 768;
    in.vw = *(const u32x2*)(raw + 4 * lane);
#pragma unroll
    for (int i = 0; i < 3; ++i) in.qw[i] = *(const unsigned*)(raw + 256 + 2 * lane + 128 * i);
    in.x1 = raw[640 + j]; in.x2 = raw[656 + j];
    const float* tb = wsp<float>(F, WS_TAB) + pos_index(row) * 32; in.cs = tb[j]; in.sn = tb[16 + j];
}
__device__ __forceinline__ void p2a_row(Frame& F, int row, const P2aIn& in) {
    const int lane = F.lane;
    {
        const u32x2 vw = in.vw;
        const f32x4 v = (f32x4){__uint_as_float(vw.x << 16), __uint_as_float(vw.x & 0xffff0000u), __uint_as_float(vw.y << 16), __uint_as_float(vw.y & 0xffff0000u)};
        const float ss = wave_sum((v.x * v.x + v.y * v.y) + (v.z * v.z + v.w * v.w));
        const float rinv = 1.0f / sqrtf(ss * (1.0f / 256.0f) + EPS);
        const f32x4 g = *(const f32x4*)(INP(I_KVG) + 4 * lane);
        const f32x4 o = v * rinv * g;
        float* lat = (row < MP) ? F.out + O_LATP + (size_t)row * 256 : F.out + O_LATS + (size_t)(row - MP) * 256;
        *(f32x4*)(lat + 4 * lane) = o;
        *(u32x2*)(wsp<bf16>(F, WS_CKV) + (size_t)row * 256 + 4 * lane) = (u32x2){pk2(o.x, o.y), pk2(o.z, o.w)};
    }
    {
        f32x2 q[3]; float ss = 0.f;
#pragma unroll
        for (int i = 0; i < 3; ++i) { const unsigned w = in.qw[i]; q[i] = (f32x2){__uint_as_float(w << 16), __uint_as_float(w & 0xffff0000u)}; ss += q[i].x * q[i].x + q[i].y * q[i].y; }
        const float rinv = 1.0f / sqrtf(wave_sum(ss) * (1.0f / 384.0f) + EPS);
#pragma unroll
        for (int i = 0; i < 3; ++i) *(unsigned*)(wsp<bf16>(F, WS_CQN) + (size_t)row * 384 + 2 * lane + 128 * i) = pk2(q[i].x * rinv, q[i].y * rinv);
    }
    {
        const float x1 = bf2f(in.x1), x2 = bf2f(in.x2), cs = in.cs, s = in.sn;
        const float o = ((lane & 31) < 16) ? (x1 * cs - x2 * s) : (x2 * cs + x1 * s);
        float s2 = o * o; s2 += __shfl_xor(s2, 1); s2 += __shfl_xor(s2, 2); s2 += __shfl_xor(s2, 4); s2 += __shfl_xor(s2, 8); s2 += __shfl_xor(s2, 16);
        if (lane < 32) { float* kr = (row < MP) ? F.out + O_KRP + (size_t)row * 32 : F.out + O_KRS + (size_t)(row - MP) * 32;
            kr[lane] = o; wsp<float>(F, WS_KPE)[(size_t)row * 32 + lane] = o;
            if (lane == 0) wsp<float>(F, WS_KPESSQ)[row] = s2; }
    }
}
__device__ __forceinline__ void p2a_rows(Frame& F, int gw, int NGW) {
#pragma unroll 1
    for (int m0 = gw; m0 < M; m0 += 5 * NGW) {
        P2aIn in[5];
#pragma unroll
        for (int k = 0; k < 5; ++k) { const int mk = m0 + k * NGW; p2a_load(F, mk < M ? mk : m0, in[k]); }
#pragma unroll
        for (int k = 0; k < 5; ++k) { const int mk = m0 + k * NGW; if (mk < M) p2a_row(F, mk, in[k]); }
    }
}
__device__ __forceinline__ void qlat_job(Frame& F, int db, int h, bf16* qlat  ) {
    const int lane = F.lane; const float* GG = wsp<float>(F, WS_GG);
    float a[4], ar[4];
#pragma unroll
    for (int qi = 0; qi < 4; ++qi) { const size_t row = (size_t)(MP + db * 4 + qi); const bf16* q = wsp<bf16>(F, WS_Q) + row * 768 + h * 96; const float* sq = wsp<float>(F, WS_SSQQ) + row * 16;
        const float rinv = 1.0f / sqrtf((sq[h] + sq[8 + h]) * (1.0f / 96.0f) + EPS);
        a[qi] = bf2f(q[lane]) * rinv * GG[lane]; ar[qi] = bf2f(q[64 + (lane & 31)]) * rinv * GG[64 + (lane & 31)]; }
    const bf16* W = wsp<bf16>(F, WS_WKV) + (size_t)(256 * (h >> 2) + 32 * (h & 3)) * 256 + 2 * lane;
    float acc[4][2][2];
#pragma unroll
    for (int qi = 0; qi < 4; ++qi)
#pragma unroll
        for (int i = 0; i < 2; ++i) { acc[qi][i][0] = 0.f; acc[qi][i][1] = 0.f; }
#pragma unroll 1
    for (int half = 0; half < 2; ++half) {
        unsigned wv[32][2];
#pragma unroll
        for (int dd = 0; dd < 32; ++dd)
#pragma unroll
            for (int i = 0; i < 2; ++i) wv[dd][i] = *(const unsigned*)(W + (size_t)(128 * half + dd) * 256 + 128 * i);
#pragma unroll
        for (int dd = 0; dd < 32; ++dd)
#pragma unroll
            for (int qi = 0; qi < 4; ++qi) { const float ad = __uint_as_float(__builtin_amdgcn_readlane(__float_as_uint(a[qi]), 32 * half + dd));
#pragma unroll
                for (int i = 0; i < 2; ++i) { acc[qi][i][0] += ad * __uint_as_float(wv[dd][i] << 16); acc[qi][i][1] += ad * __uint_as_float(wv[dd][i] & 0xffff0000u); } }
    }
#pragma unroll
    for (int qi = 0; qi < 4; ++qi) { bf16* o = qlat + (h * 4 + qi) * 288;
#pragma unroll
        for (int i = 0; i < 2; ++i) *(unsigned*)(o + 2 * lane + 128 * i) = pk2(acc[qi][i][0], acc[qi][i][1]);
        if (lane < 32) o[256 + lane] = (bf16)f2bf(ar[qi]); }
}

constexpr int CONV_ITEMS = BATCH * (SEQ / 32) + DEC_BATCH;
__device__ __forceinline__ void conv_item(Frame& F, int item) {
    const int c = F.tid, lane = F.lane;
    const bf16* U = wsp<bf16>(F, WS_U);
    LAS float* Y = (LAS float*)(F.lds + RING_OFF);
    LAS bf16* UT = (LAS bf16*)(F.lds + RING_OFF + 65536);
    int rowbase, nrows;
    if (item < BATCH * (SEQ / 32)) {
        const int seq = item >> 7, t0 = (item & 127) * 32; rowbase = seq * SEQ + t0; nrows = 32;
#pragma unroll
        for (int i = 0; i < 8; ++i) { const int id = c + 512 * i; if (id < 62 * 64) { const int j = id >> 6, part = id & 63; const int tt = t0 - 30 + j;
            v4u v = (v4u){0u, 0u, 0u, 0u}; if (tt >= 0) v = *(const v4u*)(U + (size_t)(seq * SEQ + tt) * 512 + 8 * part);
            *(LAS v4u*)(UT + j * 512 + 8 * part) = v; } }
    } else {
        const int db = item - BATCH * (SEQ / 32); rowbase = MP + db * 4; nrows = 4;
#pragma unroll
        for (int i = 0; i < 8; ++i) { const int id = c + 512 * i; if (id < 62 * 64) { const int j = id >> 6, part = id & 63;
            v4u v = (v4u){0u, 0u, 0u, 0u};
            if (j < 30) { const float* s = INP(I_SCONV) + ((size_t)db * 30 + j) * 512 + 8 * part; const f32x4 a = *(const f32x4*)s, b2 = *(const f32x4*)(s + 4); v = (v4u){pk2(a.x, a.y), pk2(a.z, a.w), pk2(b2.x, b2.y), pk2(b2.z, b2.w)}; }
            else if (j < 34) v = *(const v4u*)(U + (size_t)(MP + db * 4 + (j - 30)) * 512 + 8 * part);
            *(LAS v4u*)(UT + j * 512 + 8 * part) = v; } }
    }
    float cw[CW];
#pragma unroll
    for (int w = 0; w < CW; ++w) cw[w] = INP(I_CVW)[w * 512 + c];
    const float bias = INP(I_CVB)[c];
    __syncthreads();
    float win[62];
#pragma unroll
    for (int j = 0; j < 62; ++j) win[j] = bf2f(UT[j * 512 + c]);
#pragma unroll
    for (int i = 0; i < 32; ++i) { float y = bias;
#pragma unroll
        for (int w = 0; w < CW; ++w) y += cw[w] * win[i + w];
        Y[i * 512 + c] = y; }
    __syncthreads();
    const f32x4 lg0 = *(const f32x4*)(INP(I_LNG) + 8 * lane), lg1 = *(const f32x4*)(INP(I_LNG) + 8 * lane + 4), lb0 = *(const f32x4*)(INP(I_LNB) + 8 * lane), lb1 = *(const f32x4*)(INP(I_LNB) + 8 * lane + 4);
#pragma unroll
    for (int rr = 0; rr < 4; ++rr) { const int i = 4 * F.wave + rr;
        if (i < nrows) {
            f32x4 a = *(const LAS f32x4*)(Y + i * 512 + 8 * lane), b = *(const LAS f32x4*)(Y + i * 512 + 8 * lane + 4);
            const float mean = wave_sum(((a.x + a.y) + (a.z + a.w)) + ((b.x + b.y) + (b.z + b.w))) * (1.0f / 512.0f);
            a = a - mean; b = b - mean;
            const float var = wave_sum(((a.x * a.x + a.y * a.y) + (a.z * a.z + a.w * a.w)) + ((b.x * b.x + b.y * b.y) + (b.z * b.z + b.w * b.w))) * (1.0f / 512.0f);
            const float rstd = 1.0f / sqrtf(var + EPS);
            f32x4 r0 = a * rstd * lg0 + lb0, r1 = b * rstd * lg1 + lb1;
#pragma unroll
            for (int e = 0; e < 4; ++e) { r0[e] = r0[e] * sigm(r0[e]); r1[e] = r1[e] * sigm(r1[e]); }
            *(v4u*)(wsp<bf16>(F, WS_T) + (size_t)(rowbase + i) * 512 + 8 * lane) = pack8(r0, r1);
        } }
    __syncthreads();
}
}
namespace mk {
typedef float f32x16 __attribute__((ext_vector_type(16)));
typedef short s16x4 __attribute__((ext_vector_type(4)));
typedef short v4i16_t __attribute__((ext_vector_type(4)));
typedef int v8i_t __attribute__((ext_vector_type(8)));
__device__ __forceinline__ int crow(int r, int hi) { return (r & 3) + 8 * (r >> 2) + 4 * hi; }
__device__ __forceinline__ s16x4 tr_read(const LAS unsigned char* p) { return __builtin_bit_cast(s16x4, __builtin_amdgcn_ds_read_tr16_b64_v4i16((LAS v4i16_t*)p)); }
__device__ __forceinline__ bf16x8 lds_b128(const LAS unsigned char* p) { return *(const LAS bf16x8*)p; }

__device__ __forceinline__ float attn_bound(Frame& F) {
    const int lane = F.lane;
    float gq = fabsf(INP(I_QNG)[lane]), gk = fabsf(INP(I_KNG)[lane]);
    if (lane < 16) { gq = fmaxf(gq, fabsf(INP(I_QNG)[64 + lane])); gk = fmaxf(gk, fabsf(INP(I_KNG)[64 + lane])); }
#pragma unroll
    for (int o = 1; o < 64; o <<= 1) { gq = fmaxf(gq, __shfl_xor(gq, o)); gk = fmaxf(gk, __shfl_xor(gk, o)); }
    return 9.7979589711f * gq * gk * LOG2E * 1.02f + 0.05f;
}

constexpr int PA_KP = 208, PA_VP = 144;
constexpr int PA_KB = 0, PA_KBSZ = 128 * PA_KP, PA_VB = 2 * PA_KBSZ, PA_VBSZ = 128 * PA_VP, PA_LW = PA_VB + 2 * PA_VBSZ;
__device__ __forceinline__ void attn_prompt_unit(Frame& F, int b, int h, int qb, float B2) {
    const int tid = F.tid, lane = F.lane, wave = F.wave, r32 = lane & 31, hi = lane >> 5;
    const bf16* Qg = wsp<bf16>(F, WS_Q); const bf16* Kg = wsp<bf16>(F, WS_K); const bf16* Vg = wsp<bf16>(F, WS_V); bf16* Og = wsp<bf16>(F, WS_O);
    const size_t rowbase = (size_t)b * SEQ;
    const int q0 = qb * 256 + wave * 32;
    LAS unsigned char* ring = F.lds + RING_OFF;
    bf16x8 qr[6];
#pragma unroll
    for (int s = 0; s < 6; ++s) qr[s] = *(const bf16x8*)(Qg + (rowbase + q0 + r32) * 768 + h * 96 + 16 * s + 8 * hi);
    {
        const float* sq = wsp<float>(F, WS_SSQQ) + (rowbase + q0 + r32) * 16; const float rq = 1.0f / sqrtf((sq[h] + sq[8 + h]) * (1.0f / 96.0f) + EPS);
#pragma unroll
        for (int s = 0; s < 6; ++s) { float f[8]; unpack8(__builtin_bit_cast(v4u, qr[s]), f);
            const float* gg = wsp<float>(F, WS_GG) + 16 * s + 8 * hi; const f32x4 g0 = *(const f32x4*)gg * rq, g1 = *(const f32x4*)(gg + 4) * rq;
            v4u w; w.x = cvtpk(f[0] * g0[0], f[1] * g0[1]); w.y = cvtpk(f[2] * g0[2], f[3] * g0[3]); w.z = cvtpk(f[4] * g1[0], f[5] * g1[1]); w.w = cvtpk(f[6] * g1[2], f[7] * g1[3]); qr[s] = __builtin_bit_cast(bf16x8, w); } }
    f32x16 o0, o1;
#pragma unroll
    for (int r = 0; r < 16; ++r) { o0[r] = 0.f; o1[r] = 0.f; }
    float lsum = 0.f;
    const int NT = 2 * qb + 2;
    unsigned koff[3]; int kdst[3]; unsigned voff[2]; int vdst[2];
#pragma unroll
    for (int i = 0; i < 3; ++i) { const int id = tid + 512 * i, key = id / 12, part = id % 12; koff[i] = (unsigned)(key * 768 + 8 * part); kdst[i] = PA_KB + key * PA_KP + part * 16; }
#pragma unroll
    for (int i = 0; i < 2; ++i) { const int id = tid + 512 * i, key = id >> 3, part = id & 7; voff[i] = (unsigned)(key * 512 + 8 * part); vdst[i] = PA_VB + key * PA_VP + part * 16; }
    const bf16* Kb0 = Kg + rowbase * 768 + h * 96; const bf16* Vb0 = Vg + rowbase * 512 + h * 64;
    v4u kreg[3], vreg[2];
#define PA_LOAD(t) do { const bf16* kt_ = Kb0 + (size_t)(t) * 128 * 768; const bf16* vt_ = Vb0 + (size_t)(t) * 128 * 512; \
                        _Pragma("unroll") for (int i_ = 0; i_ < 3; ++i_) kreg[i_] = *(const v4u*)(kt_ + koff[i_]); \
                        _Pragma("unroll") for (int i_ = 0; i_ < 2; ++i_) vreg[i_] = *(const v4u*)(vt_ + voff[i_]); } while (0)
#define PA_STORE(buf) do { _Pragma("unroll") for (int i_ = 0; i_ < 3; ++i_) *(LAS v4u*)(ring + (buf) * PA_KBSZ + kdst[i_]) = kreg[i_]; \
                           _Pragma("unroll") for (int i_ = 0; i_ < 2; ++i_) *(LAS v4u*)(ring + (buf) * PA_VBSZ + vdst[i_]) = vreg[i_]; } while (0)
    PA_LOAD(0);
    const int tl = lane & 15, g4 = lane >> 4;
    const int vtr_off = (4 * hi + (tl >> 2)) * PA_VP + (16 * (g4 & 1) + 4 * (tl & 3)) * 2;
    for (int t = 0; t < NT; ++t) {
        const int buf = t & 1;
        PA_STORE(buf);
        __syncthreads();
        if (t + 1 < NT) PA_LOAD(t + 1);
#pragma unroll 1
        for (int sub = 0; sub < 2; ++sub) {
            const int t64 = 2 * t + sub;
            if (64 * t64 > q0 + 31) continue;
            const LAS unsigned char* kb = ring + PA_KB + buf * PA_KBSZ + (64 * sub + r32) * PA_KP + hi * 16;
            f32x16 p0, p1;
#pragma unroll
            for (int r = 0; r < 16; ++r) { p0[r] = -B2; p1[r] = -B2; }
            __builtin_amdgcn_s_setprio(1);
#pragma unroll
            for (int s = 0; s < 6; ++s) {
                const bf16x8 a0 = lds_b128(kb + s * 32), a1 = lds_b128(kb + 32 * PA_KP + s * 32);
                p0 = __builtin_amdgcn_mfma_f32_32x32x16_bf16(a0, qr[s], p0, 0, 0, 0);
                p1 = __builtin_amdgcn_mfma_f32_32x32x16_bf16(a1, qr[s], p1, 0, 0, 0);
            }
            __builtin_amdgcn_s_setprio(0);
#pragma unroll
            for (int r = 0; r < 16; ++r) { p0[r] = __builtin_amdgcn_exp2f(p0[r]); p1[r] = __builtin_amdgcn_exp2f(p1[r]); }
            if (t64 >= 4 * qb) {
                const int qq = q0 + r32, k0 = 64 * t64 + 4 * hi;
#pragma unroll
                for (int r = 0; r < 16; ++r) { const int kk = k0 + (r & 3) + 8 * (r >> 2); if (kk > qq) p0[r] = 0.f; if (kk + 32 > qq) p1[r] = 0.f; }
            }
            float sacc = 0.f;
#pragma unroll
            for (int r = 0; r < 16; ++r) sacc += p0[r] + p1[r];
            lsum += sacc;
            const LAS unsigned char* vb = ring + PA_VB + buf * PA_VBSZ + 64 * sub * PA_VP + vtr_off;
#pragma unroll
            for (int mt = 0; mt < 2; ++mt)
#pragma unroll
                for (int s = 0; s < 2; ++s) {
                    const f32x16& p = mt ? p1 : p0;
                    v4u pw; pw.x = cvtpk(p[8 * s + 0], p[8 * s + 1]); pw.y = cvtpk(p[8 * s + 2], p[8 * s + 3]); pw.z = cvtpk(p[8 * s + 4], p[8 * s + 5]); pw.w = cvtpk(p[8 * s + 6], p[8 * s + 7]);
                    const bf16x8 pa = __builtin_bit_cast(bf16x8, pw);
                    const LAS unsigned char* vk = vb + (32 * mt + 16 * s) * PA_VP;
                    __builtin_amdgcn_s_setprio(1);
#pragma unroll
                    for (int d0 = 0; d0 < 2; ++d0) {
                        const s16x4 lo = tr_read(vk + d0 * 64), h4 = tr_read(vk + d0 * 64 + 8 * PA_VP);
                        const bf16x8 vf = (bf16x8){lo[0], lo[1], lo[2], lo[3], h4[0], h4[1], h4[2], h4[3]};
                        if (d0 == 0) o0 = __builtin_amdgcn_mfma_f32_32x32x16_bf16(pa, vf, o0, 0, 0, 0); else o1 = __builtin_amdgcn_mfma_f32_32x32x16_bf16(pa, vf, o1, 0, 0, 0);
                    }
                    __builtin_amdgcn_s_setprio(0);
                }
        }
    }
#undef PA_LOAD
#undef PA_STORE
    lsum += __shfl_xor(lsum, 32);
    LAS float* lw = (LAS float*)(ring + PA_LW) + wave * 32;
    if (hi == 0) lw[r32] = lsum;
    LDS_WAIT(); asm volatile("" ::: "memory");
    bf16* orow = Og + (rowbase + q0) * 512 + h * 64 + r32;
#pragma unroll
    for (int r = 0; r < 16; ++r) { const int q = crow(r, hi); const float inv = 1.0f / lw[q];
        orow[(size_t)q * 512] = (bf16)f2bf(o0[r] * inv); orow[(size_t)q * 512 + 32] = (bf16)f2bf(o1[r] * inv); }
    LDS_WAIT(); asm volatile("" ::: "memory");
}
__device__ __forceinline__ void attn_prompt_phase(Frame& F) {
    const float B2 = attn_bound(F);
    for (int p = blockIdx.x; p < BATCH * NH * 8; p += F.G) {
        const int bh = p >> 3, s = p & 7;
        attn_prompt_unit(F, bh >> 3, bh & 7, s, B2);
        attn_prompt_unit(F, bh >> 3, bh & 7, 15 - s, B2);
    }
    __syncthreads();
}

#ifndef SA_EXP
#define SA_EXP 0
#endif
#ifdef SA_PROF
#define SA_T(k) do { const unsigned t_ = (unsigned)__builtin_readcyclecounter(); if ((k) == SA_PROFK) prof_acc += (float)(t_ - prof_t); prof_t = t_; } while (0)
#else
#define SA_T(k) do {} while (0)
#endif
constexpr int SA_CP = 592;
constexpr int SA_CB = 0, SA_CBSZ = 64 * SA_CP, SA_PB = 2 * SA_CBSZ, SA_PP = 144, SA_RINV = SA_PB + 32 * SA_PP, SA_QL = SA_RINV + 8 * 64 * 4, SA_LSW = SA_QL + 32 * SA_CP, SA_C8 = SA_LSW + 8 * 16 * 4 + 64 * 4, SA_C8P = 272, SA_C8SZ = 64 * SA_C8P, SA_END = SA_C8 + 2 * SA_C8SZ;
static_assert(SA_END <= RING_BYTES, "sample attention LDS");
constexpr int SA_NUNITS = DEC_BATCH * SA_UNITS_PER_SEQ;
__device__ __forceinline__ bf16x8 fp8x8_to_bf16x8(const u32x2 w) {
    const f32x2 f0 = __builtin_amdgcn_cvt_pk_f32_fp8((int)w.x, false), f1 = __builtin_amdgcn_cvt_pk_f32_fp8((int)w.x, true), f2 = __builtin_amdgcn_cvt_pk_f32_fp8((int)w.y, false), f3 = __builtin_amdgcn_cvt_pk_f32_fp8((int)w.y, true);
    v4u o; o.x = cvtpk(f0.x, f0.y); o.y = cvtpk(f1.x, f1.y); o.z = cvtpk(f2.x, f2.y); o.w = cvtpk(f3.x, f3.y);
    return __builtin_bit_cast(bf16x8, o);
}
template <int MODE  > __device__ __forceinline__ void attn_sample_phase(Frame& F) {
    const int tid = F.tid, lane = F.lane, wave = F.wave, r32 = lane & 31, hi = lane >> 5, tl = lane & 15, g4 = lane >> 4;
    const float B2 = attn_bound(F);
    LAS unsigned char* ring = F.lds + RING_OFF;
    const float* clat = INP(I_CLAT); const float* ckpe = INP(I_CKPE); const int* ptab = (const int*)INP(I_PT);
    LAS float* RINV = (LAS float*)(ring + SA_RINV);
    LAS float* LSW = (LAS float*)(ring + SA_LSW);
    LAS float* KSQ = (LAS float*)(ring + SA_LSW) + 8 * 16;
    const int slot = blockIdx.x, nslots = F.G;
    const int nunits_cu = (slot < SA_NUNITS) ? (SA_NUNITS - slot + nslots - 1) / nslots : 0;
#pragma unroll 1
    for (int k = 0; k < nunits_cu; ++k) { const int un = slot + k * nslots; qlat_job(F, un >> 1, wave, wsp<bf16>(F, WS_QLAT) + (size_t)un * 32 * 288); }
    __builtin_amdgcn_fence(__ATOMIC_RELEASE, "workgroup"); __syncthreads(); __builtin_amdgcn_fence(__ATOMIC_ACQUIRE, "workgroup");
    v8i_t wa8[2][4];
    { const unsigned char* W = wsp<unsigned char>(F, WS_WUK8) + (size_t)(wave * 64 + r32) * 256 + 32 * hi;
#pragma unroll
      for (int mt = 0; mt < 2; ++mt)
#pragma unroll
          for (int ks = 0; ks < 4; ++ks) { const v4u lo_ = *(const v4u*)(W + (size_t)(32 * mt) * 256 + 64 * ks), hi_ = *(const v4u*)(W + (size_t)(32 * mt) * 256 + 64 * ks + 16);
              wa8[mt][ks] = (v8i_t){(int)lo_.x, (int)lo_.y, (int)lo_.z, (int)lo_.w, (int)hi_.x, (int)hi_.y, (int)hi_.z, (int)hi_.w}; } }
    asm volatile("s_waitcnt vmcnt(0)" ::: "memory");
    const int sc_row = 16 * (wave & 1) + tl, sc_key = 16 * (wave >> 1) + tl;
    const int p_key = sc_key, p_hh = 4 * (wave & 1) + g4;
#ifdef SA_PROF
    float prof_acc = 0.f; unsigned prof_t = (unsigned)__builtin_readcyclecounter(); const unsigned prof_t0 = prof_t; const unsigned long long prof_rt0 = __builtin_amdgcn_s_memrealtime();
#endif
    f32x4 preA[9], preB[9];
    const unsigned voff16 = (unsigned)tid * 16u;
    const int st_b16 = (tid >> 6) * SA_CP + (tid & 63) * 8, st_b8 = (tid >> 6) * SA_C8P + (tid & 63) * 4, st_kpe = (tid >> 3) * SA_CP + 512 + (tid & 7) * 8;
    for (int k0 = 0; k0 < nunits_cu; k0 += 2) {
        const int nk = (nunits_cu - k0 < 2) ? nunits_cu - k0 : 2, NT = nk * 64;
        int physv = 0;
        { const int k = lane >> 5; if (k < nk) { const int un = slot + (k0 + k) * nslots; physv = ptab[(un >> 1) * NPAGES + 32 * (un & 1) + (lane & 31)]; } }
#define SA_LOAD(PRE, T) do { const int phys_ = __builtin_amdgcn_readlane(physv, (T) >> 1); \
            const float* lat_ = clat + ((size_t)phys_ * PAGE + ((T) & 1) * 64) * KVLORA; const float* kp_ = ckpe + ((size_t)phys_ * PAGE + ((T) & 1) * 64) * ROPE; \
            _Pragma("unroll") for (int j_ = 0; j_ < 8; ++j_) { const char* bj_ = (const char*)lat_ + 8192 * j_; PRE[j_] = __builtin_nontemporal_load((const f32x4*)(bj_ + voff16)); } \
            PRE[8] = __builtin_nontemporal_load((const f32x4*)((const char*)kp_ + voff16)); } while (0)
#define SA_STORE(PRE, buf) do { LAS unsigned char* cb_ = ring + SA_CB + (buf) * SA_CBSZ; \
            LAS unsigned char* c8_ = ring + SA_C8 + (buf) * SA_C8SZ; \
            _Pragma("unroll") for (int j_ = 0; j_ < 8; ++j_) { *(LAS u32x2*)(cb_ + st_b16 + j_ * 8 * SA_CP) = (u32x2){cvtpk(PRE[j_][0], PRE[j_][1]), cvtpk(PRE[j_][2], PRE[j_][3])}; \
                int p8_ = __builtin_amdgcn_cvt_pk_fp8_f32(PRE[j_][0], PRE[j_][1], 0, false); p8_ = __builtin_amdgcn_cvt_pk_fp8_f32(PRE[j_][2], PRE[j_][3], p8_, true); *(LAS int*)(c8_ + st_b8 + j_ * 8 * SA_C8P) = p8_; } \
            *(LAS u32x2*)(cb_ + st_kpe) = (u32x2){cvtpk(PRE[8][0], PRE[8][1]), cvtpk(PRE[8][2], PRE[8][3])}; } while (0)
        SA_LOAD(preA, 0);
        SA_LOAD(preB, 1);
        __syncthreads();
        SA_STORE(preA, 0);
        if (2 < NT) SA_LOAD(preA, 2);
        f32x16 oacc;
#pragma unroll
        for (int r = 0; r < 16; ++r) oacc[r] = 0.f;
        float lsum[4] = {0.f, 0.f, 0.f, 0.f};
        int unit = 0;
#define SA_RDB(DST, KP, KS) do { const v4u lo_ = *(const LAS v4u*)((KP) + 64 * (KS)), hi_ = *(const LAS v4u*)((KP) + 64 * (KS) + 16); DST = (v8i_t){(int)lo_.x, (int)lo_.y, (int)lo_.z, (int)lo_.w, (int)hi_.x, (int)hi_.y, (int)hi_.z, (int)hi_.w}; } while (0)
#define SA_STEP(T, PRE) do { const int buf = (T) & 1; \
            if ((T & 63) == 0) {    \
                unit = slot + (k0 + (T >> 6)) * nslots; const int db = unit >> 1; \
                {    \
                    const bf16* src = wsp<bf16>(F, WS_QLAT) + (size_t)unit * 32 * 288; (void)db; \
                    int t2_ = tid; asm volatile("" : "+v"(t2_)); \
_Pragma("unroll") \
                    for (int j = 0; j < 3; ++j) { const int id = t2_ + 512 * j; if (id < 1152) { const int row = id / 36, part = id % 36; *(LAS v4u*)(ring + SA_QL + row * SA_CP + part * 16) = *(const v4u*)(src + row * 288 + 8 * part); } } \
                } \
_Pragma("unroll") \
                for (int r = 0; r < 16; ++r) oacc[r] = 0.f; \
_Pragma("unroll") \
                for (int q = 0; q < 4; ++q) lsum[q] = 0.f; \
                __syncthreads(); \
            } \
            const LAS unsigned char* cb = ring + SA_CB + buf * SA_CBSZ; \
            SA_T(0); \
            {    \
                const LAS unsigned char* c8 = ring + SA_C8 + buf * SA_C8SZ + r32 * SA_C8P + hi * 32; \
                float ssq0 = 0.f, ssq1 = 0.f; \
_Pragma("unroll") \
                for (int kt = 0; kt < 2; ++kt) { \
                    const LAS unsigned char* kp = c8 + kt * 32 * SA_C8P; \
                    float ss = 0.f; \
_Pragma("unroll") \
                    for (int mt = 0; mt < 2; ++mt) { \
                        f32x16 a0; \
_Pragma("unroll") \
                        for (int r = 0; r < 16; ++r) a0[r] = 0.f; \
                        v8i_t bq[2]; \
                        SA_RDB(bq[0], kp, 0); \
                        __builtin_amdgcn_sched_barrier(0); \
_Pragma("unroll") \
                        for (int ks = 0; ks < 4; ++ks) { \
                            if (ks < 3) SA_RDB(bq[(ks + 1) & 1], kp, ks + 1); \
                            __builtin_amdgcn_sched_barrier(0); \
                            a0 = __builtin_amdgcn_mfma_scale_f32_32x32x64_f8f6f4(wa8[mt][ks], bq[ks & 1], a0, 0, 0, 0, 0x7F7F7F7F, 0, 0x7F7F7F7F); \
                            __builtin_amdgcn_sched_barrier(0); \
                        } \
_Pragma("unroll") \
                        for (int r = 0; r < 16; ++r) ss += a0[r] * a0[r]; \
                    } \
                    if (kt == 0) ssq0 = ss; else ssq1 = ss; \
                } \
                ssq0 *= (1.0f / 256.0f); ssq1 *= (1.0f / 256.0f); \
_Pragma("unroll") \
                for (int kt = 0; kt < 2; ++kt) { float kf[8]; float ss = 0.f; \
                    unpack8(*(const LAS v4u*)(cb + (32 * kt + r32) * SA_CP + 512 + hi * 32), kf); \
_Pragma("unroll") \
                    for (int e = 0; e < 8; ++e) ss += kf[e] * kf[e]; \
                    unpack8(*(const LAS v4u*)(cb + (32 * kt + r32) * SA_CP + 512 + hi * 32 + 16), kf); \
_Pragma("unroll") \
                    for (int e = 0; e < 8; ++e) ss += kf[e] * kf[e]; \
                    if (kt == 0) ssq0 += ss; else ssq1 += ss; } \
                ssq0 += __shfl_xor(ssq0, 32); ssq1 += __shfl_xor(ssq1, 32); \
                if (hi == 0) { RINV[wave * 64 + r32] = 1.0f / sqrtf(ssq0 * (1.0f / 96.0f) + EPS); RINV[wave * 64 + 32 + r32] = 1.0f / sqrtf(ssq1 * (1.0f / 96.0f) + EPS); } \
            } \
            f32x4 sc = (f32x4){0.f, 0.f, 0.f, 0.f}; \
_Pragma("unroll") \
            for (int ks = 0; ks < (MODE == 6 ? 0 : 9); ++ks) { \
                const bf16x8 af = lds_b128(ring + SA_QL + sc_row * SA_CP + (32 * ks + 8 * g4) * 2); \
                const bf16x8 bfr = lds_b128(cb + sc_key * SA_CP + (32 * ks + 8 * g4) * 2); \
                sc = __builtin_amdgcn_mfma_f32_16x16x32_bf16(af, bfr, sc, 0, 0, 0); \
            } \
            SA_T(2); \
            if (MODE != 4) __syncthreads(); \
            SA_T(3); \
            if (MODE != 6) {    \
                const float rinv = RINV[p_hh * 64 + p_key]; \
_Pragma("unroll") \
                for (int q = 0; q < 4; ++q) { const float p = __builtin_amdgcn_exp2f(sc[q] * rinv - B2); lsum[q] += p; \
                    *(LAS bf16*)(ring + SA_PB + (4 * p_hh + q) * SA_PP + p_key * 2) = (bf16)f2bf(p); } \
            } \
            if (T + 1 < NT) { SA_STORE(PRE, buf ^ 1); if (T + 3 < NT) SA_LOAD(PRE, T + 3); } \
            SA_T(4); \
            if (MODE != 4) __syncthreads(); \
            SA_T(5); \
_Pragma("unroll") \
            for (int s = 0; s < (MODE == 6 ? 0 : 4); ++s) { \
                const bf16x8 pa = lds_b128(ring + SA_PB + r32 * SA_PP + (16 * s + 8 * hi) * 2); \
                const LAS unsigned char* vb = cb + (16 * s + 8 * hi + (tl >> 2)) * SA_CP + (32 * wave + 16 * (g4 & 1) + 4 * (tl & 3)) * 2; \
                const s16x4 lo = tr_read(vb), h4 = tr_read(vb + 4 * SA_CP); \
                oacc = __builtin_amdgcn_mfma_f32_32x32x16_bf16(pa, (bf16x8){lo[0], lo[1], lo[2], lo[3], h4[0], h4[1], h4[2], h4[3]}, oacc, 0, 0, 0); \
            } \
            SA_T(6); \
            if (MODE == 0 && (T & 63) == 63) {    \
                int l2_ = lane; asm volatile("" : "+v"(l2_)); \
                float* part = wsp<float>(F, WS_SPART) + (size_t)unit * SA_PART_STRIDE + 32 * wave + (l2_ & 31); \
_Pragma("unroll") \
                for (int r = 0; r < 16; ++r) part[crow(r, l2_ >> 5) * 256] = oacc[r]; \
_Pragma("unroll") \
                for (int q = 0; q < 4; ++q) { float v = lsum[q]; v += __shfl_xor(v, 1); v += __shfl_xor(v, 2); v += __shfl_xor(v, 4); v += __shfl_xor(v, 8); if ((l2_ & 15) == 0) LSW[wave * 16 + (l2_ >> 4) * 4 + q] = v; } \
                __syncthreads(); \
                if (tid < 32) { const int par = tid >> 4, idx = tid & 15; wsp<float>(F, WS_SPART)[(size_t)unit * SA_PART_STRIDE + 32 * 256 + tid] = (LSW[(0 + par) * 16 + idx] + LSW[(2 + par) * 16 + idx]) + (LSW[(4 + par) * 16 + idx] + LSW[(6 + par) * 16 + idx]); } \
            } \
        } while (0)
        for (int T0 = 0; T0 < NT; T0 += 2) { SA_STEP(T0, preB); SA_STEP(T0 + 1, preA); }
#undef SA_STEP
#undef SA_RDB
#undef SA_LOAD
#undef SA_STORE
    }
#ifdef SA_PROF
    if (blockIdx.x == SA_PROF && tid == 64 * (SA_PROFW)) { float* st = (float*)(F.ws + WS_END); st[0] = prof_acc; st[1] = (float)((unsigned)__builtin_readcyclecounter() - prof_t0); if (SA_PROFK == 9) { st[0] = st[1]; st[1] = (float)(__builtin_amdgcn_s_memrealtime() - prof_rt0) * 40.0f; } if (SA_PROFK == 8) { st[0] = (float)(__builtin_amdgcn_s_memrealtime() - prof_rt0); st[1] = 100000.0f; } }
#endif
    __syncthreads();
}


__device__ __forceinline__ void attn_combine_phase(Frame& F) {
    const int lane = F.lane, wave = F.wave;
    const float B2 = attn_bound(F);
    const int gw = blockIdx.x * NWAVES + wave, NGW = F.G * NWAVES;
    LAS float* LO = (LAS float*)(F.lds + RING_OFF) + wave * 1024;
    const bf16* Qg = wsp<bf16>(F, WS_Q); const bf16* Kg = wsp<bf16>(F, WS_K); const bf16* CKV = wsp<bf16>(F, WS_CKV);
    const float* wuv = INP(I_WUV); const float* GG = wsp<float>(F, WS_GG);
    for (int j = gw; j < DEC_BATCH * NH; j += NGW) {
        const int db = j >> 3, h = j & 7;
        float ol[4][4], l[4];
#pragma unroll
        for (int q = 0; q < 4; ++q) { l[q] = 0.f;
#pragma unroll
            for (int i = 0; i < 4; ++i) ol[q][i] = 0.f; }
#pragma unroll
        for (int u = 0; u < SA_UNITS_PER_SEQ; ++u) {
            const float* part = wsp<float>(F, WS_SPART) + (size_t)(db * SA_UNITS_PER_SEQ + u) * SA_PART_STRIDE;
#pragma unroll
            for (int q = 0; q < 4; ++q) { l[q] += part[32 * 256 + 4 * h + q];
#pragma unroll
                for (int i = 0; i < 4; ++i) ol[q][i] += part[(4 * h + q) * 256 + lane + 64 * i]; }
        }
#pragma unroll
        for (int jn = 0; jn < 4; ++jn) {
            const size_t rk = (size_t)(MP + db * 4 + jn);
            const float kn = bf2f(Kg[rk * 768 + h * 96 + lane]); const float kr = (lane < 32) ? bf2f(Kg[rk * 768 + h * 96 + 64 + lane]) : 0.f;
            float c4[4];
#pragma unroll
            for (int i = 0; i < 4; ++i) c4[i] = bf2f(CKV[rk * 256 + lane + 64 * i]);
#pragma unroll
            for (int q = 0; q < 4; ++q) if (q >= jn) {
                const size_t rq = (size_t)(MP + db * 4 + q);
                const float qn = bf2f(Qg[rq * 768 + h * 96 + lane]); const float qr = (lane < 32) ? bf2f(Qg[rq * 768 + h * 96 + 64 + lane]) : 0.f;
                const float* sq = wsp<float>(F, WS_SSQQ) + rq * 16; const float rinvq = 1.0f / sqrtf((sq[h] + sq[8 + h]) * (1.0f / 96.0f) + EPS);
                const float s = wave_sum(qn * kn * GG[lane] + qr * kr * GG[64 + (lane & 31)]) * rinvq; const float p = __builtin_amdgcn_exp2f(s - B2);
                l[q] += p;
#pragma unroll
                for (int i = 0; i < 4; ++i) ol[q][i] += p * c4[i];
            }
        }
#pragma unroll
        for (int q = 0; q < 4; ++q)
#pragma unroll
            for (int i = 0; i < 4; ++i) LO[q * 256 + lane + 64 * i] = ol[q][i];
        LDS_WAIT(); asm volatile("" ::: "memory");
        float o[4] = {0.f, 0.f, 0.f, 0.f};
        for (int c0 = 0; c0 < KVLORA; c0 += 16) {
            float w[16];
#pragma unroll
            for (int cc = 0; cc < 16; ++cc) w[cc] = wuv[(size_t)(c0 + cc) * 512 + h * 64 + lane];
#pragma unroll
            for (int cc = 0; cc < 16; ++cc)
#pragma unroll
                for (int q = 0; q < 4; ++q) o[q] += LO[q * 256 + c0 + cc] * w[cc];
        }
#pragma unroll
        for (int q = 0; q < 4; ++q) wsp<bf16>(F, WS_O)[(size_t)(MP + db * 4 + q) * 512 + h * 64 + lane] = (bf16)f2bf(o[q] / l[q]);
        LDS_WAIT(); asm volatile("" ::: "memory");
    }
}
}
namespace mk {
struct Args { const float* in[26]; float* out; unsigned char* ws; int ph_lo, ph_hi, li, pad; };
#ifndef SA_VARIANT
#define SA_VARIANT 0
#endif
#ifndef REP_PHASE
#define REP_PHASE -1
#endif
#ifndef REP_COUNT
#define REP_COUNT 1
#endif
#define NREP(k) (((k) == REP_PHASE) ? REP_COUNT : 1)
enum { PH_PRO = 0, PH_INPROJ, PH_ROWA, PH_QKV, PH_ROWC, PH_ATTN, PH_COMB, PH_MERGE, PH_OUT, PH_GU, PH_DOWN, PH_N };

__global__ void __launch_bounds__(NTHREADS, 2) fused_fwd(Args args) {
    extern __shared__ __attribute__((aligned(16))) unsigned char lds[];
    Frame F;
    F.lds = (LAS unsigned char*)lds;
    F.MISC = (volatile LAS unsigned*)(F.lds + MISC_OFF);
    F.tid = threadIdx.x; F.lane = F.tid & 63; F.wave = __builtin_amdgcn_readfirstlane(F.tid >> 6);
    F.G = gridDim.x;
#pragma unroll
    for (int i = 0; i < 26; ++i) F.in[i] = args.in[i];
    F.out = args.out; F.ws = args.ws; F.ctl = (gu32*)(args.ws + WS_CTL);
    for (int u = F.tid; u < (LDS_BYTES - LDSCTL_OFF) / 4; u += NTHREADS) ((LAS unsigned*)(F.lds + LDSCTL_OFF))[u] = 0u;
    __syncthreads();
    XcdBarrier bar = xcd_barrier_post((unsigned*)(F.ctl + CW_BAR) + args.li * XCD_BAR_WORDS, F.MISC + 8);
    const int lo = args.ph_lo, hi = args.ph_hi;
#define IN(k) (lo <= (k) && (k) < hi)
#define SEAM(k) do { if (IN(k) && IN((k) + 1)) xcd_barrier(bar); } while (0)
#define PHASE_BEGIN() do { int t_; asm volatile("v_mbcnt_lo_u32_b32 %0, -1, 0\n\tv_mbcnt_hi_u32_b32 %0, -1, %0" : "=v"(t_)); F.lane = t_; F.tid = t_ + 64 * F.wave; } while (0)
    const int gw = blockIdx.x * NWAVES + F.wave, NGW = F.G * NWAVES;
    LAS unsigned char* ring = F.lds + RING_OFF;

    const int ip_rounds = (66 * 15 + F.G - 1) / F.G, ip_nfull = 66 * 15 - (ip_rounds - 1) * F.G; const bool late_in_ip = (F.G - ip_nfull >= 16) && IN(PH_INPROJ);
    if (IN(PH_PRO)) { PHASE_BEGIN(); p0_prologue(F, late_in_ip); }
    SEAM(PH_PRO);
    if (IN(PH_INPROJ)) { PHASE_BEGIN();
        pg8::Gemm g{wsp<bf16>(F, WS_H), wsp<bf16>(F, WS_WIN), M, NIN, 1024}; pg8::StaticOrder S; S.init(M, NIN, F.G, (int)blockIdx.x);
        EpiInProj E{wsp<bf16>(F, WS_U), wsp<bf16>(F, WS_G), wsp<bf16>(F, WS_RAW), F.out};
        pg8::gemm_phase<EpiInProj, pg8::StaticOrder, true, true>(ring, g, S, E, F.wave);
        if (late_in_ip && (int)blockIdx.x >= ip_nfull) { PHASE_BEGIN(); const int ci = (int)blockIdx.x - ip_nfull, nc = F.G - ip_nfull;
            p0_late(F, ci * NWAVES + F.wave, nc * NWAVES, ci * NTHREADS + F.tid, nc * NTHREADS); }
    }
    SEAM(PH_INPROJ);
    if (IN(PH_ROWA)) { PHASE_BEGIN();
        p2a_rows(F, gw, NGW);
        for (int it = blockIdx.x; it < CONV_ITEMS; it += F.G) conv_item(F, it);
    }
    SEAM(PH_ROWA);
    if (IN(PH_QKV)) { PHASE_BEGIN();
        const int sb = (int)blockIdx.x;
        const int xb = (F.G >= 214) ? 192 : 0, xe = sb - xb;
        { pg8::Gemm g{wsp<bf16>(F, WS_CQN), wsp<bf16>(F, WS_WUQ), M, NQP, 384}; QOrder S; S.init(F.G, sb, (xe >= 0 && xe < 6) ? xe : -1);
          EpiQ3 E{wsp<bf16>(F, WS_Q), wsp<float>(F, WS_SSQQ), wsp<float>(F, WS_TAB)}; pg8::gemm_phase<EpiQ3, QOrder, true, true>(ring, g, S, E, F.wave); }
        { pg8::Gemm g{wsp<bf16>(F, WS_CKV), wsp<bf16>(F, WS_WKV), M, 1024, 256}; ExtraOrder S; S.init(1024, F.G, sb, (xe >= 6 && xe < 14) ? xe - 6 : -1);
          EpiKV3 E{wsp<bf16>(F, WS_K), wsp<bf16>(F, WS_V), wsp<float>(F, WS_KPE), wsp<float>(F, WS_KPESSQ)}; pg8::gemm_phase<EpiKV3, ExtraOrder, true, true>(ring, g, S, E, F.wave); }
        { pg8::Gemm g{wsp<bf16>(F, WS_T), wsp<bf16>(F, WS_WC), M, 1024, 512}; ExtraOrder S; S.init(1024, F.G, sb, (xe >= 14 && xe < 22) ? xe - 14 : -1);
          EpiConv E{wsp<bf16>(F, WS_G), wsp<bf16>(F, WS_CONVO)}; pg8::gemm_phase<EpiConv, ExtraOrder, true, true>(ring, g, S, E, F.wave); }
        if (F.G > xb + 22) { if (sb >= xb + 22) { PHASE_BEGIN(); convert_weights<1>(F, (sb - xb - 22) * NWAVES + F.wave, (F.G - xb - 22) * NWAVES); } }
        else { PHASE_BEGIN(); convert_weights<1>(F, gw, NGW); }
    }
    SEAM(PH_QKV);
    if (IN(PH_ATTN)) { PHASE_BEGIN();
        attn_prompt_phase(F);
        PHASE_BEGIN(); attn_sample_phase<0>(F);
    }
    SEAM(PH_ATTN);
    if (IN(PH_COMB)) { PHASE_BEGIN(); attn_combine_phase(F); }
    SEAM(PH_COMB);
    if (IN(PH_MERGE)) { PHASE_BEGIN();
        pg8::Gemm g{wsp<bf16>(F, WS_O), wsp<bf16>(F, WS_WO), M, 1024, 512}; pg8::StaticOrder S; S.init(M, 1024, F.G, (int)blockIdx.x);
        EpiMerge E{wsp<bf16>(F, WS_G), wsp<bf16>(F, WS_CONVO), wsp<bf16>(F, WS_MERGED)}; pg8::gemm_phase<EpiMerge, pg8::StaticOrder, true, true>(ring, g, S, E, F.wave);
        { const int nfirst = (66 * 4 > F.G) ? 66 * 4 - F.G : 0;
          const int sb2 = (int)blockIdx.x;
          if (F.G > nfirst && nfirst < F.G) { if (sb2 >= nfirst) { PHASE_BEGIN(); convert_weights<2>(F, (sb2 - nfirst) * NWAVES + F.wave, (F.G - nfirst) * NWAVES); css_copy(F, (sb2 - nfirst) * NTHREADS + F.tid, (F.G - nfirst) * NTHREADS); } }
          else { PHASE_BEGIN(); convert_weights<2>(F, gw, NGW); css_copy(F, (int)blockIdx.x * NTHREADS + F.tid, F.G * NTHREADS); } }
    }
    SEAM(PH_MERGE);
    if (IN(PH_OUT)) { PHASE_BEGIN();
        { pg8::Gemm g{wsp<bf16>(F, WS_MERGED), wsp<bf16>(F, WS_WOUT), MP, 1024, 1024}; pg8::StaticOrder S; S.init(MP, 1024, F.G, (int)blockIdx.x);
          EpiOut E{INP(I_XP), INP(I_XS), F.out + O_YP, wsp<bf16>(F, WS_X1B), wsp<float>(F, WS_SSQ2)}; pg8::gemm_phase<EpiOut, pg8::StaticOrder, true, true>(ring, g, S, E, F.wave); }
        {
            const int sb = (int)blockIdx.x, ch = sb >> 3;
            pg8::Gemm g{wsp<bf16>(F, WS_MERGED) + (size_t)MP * 1024 + 256 * (ch & 3), wsp<bf16>(F, WS_WOUT) + 256 * (ch & 3), MS, 1024, 256, 1024, 1024}; ListOrder S{sb & 7, 4, sb < 8 * OUT_SPLIT ? 1 : 0};
            EpiPart E{wsp<float>(F, WS_PARTK) + (size_t)(ch & 3) * 512 * 1024}; pg8::gemm_phase<EpiPart, ListOrder, true, true>(ring, g, S, E, F.wave); }
        xcd_barrier(bar);
        PHASE_BEGIN();
        for (int r = gw; r < MS; r += NGW) fixup_out_row(F, r);
        rinvf_rows(F, (int)blockIdx.x * NTHREADS + F.tid, F.G * NTHREADS);
    }
    SEAM(PH_OUT);
    if (IN(PH_GU)) { PHASE_BEGIN();
        pg8::Gemm g{wsp<bf16>(F, WS_X1B), wsp<bf16>(F, WS_WGU), M, NGU, 1024}; pg8::StaticOrder S; S.init(M, NGU, F.G, (int)blockIdx.x);
        EpiGateUp E{wsp<float>(F, WS_RINVF), wsp<bf16>(F, WS_ACT)}; pg8::gemm_phase<EpiGateUp, pg8::StaticOrder, true, true>(ring, g, S, E, F.wave);
    }
    SEAM(PH_GU);
    if (IN(PH_DOWN)) { PHASE_BEGIN();
        { pg8::Gemm g{wsp<bf16>(F, WS_ACT), wsp<bf16>(F, WS_WD), MP, 1024, DFF}; pg8::StaticOrder S; S.init(MP, 1024, F.G, (int)blockIdx.x);
          EpiDown E{F.out + O_YP, wsp<bf16>(F, WS_X1B)}; pg8::gemm_phase<EpiDown, pg8::StaticOrder, true, true>(ring, g, S, E, F.wave); }
        {
            const int sb = (int)blockIdx.x; int ch = sb >> 3; if (ch >= DOWN_SPLIT) ch = 0;
            pg8::Gemm g{wsp<bf16>(F, WS_ACT) + (size_t)MP * DFF + 256 * ch, wsp<bf16>(F, WS_WD) + 256 * ch, MS, 1024, 256, DFF, DFF}; ListOrder S{sb & 7, 4, sb < 8 * DOWN_SPLIT ? 1 : 0};
            EpiPart E{wsp<float>(F, WS_PARTK) + (size_t)ch * 512 * 1024}; pg8::gemm_phase<EpiPart, ListOrder, true, true>(ring, g, S, E, F.wave); }
        xcd_barrier(bar);
        PHASE_BEGIN();
        for (int r = gw; r < MS; r += NGW) fixup_down_row(F, r);
    }
#undef IN
#undef SEAM
}

static int g_grid = 0;
inline bool setup_once() {
    if (g_grid == 0) {
        int dev = 0, cus = 0, per_cu = 0;
        if (hipGetDevice(&dev) != hipSuccess || hipDeviceGetAttribute(&cus, hipDeviceAttributeMultiprocessorCount, dev) != hipSuccess) { g_grid = -1; return false; }
        if (hipFuncSetAttribute((const void*)fused_fwd, hipFuncAttributeMaxDynamicSharedMemorySize, LDS_BYTES) != hipSuccess) { g_grid = -1; return false; }
        if (hipOccupancyMaxActiveBlocksPerMultiprocessor(&per_cu, (const void*)fused_fwd, NTHREADS, LDS_BYTES) != hipSuccess || per_cu < 1) { fprintf(stderr, "occupancy query says %d\n", per_cu); }
        (void)hipGetLastError();
        g_grid = cus;
    }
    return g_grid > 0;
}
inline void launch_phases(void* const* d_in, void* d_out, void* d_ws, hipStream_t stream, int lo, int hi, int li) {
    Args a{};
    for (int i = 0; i < 26; ++i) a.in[i] = (const float*)d_in[i];
    a.out = (float*)d_out; a.ws = (unsigned char*)d_ws; a.ph_lo = lo; a.ph_hi = hi; a.li = li; a.pad = 0;
    hipLaunchKernelGGL(fused_fwd, dim3(g_grid), dim3(NTHREADS), LDS_BYTES, stream, a);
}
}
extern "C" void kernel_launch(void* const* d_in, const int* in_sizes, int n_in, void* d_out, int out_size, void* d_ws, size_t ws_size, hipStream_t stream) {
    if (!mk::setup_once()) return;
    if (n_in != 26 || (size_t)out_size != mk::O_END || ws_size < mk::WS_END) { fprintf(stderr, "kernel_launch: unexpected shapes\n"); return; }
    if (hipMemsetAsync((char*)d_ws + mk::WS_CTL, 0, mk::CTL_ZERO_BYTES, stream) != hipSuccess) return;
    mk::launch_phases(d_in, d_out, d_ws, stream, 0, mk::PH_N, 0);
}
```

```cpp
#include <hip/hip_runtime.h>
#include <cstdio>
#include <cstdint>
#include <math.h>
#define MK_HAVE_ATTN 1
namespace pg8 {
#define PG8_LAS __attribute__((address_space(3)))
typedef unsigned short bf16_t;
typedef short bf16x8 __attribute__((ext_vector_type(8)));
typedef float f32x4 __attribute__((ext_vector_type(4)));
typedef unsigned u32x4 __attribute__((ext_vector_type(4)));
constexpr int BM = 256, BK = 64, HALF = 128, HTB = HALF * BK * 2  , STAGE_BYTES = 8 * HTB, NXCD = 8, WGM = 4;

__host__ __device__ __forceinline__ int lds_byte(int r, int c) { const int st = (r >> 4) * 2 + (c >> 5), rr = r & 15, cc = c & 31, ob = rr * 64 + cc * 2; return st * 1024 + (ob ^ (((ob >> 9) & 1) << 5)); }
__host__ __device__ __forceinline__ void stage_rc(int b, int& R, int& C) { const int st = b / 1024, sb = b % 1024, swz = sb ^ (((sb >> 9) & 1) << 5); R = (st >> 1) * 16 + swz / 64; C = (st & 1) * 32 + (swz % 64) / 2; }
__host__ __device__ __forceinline__ int perm32(int rho) { const int n = rho >> 4, i = rho & 15; return 8 * (i >> 2) + 4 * n + (i & 3); }

struct Unit { int pm, pn; };
struct Gemm { const bf16_t* A; const bf16_t* Bt; int M, N, K; int lda = 0, ldb = 0; };

struct StaticOrder {
    int nM, nN, nwg, G, c;
    __host__ __device__ void init(int M, int N, int G_, int c_) { nM = M / BM; nN = N / BM; nwg = nM * nN; G = G_; c = c_; }
    __host__ __device__ bool next(int i, Unit& u) const {
        const long L = (long)i * G + c; if (L >= nwg) return false;
        int wgid = (int)L; { const int q = nwg / NXCD, r = nwg % NXCD, xcd = wgid % NXCD, off = wgid / NXCD; wgid = (xcd < r ? xcd * (q + 1) : r * (q + 1) + (xcd - r) * q) + off; }
        const int nig = WGM * nN, gid = wgid / nig, fm = gid * WGM, gsz = (nM - fm) < WGM ? (nM - fm) : WGM;
        u.pm = fm + ((wgid % nig) % gsz); u.pn = (wgid % nig) / gsz; return true;
    }
    __device__ __forceinline__ void a_ready(const Unit&) const {}
    __device__ __forceinline__ void done(const Unit&) const {}
};

__device__ __forceinline__ unsigned cvt_pk_bf16(float lo, float hi) { unsigned r; asm volatile("v_cvt_pk_bf16_f32 %0, %1, %2" : "=v"(r) : "v"(lo), "v"(hi)); return r; }
typedef float f32x2 __attribute__((ext_vector_type(2)));
__device__ __forceinline__ f32x2 gelu_pk(f32x2 v) {
    const f32x2 av = __builtin_elementwise_abs(v), d = av * 0.2316418882f + 1.0f;
    f32x2 t; t.x = __builtin_amdgcn_rcpf(d.x); t.y = __builtin_amdgcn_rcpf(d.y);
    f32x2 q = t * 0.5307027145f + (-0.7265760135f); q = q * t + 0.7107068705f; q = q * t + (-0.142248368f); q = q * t + 0.127414796f; q = q * t;
    const f32x2 s = (v * v) * (-0.72134752044f);
    f32x2 e; e.x = __builtin_amdgcn_exp2f(s.x); e.y = __builtin_amdgcn_exp2f(s.y);
    const f32x2 m = v * (q * e), r = v - m;
    f32x2 o; o.x = v.x < 0.f ? m.x : r.x; o.y = v.y < 0.f ? m.y : r.y; return o;
}

template <int ACT  > struct EpiBf16 {
    static constexpr bool PERM = true, AFTER_DRAIN = false; static_assert(ACT == 0 || ACT == 1, "EpiBf16: ACT is 0 (none) or 1 (gelu_pk)");
    bf16_t* O; int ldc; const float* bias; int split_cols; size_t split_stride; float scale0;
    __device__ __forceinline__ void operator()(const f32x4 (&acc)[2][2][4][2], const Unit& u, int wr, int wc, int fr, int fq) const {
        const int row0 = u.pm * BM + wr * 64 + fr; int colt = u.pn * BM; bf16_t* base = O;
        float sc = 1.f; if (split_cols) { const int t = colt / split_cols; base += (size_t)t * split_stride; colt -= t * split_cols; if (t == 0) sc = scale0; }
        const int col0 = colt + wc * 32 + 8 * fq, bcol0 = u.pn * BM + wc * 32 + 8 * fq;
        f32x4 bv[2][2];
#pragma unroll
        for (int bj = 0; bj < 2; ++bj)
#pragma unroll
            for (int n = 0; n < 2; ++n) bv[bj][n] = bias ? *(const f32x4*)(bias + bcol0 + bj * HALF + 4 * n) : (f32x4){0.f, 0.f, 0.f, 0.f};
#pragma unroll
        for (int ai = 0; ai < 2; ++ai)
#pragma unroll
            for (int m = 0; m < 4; ++m) { bf16_t* rowp = base + (size_t)(row0 + ai * HALF + m * 16) * ldc + col0;
#pragma unroll
                for (int bj = 0; bj < 2; ++bj) { f32x4 v0 = acc[ai][bj][m][0] + bv[bj][0], v1 = acc[ai][bj][m][1] + bv[bj][1];
                    if (ACT == 1) { f32x2 a = gelu_pk((f32x2){v0[0], v0[1]}), b = gelu_pk((f32x2){v0[2], v0[3]}), c = gelu_pk((f32x2){v1[0], v1[1]}), d = gelu_pk((f32x2){v1[2], v1[3]});
                        v0 = (f32x4){a.x, a.y, b.x, b.y}; v1 = (f32x4){c.x, c.y, d.x, d.y}; }
                    v0 = v0 * sc; v1 = v1 * sc; u32x4 w; w.x = cvt_pk_bf16(v0[0], v0[1]); w.y = cvt_pk_bf16(v0[2], v0[3]); w.z = cvt_pk_bf16(v1[0], v1[1]); w.w = cvt_pk_bf16(v1[2], v1[3]);
                    *(u32x4*)(rowp + bj * HALF) = w; } }
    }
};

template <class Epi, class Sched, bool ALIGN_EPI = false, bool SP2 = false>
__device__ __forceinline__ void gemm_phase(PG8_LAS unsigned char* lds, const Gemm g, const Sched& S, const Epi& E, const int wave_in  ) {
    int tid_; asm volatile("v_mbcnt_lo_u32_b32 %0, -1, 0\n\tv_mbcnt_hi_u32_b32 %0, -1, %0" : "=v"(tid_)); tid_ += 64 * wave_in;
    const int tid = tid_, wid = __builtin_amdgcn_readfirstlane(tid >> 6), lane = tid & 63, wr = wid >> 2, wc = wid & 3, fr = lane & 15, fq = lane >> 4;
    const int K = g.K, nt = K / BK, lda = g.lda ? g.lda : K, ldb = g.ldb ? g.ldb : K;
    unsigned voffA[2], voffB[2];
#pragma unroll
    for (int i = 0; i < 2; ++i) { int R, C; stage_rc(tid * 16 + i * 8192, R, C); const int Rb = Epi::PERM ? ((R & ~31) + perm32(R & 31)) : R;
        voffA[i] = (unsigned)(R * lda + C) * 2u; voffB[i] = (unsigned)(Rb * ldb + C) * 2u; }
    const size_t kstep = (size_t)(BK * 2);
    const size_t hstepA = (size_t)HALF * lda * 2, hstepB = (size_t)HALF * ldb * 2;
    const size_t tstepA = 2 * hstepA, tstepB = 2 * hstepB;
    const unsigned ldsw = (unsigned)wid * 1024u;
    const int aoff = lds_byte(wr * 64 + fr, fq * 8), boff = lds_byte(wc * 32 + fr, fq * 8);
#define PG8_SA(b, h) (((b) * 2 + (h)) * HTB)
#define PG8_SB(b, h) ((4 + (b) * 2 + (h)) * HTB)
#define PG8_STAGE(bufoff, gbase, voff) do { _Pragma("unroll") for (int _i = 0; _i < 2; ++_i) \
        __builtin_amdgcn_global_load_lds((const unsigned*)((const char*)(gbase) + (voff)[_i]), (PG8_LAS unsigned*)(lds + (bufoff) + ldsw + _i * 8192), 16, 0, 0); } while (0)
#define PG8_LDA(dst, b, h) do { _Pragma("unroll") for (int m = 0; m < 4; ++m) _Pragma("unroll") for (int k = 0; k < 2; ++k) dst[m][k] = *(const PG8_LAS bf16x8*)(lds + PG8_SA(b, h) + aoff + m * 2048 + k * 1024); } while (0)
#define PG8_LDB(dst, b, h) do { _Pragma("unroll") for (int n = 0; n < 2; ++n) _Pragma("unroll") for (int k = 0; k < 2; ++k) dst[n][k] = *(const PG8_LAS bf16x8*)(lds + PG8_SB(b, h) + boff + n * 2048 + k * 1024); } while (0)
#define PG8_MMA(ai, bj, At, Bt) do { __builtin_amdgcn_s_setprio(1); _Pragma("unroll") for (int m = 0; m < 4; ++m) _Pragma("unroll") for (int n = 0; n < 2; ++n) _Pragma("unroll") for (int k = 0; k < 2; ++k) \
        acc[ai][bj][m][n] = __builtin_amdgcn_mfma_f32_16x16x32_bf16(Bt[n][k], At[m][k], acc[ai][bj][m][n], 0, 0, 0); __builtin_amdgcn_s_setprio(0); } while (0)
#define PG8_WAIT_V(n) asm volatile("s_waitcnt vmcnt(" #n ")" ::: "memory")
#define PG8_WAIT_L(n) asm volatile("s_waitcnt lgkmcnt(" #n ")" ::: "memory")
#define PG8_BAR __builtin_amdgcn_s_barrier()
#define PG8_SCHED __builtin_amdgcn_sched_barrier(0)
    Unit cur, nxt; int ui = 0;
    if (!S.next(0, cur)) return;
    f32x4 acc[2][2][4][2];
#pragma unroll
    for (int a = 0; a < 2; ++a)
#pragma unroll
        for (int b = 0; b < 2; ++b)
#pragma unroll
            for (int m = 0; m < 4; ++m)
#pragma unroll
                for (int n = 0; n < 2; ++n) acc[a][b][m][n] = (f32x4){0.f, 0.f, 0.f, 0.f};
    bf16x8 At[4][2], B0[2][2], B1[2][2];
    const char* cA = (const char*)g.A + (size_t)cur.pm * tstepA; const char* cB = (const char*)g.Bt + (size_t)cur.pn * tstepB;
    S.a_ready(cur);
    if constexpr (SP2) {
        PG8_STAGE(PG8_SB(0, 0), cB, voffB); PG8_STAGE(PG8_SB(0, 1), cB + hstepB, voffB); PG8_STAGE(PG8_SA(0, 0), cA, voffA); PG8_STAGE(PG8_SA(0, 1), cA + hstepA, voffA);
        if (wr == 1) PG8_BAR;
        PG8_WAIT_V(2); PG8_BAR;
        PG8_STAGE(PG8_SB(1, 0), cB + kstep, voffB); PG8_STAGE(PG8_SA(1, 0), cA + kstep, voffA); PG8_STAGE(PG8_SB(1, 1), cB + hstepB + kstep, voffB);
        PG8_WAIT_V(6); PG8_BAR;
    } else {
        PG8_STAGE(PG8_SB(0, 0), cB, voffB); PG8_STAGE(PG8_SA(0, 0), cA, voffA); PG8_STAGE(PG8_SB(0, 1), cB + hstepB, voffB); PG8_STAGE(PG8_SA(0, 1), cA + hstepA, voffA);
        if (wr == 1) PG8_BAR;
        PG8_WAIT_V(4); PG8_BAR;
        PG8_STAGE(PG8_SB(1, 0), cB + kstep, voffB); PG8_STAGE(PG8_SA(1, 0), cA + kstep, voffA); PG8_STAGE(PG8_SB(1, 1), cB + hstepB + kstep, voffB);
        PG8_WAIT_V(6); PG8_BAR;
    }
    for (;;) {
        const bool has_next = S.next(ui + 1, nxt);
        const char* nA = has_next ? (const char*)g.A + (size_t)nxt.pm * tstepA : cA; const char* nB = has_next ? (const char*)g.Bt + (size_t)nxt.pn * tstepB : cB;
        for (int t = 0; t < nt; t += 2) {
            const bool last = (t == nt - 2);
            const char* a1 = cA + (size_t)(t + 1) * kstep;
            const char* a2 = last ? nA : cA + (size_t)(t + 2) * kstep; const char* b2 = last ? nB : cB + (size_t)(t + 2) * kstep;
            const char* a3 = a2 + kstep; const char* b3 = b2 + kstep;
            if (last && has_next) S.a_ready(nxt);
            if constexpr (SP2) {
            PG8_LDB(B0, 0, 0); PG8_LDB(B1, 0, 1); PG8_SCHED; PG8_LDA(At, 0, 0); PG8_STAGE(PG8_SA(1, 1), a1 + hstepA, voffA);
            PG8_WAIT_V(8); PG8_WAIT_L(0); PG8_BAR; PG8_MMA(0, 0, At, B0); PG8_MMA(0, 1, At, B1); PG8_BAR; PG8_SCHED;
            PG8_LDA(At, 0, 1); PG8_STAGE(PG8_SB(0, 0), b2, voffB); PG8_STAGE(PG8_SB(0, 1), b2 + hstepB, voffB); PG8_STAGE(PG8_SA(0, 0), a2, voffA);
            PG8_WAIT_V(8); PG8_WAIT_L(0); PG8_BAR; PG8_MMA(1, 0, At, B0); PG8_MMA(1, 1, At, B1); PG8_BAR; PG8_SCHED;
            PG8_LDB(B0, 1, 0); PG8_LDB(B1, 1, 1); PG8_SCHED; PG8_LDA(At, 1, 0); PG8_STAGE(PG8_SA(0, 1), a2 + hstepA, voffA);
            PG8_WAIT_V(8); PG8_WAIT_L(0); PG8_BAR; PG8_MMA(0, 0, At, B0); PG8_MMA(0, 1, At, B1); PG8_BAR; PG8_SCHED;
            PG8_LDA(At, 1, 1); PG8_STAGE(PG8_SB(1, 0), b3, voffB); PG8_STAGE(PG8_SB(1, 1), b3 + hstepB, voffB); PG8_STAGE(PG8_SA(1, 0), a3, voffA);
            PG8_WAIT_V(8); PG8_WAIT_L(0); PG8_BAR; PG8_MMA(1, 0, At, B0); PG8_MMA(1, 1, At, B1); PG8_BAR; PG8_SCHED;
            } else {
            PG8_LDB(B0, 0, 0); PG8_SCHED; PG8_LDA(At, 0, 0); PG8_STAGE(PG8_SA(1, 1), a1 + hstepA, voffA);
            PG8_WAIT_L(8); PG8_BAR; PG8_WAIT_L(0); PG8_MMA(0, 0, At, B0); PG8_BAR; PG8_SCHED;
            PG8_LDB(B1, 0, 1); PG8_STAGE(PG8_SB(0, 0), b2, voffB);
            PG8_BAR; PG8_WAIT_L(0); PG8_MMA(0, 1, At, B1); PG8_BAR;
            PG8_LDA(At, 0, 1); PG8_STAGE(PG8_SA(0, 0), a2, voffA);
            PG8_BAR; PG8_WAIT_L(0); PG8_MMA(1, 0, At, B0); PG8_BAR; PG8_SCHED;
            PG8_STAGE(PG8_SB(0, 1), b2 + hstepB, voffB);
            PG8_WAIT_V(6); PG8_BAR; PG8_MMA(1, 1, At, B1); PG8_BAR;
            PG8_LDB(B0, 1, 0); PG8_SCHED; PG8_LDA(At, 1, 0); PG8_STAGE(PG8_SA(0, 1), a2 + hstepA, voffA);
            PG8_WAIT_L(8); PG8_BAR; PG8_WAIT_L(0); PG8_MMA(0, 0, At, B0); PG8_BAR; PG8_SCHED;
            PG8_LDB(B1, 1, 1); PG8_STAGE(PG8_SB(1, 0), b3, voffB);
            PG8_BAR; PG8_WAIT_L(0); PG8_MMA(0, 1, At, B1); PG8_BAR;
            PG8_LDA(At, 1, 1); PG8_STAGE(PG8_SA(1, 0), a3, voffA);
            PG8_BAR; PG8_WAIT_L(0); PG8_MMA(1, 0, At, B0); PG8_BAR; PG8_SCHED;
            PG8_STAGE(PG8_SB(1, 1), b3 + hstepB, voffB);
            PG8_WAIT_V(6); PG8_BAR; PG8_MMA(1, 1, At, B1); PG8_BAR;
            }
        }
        if constexpr (ALIGN_EPI) { if (wr == 0) PG8_BAR; }
        if constexpr (!Epi::AFTER_DRAIN) { E(acc, cur, wr, wc, fr, fq); S.done(cur); }
        if (!has_next) break;
#pragma unroll
        for (int a = 0; a < 2; ++a)
#pragma unroll
            for (int b = 0; b < 2; ++b)
#pragma unroll
                for (int m = 0; m < 4; ++m)
#pragma unroll
                    for (int n = 0; n < 2; ++n) acc[a][b][m][n] = (f32x4){0.f, 0.f, 0.f, 0.f};
        cur = nxt; cA = nA; cB = nB; ++ui;
        if constexpr (ALIGN_EPI) { if (wr == 1) PG8_BAR; }
    }
    PG8_WAIT_V(0);
    if constexpr (!ALIGN_EPI) { if (wr == 0) PG8_BAR; }
    PG8_BAR;
    if constexpr (Epi::AFTER_DRAIN) { E.fused(acc, cur, wr, wc, fr, fq, lds, wid, lane); S.done(cur); }
#undef PG8_SA
#undef PG8_SB
#undef PG8_STAGE
#undef PG8_LDA
#undef PG8_LDB
#undef PG8_MMA
#undef PG8_WAIT_V
#undef PG8_WAIT_L
#undef PG8_BAR
#undef PG8_SCHED
}
}
#define GAS __attribute__((address_space(1)))
#define LAS __attribute__((address_space(3)))
typedef unsigned short bf16;
typedef unsigned v4u __attribute__((ext_vector_type(4)));
typedef float f32x4 __attribute__((ext_vector_type(4)));
typedef short bf16x8 __attribute__((ext_vector_type(8)));
typedef GAS unsigned gu32;
typedef GAS unsigned long long gu64;
#define RLX_AGENT __ATOMIC_RELAXED, __HIP_MEMORY_SCOPE_AGENT
#define LDS_WAIT() asm volatile("s_waitcnt lgkmcnt(0)" ::: "memory")
#define VM_WAIT() asm volatile("s_waitcnt vmcnt(0)" ::: "memory")
__device__ __forceinline__ unsigned long long rt() { return __builtin_amdgcn_s_memrealtime(); }
__device__ __forceinline__ unsigned f2bf(float f) { unsigned u = __builtin_bit_cast(unsigned, f); return (u + 0x7fffu + ((u >> 16) & 1u)) >> 16; }
__device__ __forceinline__ unsigned pk2(float lo, float hi) { return f2bf(lo) | (f2bf(hi) << 16); }

#define XB_TMO      128
#define XB_XCNT(j)  (256  + 64 * (j))
#define XB_XSUB(j)  (1280 + 64 * (j))
#define XB_XGEN(j)  (2304 + 64 * (j))
#define XB_TOP      3328
#define XB_TOPGEN   3392
#define XCD_BAR_WORDS 3456
#define XB_SPIN_CAP (1u << 18)

__device__ __forceinline__ unsigned xb_ld(unsigned* p)              { return __hip_atomic_load(p, __ATOMIC_RELAXED, __HIP_MEMORY_SCOPE_AGENT); }
__device__ __forceinline__ unsigned xb_add(unsigned* p, unsigned v) { return __hip_atomic_fetch_add(p, v, __ATOMIC_RELAXED, __HIP_MEMORY_SCOPE_AGENT); }
__device__ __forceinline__ unsigned xb_xcc_id() { return (unsigned)__builtin_amdgcn_s_getreg((3 << 11) | 20) & 0xFu; }
#define XB_SPIN(cond, bar) do { unsigned _sp = 0; while (cond) { __builtin_amdgcn_s_sleep(1); \
    if ((++_sp & 255u) == 0u) { if (xb_ld(&(bar)[XB_TMO])) break; if (_sp > XB_SPIN_CAP) { atomicAdd(&(bar)[XB_TMO], 1u); break; } } } } while (0)

struct XcdBarrier {
    unsigned* bar; unsigned x;
    volatile LAS unsigned* st;
};

__device__ __forceinline__ XcdBarrier xcd_barrier_post(unsigned* bar, volatile LAS unsigned* st) {
    XcdBarrier b; b.bar = bar; b.x = xb_xcc_id(); b.st = st;
    if (threadIdx.x == 0) (void)xb_add(&bar[XB_XCNT(b.x)], 1u);
    return b;
}
__device__ __forceinline__ void xcd_barrier_complete(unsigned* bar, unsigned x, unsigned& nloc, unsigned& nx) {
    const unsigned G = gridDim.x * gridDim.y * gridDim.z;
    unsigned sum, cnt, mine, sp = 0u;
    for (;;) {
        sum = 0u; cnt = 0u; mine = 0u;
#pragma unroll
        for (unsigned j = 0; j < 16; ++j) { const unsigned c = xb_ld(&bar[XB_XCNT(j)]); sum += c; cnt += (c > 0u) ? 1u : 0u; mine = (j == x) ? c : mine; }
        if (sum == G) break;
        __builtin_amdgcn_s_sleep(1);
        if ((++sp & 255u) == 0u) { if (xb_ld(&bar[XB_TMO])) break; if (sp > XB_SPIN_CAP) { atomicAdd(&bar[XB_TMO], 1u); break; } }
    }
    nloc = mine > 0u ? mine : 1u; nx = cnt > 0u ? cnt : 1u;
}

__device__ __forceinline__ void xcd_barrier(const XcdBarrier& b) {
    asm volatile("s_waitcnt vmcnt(0)" ::: "memory");
    __syncthreads();
    if (threadIdx.x == 0) {
        unsigned* bar = b.bar;
        __builtin_amdgcn_s_waitcnt(0);
        unsigned nloc = b.st[0], nx = b.st[1];
        if (nloc == 0u) { xcd_barrier_complete(bar, b.x, nloc, nx); b.st[0] = nloc; b.st[1] = nx; }
        const unsigned old = xb_add(&bar[XB_XSUB(b.x)], 1u);
        const unsigned gen = old / nloc;
        if (old + 1u == (gen + 1u) * nloc) {
            __builtin_amdgcn_fence(__ATOMIC_RELEASE, "agent");
            asm volatile("s_waitcnt vmcnt(0)" ::: "memory");
            const unsigned og = xb_add(&bar[XB_TOP], 1u);
            const unsigned tg = og / nx;
            if (og + 1u == (tg + 1u) * nx) xb_add(&bar[XB_TOPGEN], 1u);
            else XB_SPIN(xb_ld(&bar[XB_TOPGEN]) == tg, bar);
            __builtin_amdgcn_fence(__ATOMIC_ACQUIRE, "agent");
            xb_add(&bar[XB_XGEN(b.x)], 1u);
            asm volatile("s_waitcnt vmcnt(0)" ::: "memory");
        } else {
            XB_SPIN(xb_ld(&bar[XB_XGEN(b.x)]) == gen, bar);
            __builtin_amdgcn_fence(__ATOMIC_ACQUIRE, "agent");
            asm volatile("s_waitcnt vmcnt(0)" ::: "memory");
        }
    }
    __syncthreads();
}
namespace mk {
constexpr int D_MODEL = 1024, BATCH = 4, SEQ = 4096, DEC_BATCH = 128, DEC_SEQ = 4, PAST = 8192, PAGE = 128, NPAGES = 64;
constexpr int NH = 8, NOPE = 64, ROPE = 32, QKH = 96, VH = 64, QLORA = 384, KVLORA = 256;
constexpr int DCONV = 512, CW = 31, DFF = 2816, DIN = 3744;
constexpr int MP = BATCH * SEQ, MS = DEC_BATCH * DEC_SEQ, M = MP + MS;
constexpr float EPS = 1e-6f;
constexpr float LOG2E = 1.4426950408889634f;
constexpr float QSCALE = 0.10206207261596577f * LOG2E;
constexpr size_t O_YP = 0, O_YS = O_YP + (size_t)MP * 1024, O_LATP = O_YS + (size_t)MS * 1024, O_KRP = O_LATP + (size_t)MP * 256,
                 O_CSP = O_KRP + (size_t)MP * 32, O_LATS = O_CSP + (size_t)BATCH * 30 * 512, O_KRS = O_LATS + (size_t)MS * 256,
                 O_CSS = O_KRS + (size_t)MS * 32, O_END = O_CSS + (size_t)DEC_BATCH * 30 * 512;
constexpr int NIN = 3840;
constexpr int NQP = 768;
constexpr int NGU = 2 * DFF;
constexpr int NPOS = SEQ + DEC_SEQ;

constexpr size_t al(size_t x) { return (x + 4095) / 4096 * 4096; }
constexpr size_t WS_CTL = 0, CTL_ZERO_BYTES = 1u << 20;
constexpr size_t WS_WIN = CTL_ZERO_BYTES;
constexpr size_t WS_WUQ = WS_WIN + al((size_t)NIN * 1024 * 2);
constexpr size_t WS_WKV = WS_WUQ + al((size_t)NQP * 384 * 2);
constexpr size_t WS_WC = WS_WKV + al((size_t)1024 * 256 * 2);
constexpr size_t WS_WO = WS_WC + al((size_t)1024 * 512 * 2);
constexpr size_t WS_WOUT = WS_WO + al((size_t)1024 * 512 * 2);
constexpr size_t WS_WGU = WS_WOUT + al((size_t)1024 * 1024 * 2);
constexpr size_t WS_WD = WS_WGU + al((size_t)NGU * 1024 * 2);
constexpr size_t WS_TAB = WS_WD + al((size_t)1024 * DFF * 2);
constexpr size_t WS_H = WS_TAB + al((size_t)NPOS * 32 * 4);
constexpr size_t WS_U = WS_H + al((size_t)M * 1024 * 2);
constexpr size_t WS_G = WS_U + al((size_t)M * 512 * 2);
constexpr size_t WS_RAW = WS_G + al((size_t)M * 2048 * 2);
constexpr size_t WS_CKV = WS_RAW + al((size_t)M * 768 * 4);
constexpr size_t WS_CQN = WS_CKV + al((size_t)M * 256 * 2);
constexpr size_t WS_KPE = WS_CQN + al((size_t)M * 384 * 2);
constexpr size_t WS_T = WS_KPE + al((size_t)M * 32 * 4);
constexpr size_t WS_QRAW = WS_T + al((size_t)M * 512 * 2);
constexpr size_t WS_KN = WS_QRAW + al((size_t)M * 1024 * 4);
constexpr size_t WS_V = WS_KN + al((size_t)M * 512 * 4);
constexpr size_t WS_Q = WS_V + al((size_t)M * 512 * 2);
constexpr size_t WS_K = WS_Q + al((size_t)M * 768 * 2);
constexpr size_t WS_O = WS_K + al((size_t)M * 768 * 2);
constexpr size_t WS_CONVO = WS_O + al((size_t)M * 512 * 2);
constexpr size_t WS_MERGED = WS_CONVO + al((size_t)M * 1024 * 2);
constexpr size_t WS_X1B = WS_MERGED + al((size_t)M * 1024 * 2);
constexpr size_t WS_SSQ2 = WS_X1B + al((size_t)M * 1024 * 2);
constexpr size_t WS_ACT = WS_SSQ2 + al((size_t)M * 16 * 4);
constexpr size_t WS_QLAT = WS_ACT + al((size_t)M * DFF * 2);
constexpr size_t WS_SPART = WS_QLAT + al((size_t)DEC_BATCH * 2 * 32 * 288 * 2);
constexpr size_t WS_WUK8_DECL = 0;
constexpr int SA_UNITS_PER_SEQ = 2; static_assert(SA_UNITS_PER_SEQ == 2, "WS_QLAT is sized for two units per sequence");
constexpr int SA_PART_STRIDE = 32 * 256 + 32;
constexpr size_t WS_WUK8 = WS_SPART + al((size_t)DEC_BATCH * SA_UNITS_PER_SEQ * SA_PART_STRIDE * 4);
constexpr size_t WS_PARTK = WS_WUK8 + al((size_t)512 * 256);
constexpr size_t WS_KPESSQ = WS_PARTK + al((size_t)11 * 512 * 1024 * 4);
constexpr size_t WS_SSQQ = WS_KPESSQ + al((size_t)M * 4);
constexpr size_t WS_GG = WS_SSQQ + al((size_t)M * 16 * 4);
constexpr size_t WS_RINVF = WS_GG + al(96 * 4);
constexpr size_t WS_END = WS_RINVF + al((size_t)M * 4);
constexpr int CW_BAR = 4096;
constexpr int CW_CFLAG = 32768;
constexpr int CW_QFLAG = 64;

constexpr int NWAVES = 8, NTHREADS = 512;
constexpr int RING_OFF = 0, RING_BYTES = 155648;
constexpr int LDSCTL_OFF = RING_BYTES, MISC_OFF = LDSCTL_OFF + 320;
constexpr int LDS_BYTES = 163840;

typedef unsigned u32x2 __attribute__((ext_vector_type(2)));
typedef float f32x2 __attribute__((ext_vector_type(2)));

__device__ __forceinline__ float bf2f(bf16 b) { return __uint_as_float((unsigned)b << 16); }
__device__ __forceinline__ float sigm(float x) { return __builtin_amdgcn_rcpf(1.0f + __builtin_amdgcn_exp2f(-x * LOG2E)); }
__device__ __forceinline__ float wave_sum(float v) {
#pragma unroll
    for (int o = 1; o < 64; o <<= 1) v += __shfl_xor(v, o);
    return v;
}
typedef __bf16 bf16x2_t __attribute__((ext_vector_type(2)));
__device__ __forceinline__ unsigned cvtpk(float lo, float hi) { f32x2 v = {lo, hi}; bf16x2_t b = __builtin_convertvector(v, bf16x2_t); return __builtin_bit_cast(unsigned, b); }
__device__ __forceinline__ v4u pack8(const f32x4 a, const f32x4 b) { v4u w; w.x = cvtpk(a[0], a[1]); w.y = cvtpk(a[2], a[3]); w.z = cvtpk(b[0], b[1]); w.w = cvtpk(b[2], b[3]); return w; }

struct Frame {
    LAS unsigned char* lds;
    volatile LAS unsigned* MISC;
    gu32* ctl;
    int tid, lane, wave, G;
    const float* in[26];
    float* out;
    unsigned char* ws;
};
#define INP(i) (F.in[i])
enum { I_XP = 0, I_XS, I_CLAT, I_CKPE, I_SCONV, I_PT, I_NMG, I_WIN, I_QAG, I_WUQ, I_KVG, I_WUK, I_WUV, I_QNG, I_KNG, I_WOM, I_CVW, I_CVB, I_LNG, I_LNB, I_WCO, I_WOUT, I_NFG, I_WG, I_WU, I_WDN };
template <class T> __device__ __forceinline__ T* wsp(const Frame& F, size_t off) { return (T*)(F.ws + off); }

__device__ __forceinline__ void tr_item(const float* Wc0, int ldw, const float* kscale, bf16* WTr0, int K, int k0, LAS float* scr, int lane) {
    float wv[32];
#pragma unroll
    for (int i = 0; i < 32; ++i) { const int kk = 2 * i + (lane >> 5); wv[i] = Wc0 ? Wc0[(size_t)(k0 + kk) * ldw + (lane & 31)] : 0.f; }
    if (kscale) {
#pragma unroll
        for (int i = 0; i < 32; ++i) wv[i] *= kscale[k0 + 2 * i + (lane >> 5)]; }
#pragma unroll
    for (int i = 0; i < 32; ++i) scr[(2 * i + (lane >> 5)) * 33 + (lane & 31)] = wv[i];
    LDS_WAIT(); asm volatile("" ::: "memory");
    const int c = lane & 7;
#pragma unroll
    for (int j = 0; j < 4; ++j) { const int n = (lane >> 3) + 8 * j; const LAS float* s = scr + (8 * c) * 33 + n;
        v4u o; o.x = pk2(s[0 * 33], s[1 * 33]); o.y = pk2(s[2 * 33], s[3 * 33]); o.z = pk2(s[4 * 33], s[5 * 33]); o.w = pk2(s[6 * 33], s[7 * 33]);
        *(GAS v4u*)(WTr0 + (size_t)n * K + k0 + 8 * c) = o; }
    LDS_WAIT(); asm volatile("" ::: "memory");
}
__device__ __forceinline__ int wuk_src_col(int n0) { const int t = n0 >> 8, bj = (n0 >> 7) & 1, wc = (n0 >> 5) & 3; return (4 * t + wc) * 64 + 32 * bj; }
__device__ __forceinline__ int wuq_src_col(int n0) { const int t = n0 >> 8, bj = (n0 >> 7) & 1, wc = (n0 >> 5) & 3;
    return (t < 2) ? (4 * t + wc) * 96 + 32 * bj : (2 * wc + bj) * 96 + 64; }
__device__ __forceinline__ int wkvt_row(int h, int d) { return 256 * (h >> 2) + 128 * (d >> 5) + 32 * (h & 3) + (d & 31); }
__device__ __forceinline__ int win_src_col(int n0) {
    if (n0 < 1024) { const int t = n0 >> 8, j = n0 & 255; return (j < 128) ? 128 * t + j : 512 + 128 * t + (j - 128); }
    if (n0 < 2048) return 1696 + (n0 - 1024);
    if (n0 < 3072) return 2720 + (n0 - 2048);
    if (n0 < 3328) return 1408 + (n0 - 3072);
    if (n0 < 3584) return 1024 + (n0 - 3328);
    if (n0 < 3712) return 1280 + (n0 - 3584);
    if (n0 < 3744) return 1664 + (n0 - 3712);
    return -1;
}
template <int SET> __device__ __forceinline__ void convert_weights(Frame& F, int gwl, int ngw) {
    LAS float* scr = (LAS float*)(F.lds + RING_OFF + F.wave * 16384);
    const int lane = F.lane;
    constexpr int I_A = 120 * 16, I_B = 24 * 6, I_C = 32 * 4, I_D = 32 * 8, I_E = 32 * 8, I_F = 32 * 16, I_G = 176 * 16, I_H = 32 * 44;
    if (SET == 0) {
        for (int it = gwl; it < I_A; it += ngw) { const int g = it / 16, kb = it % 16; const int sc = win_src_col(32 * g);
            tr_item(sc >= 0 ? INP(I_WIN) + sc : nullptr, DIN, INP(I_NMG), wsp<bf16>(F, WS_WIN) + (size_t)(32 * g) * 1024, 1024, 64 * kb, scr, lane); }
    } else if (SET == 3) {
        for (int it = gwl; it < I_B + I_C + I_D; it += ngw) {
            int r = it;
            if (r < I_B) { const int g = r / 6, kb = r % 6;
                tr_item(INP(I_WUQ) + wuq_src_col(32 * g), 768, INP(I_QAG), wsp<bf16>(F, WS_WUQ) + (size_t)(32 * g) * 384, 384, 64 * kb, scr, lane); continue; } r -= I_B;
            if (r < I_C) { const int g = r / 4, kb = r % 4;
                tr_item(g < 16 ? INP(I_WUK) + wuk_src_col(32 * g) : INP(I_WUV) + 32 * (g - 16), 512, nullptr, wsp<bf16>(F, WS_WKV) + (size_t)(32 * g) * 256, 256, 64 * kb, scr, lane); continue; } r -= I_C;
            { const int g = r / 8, kb = r % 8;
                tr_item(INP(I_WCO) + 32 * g, 1024, nullptr, wsp<bf16>(F, WS_WC) + (size_t)(32 * g) * 512, 512, 64 * kb, scr, lane); }
        }
    } else if (SET == 1) {
        for (int it = gwl; it < I_E + I_F; it += ngw) {
            int r = it;
            if (r < I_E) { const int g = r / 8, kb = r % 8;
                tr_item(INP(I_WOM) + 32 * g, 1024, nullptr, wsp<bf16>(F, WS_WO) + (size_t)(32 * g) * 512, 512, 64 * kb, scr, lane); continue; } r -= I_E;
            { const int g = r / 16, kb = r % 16;
                tr_item(INP(I_WOUT) + 32 * g, 1024, nullptr, wsp<bf16>(F, WS_WOUT) + (size_t)(32 * g) * 1024, 1024, 64 * kb, scr, lane); }
        }
    } else {
        for (int it = gwl; it < I_G + I_H; it += ngw) {
            int r = it;
            if (r < I_G) { const int g = r / 16, kb = r % 16; const int n0 = 32 * g, t = n0 >> 8, j = n0 & 255;
                tr_item(j < 128 ? INP(I_WG) + 128 * t + j : INP(I_WU) + 128 * t + (j - 128), DFF, INP(I_NFG), wsp<bf16>(F, WS_WGU) + (size_t)n0 * 1024, 1024, 64 * kb, scr, lane); continue; } r -= I_G;
            { const int g = r / 44, kb = r % 44;
                tr_item(INP(I_WDN) + 32 * g, 1024, nullptr, wsp<bf16>(F, WS_WD) + (size_t)(32 * g) * DFF, DFF, 64 * kb, scr, lane); }
        }
    }
}
__device__ __forceinline__ void css_copy(Frame& F, int first, int T) {
    const f32x4* src = (const f32x4*)INP(I_SCONV); f32x4* dst = (f32x4*)(F.out + O_CSS);
    const int total = DEC_BATCH * 26 * 128;
#pragma unroll 1
    for (int i0 = first; i0 < total; i0 += 4 * T) {
        f32x4 v[4];
#pragma unroll
        for (int k = 0; k < 4; ++k) { const int idx = i0 + k * T; if (idx < total) { const int db = idx / (26 * 128), rem = idx % (26 * 128); v[k] = src[(size_t)db * 30 * 128 + 4 * 128 + rem]; } }
#pragma unroll
        for (int k = 0; k < 4; ++k) { const int idx = i0 + k * T; if (idx < total) { const int db = idx / (26 * 128), rem = idx % (26 * 128); dst[(size_t)db * 30 * 128 + rem] = v[k]; } } }
}
__device__ __forceinline__ void p0_late(Frame& F, int gwl, int ngw, int t0, int nt);
__device__ __forceinline__ void p0_prologue(Frame& F, bool late_elsewhere) {
    const int gw = blockIdx.x * NWAVES + F.wave, NGW = F.G * NWAVES, lane = F.lane;
    convert_weights<0>(F, gw, NGW);
    bf16* H = wsp<bf16>(F, WS_H);
#pragma unroll 1
    for (int m0 = gw; m0 < M; m0 += 5 * NGW) {
        f32x4 v[5][4]; int mr[5];
#pragma unroll
        for (int k = 0; k < 5; ++k) { const int mk = m0 + k * NGW; mr[k] = (mk < M) ? mk : m0;
            const float* x = (mr[k] < MP) ? INP(I_XP) + (size_t)mr[k] * 1024 : INP(I_XS) + (size_t)(mr[k] - MP) * 1024;
#pragma unroll
            for (int j = 0; j < 4; ++j) v[k][j] = ((const GAS f32x4*)x)[lane + 64 * j]; }
#pragma unroll
        for (int k = 0; k < 5; ++k) {
            float s = 0.f;
#pragma unroll
            for (int j = 0; j < 4; ++j) s += (v[k][j].x * v[k][j].x + v[k][j].y * v[k][j].y) + (v[k][j].z * v[k][j].z + v[k][j].w * v[k][j].w);
#pragma unroll
            for (int o = 1; o < 64; o <<= 1) s += __shfl_xor(s, o);
            const float r = 1.0f / sqrtf(s * (1.0f / 1024.0f) + EPS);
            if (m0 + k * NGW < M) { GAS unsigned long long* op = (GAS unsigned long long*)(H + (size_t)mr[k] * 1024) + lane;
#pragma unroll
                for (int j = 0; j < 4; ++j) op[64 * j] = (unsigned long long)pk2(v[k][j].x * r, v[k][j].y * r) | ((unsigned long long)pk2(v[k][j].z * r, v[k][j].w * r) << 32); }
        }
    }
    if (!late_elsewhere) p0_late(F, gw, NGW, blockIdx.x * NTHREADS + F.tid, F.G * NTHREADS);
}
__device__ __forceinline__ void p0_late(Frame& F, int gwl, int ngw, int t0, int nt) {
    convert_weights<3>(F, gwl, ngw);
    { unsigned* W8 = wsp<unsigned>(F, WS_WUK8);
      for (int idx = t0; idx < 64 * 512; idx += nt) { const int cg = idx >> 9, n = idx & 511; const float* w = INP(I_WUK) + (size_t)(4 * cg) * 512 + n;
          int p = 0; p = __builtin_amdgcn_cvt_pk_fp8_f32(16.0f * w[0], 16.0f * w[512], p, false); p = __builtin_amdgcn_cvt_pk_fp8_f32(16.0f * w[1024], 16.0f * w[1536], p, true);
          W8[n * 64 + cg] = (unsigned)p; } }
    if (t0 < 96) { const int dm = (t0 < 64) ? t0 : 64 + ((t0 - 64) & 15); wsp<float>(F, WS_GG)[t0] = INP(I_QNG)[dm] * INP(I_KNG)[dm] * QSCALE; }
    float* TAB = wsp<float>(F, WS_TAB);
    for (int idx = t0; idx < NPOS * 16; idx += nt) {
        const int p = idx >> 4, j = idx & 15; const int pos = (p < SEQ) ? p : PAST + (p - SEQ);
        const float invf = 1.0f / powf(10000.0f, (float)(2 * j) / 32.0f);
        const float angf = (float)pos * invf;
        float sn_, cs_; sincosf(angf, &sn_, &cs_);
        TAB[p * 32 + j] = cs_; TAB[p * 32 + 16 + j] = sn_;
    }
}

__device__ __forceinline__ int pos_index(int row) { return row < MP ? (row & (SEQ - 1)) : SEQ + ((row - MP) & 3); }
#define EPI_FOR_ROWS _Pragma("unroll") for (int ai = 0; ai < 2; ++ai) _Pragma("unroll") for (int m = 0; m < 4; ++m)
#define EPI_ROW (row0 + u.pm * 256 + ai * 128 + wr * 64 + m * 16 + fr)
#define EPI_ROW_OPAQUE (rbase + ai * 128 + wr * 64 + m * 16 + fr)
struct EpiInProj {
    static constexpr bool PERM = true, AFTER_DRAIN = false;
    bf16* U; bf16* G; bf16* RAW; float* out; int row0 = 0;
    __device__ __forceinline__ void operator()(const f32x4 (&acc)[2][2][4][2], const pg8::Unit& u, int wr, int wc, int fr, int fq) const {
        const int cb = wc * 32 + 8 * fq;
        if (u.pn < 4) {
            const int ch = 128 * u.pn + cb;
            EPI_FOR_ROWS { const int row = EPI_ROW;
                f32x4 r0, r1;
#pragma unroll
                for (int e = 0; e < 4; ++e) { r0[e] = acc[ai][0][m][0][e] * sigm(acc[ai][1][m][0][e]); r1[e] = acc[ai][0][m][1][e] * sigm(acc[ai][1][m][1][e]); }
                *(v4u*)(U + (size_t)row * 512 + ch) = pack8(r0, r1);
                float* cs = nullptr;
                if (row < MP) { const int t = row & (SEQ - 1); if (t >= SEQ - 30) cs = out + O_CSP + ((size_t)(row >> 12) * 30 + (t - (SEQ - 30))) * 512 + ch; }
                else { const int rs = row - MP; cs = out + O_CSS + ((size_t)(rs >> 2) * 30 + 26 + (rs & 3)) * 512 + ch; }
                if (cs) { *(f32x4*)cs = r0; *(f32x4*)(cs + 4) = r1; }
            }
        } else if (u.pn < 12) {
            const int col = 256 * (u.pn - 4) + cb;
            EPI_FOR_ROWS { const int row = EPI_ROW;
#pragma unroll
                for (int bj = 0; bj < 2; ++bj) { f32x4 r0, r1;
#pragma unroll
                    for (int e = 0; e < 4; ++e) { r0[e] = sigm(acc[ai][bj][m][0][e]); r1[e] = sigm(acc[ai][bj][m][1][e]); }
                    *(v4u*)(G + (size_t)row * 2048 + col + 128 * bj) = pack8(r0, r1); }
            }
        } else {
            const int col = 256 * (u.pn - 12) + cb;
            EPI_FOR_ROWS { const int row = EPI_ROW;
#pragma unroll
                for (int bj = 0; bj < 2; ++bj) *(v4u*)(RAW + (size_t)row * 768 + col + 128 * bj) = pack8(acc[ai][bj][m][0], acc[ai][bj][m][1]);
            }
        }
    }
};
struct EpiF32 {
    static constexpr bool PERM = true, AFTER_DRAIN = false;
    float* C; int ldc; int row0 = 0;
    __device__ __forceinline__ void operator()(const f32x4 (&acc)[2][2][4][2], const pg8::Unit& u, int wr, int wc, int fr, int fq) const {
        const int col = 256 * u.pn + wc * 32 + 8 * fq;
        EPI_FOR_ROWS { const int row = EPI_ROW;
#pragma unroll
            for (int bj = 0; bj < 2; ++bj) { float* p = C + (size_t)row * ldc + col + 128 * bj; *(f32x4*)p = acc[ai][bj][m][0]; *(f32x4*)(p + 4) = acc[ai][bj][m][1]; }
        }
    }
};
struct EpiKV {
    static constexpr bool PERM = true, AFTER_DRAIN = false;
    float* KN; bf16* V; int row0 = 0;
    __device__ __forceinline__ void operator()(const f32x4 (&acc)[2][2][4][2], const pg8::Unit& u, int wr, int wc, int fr, int fq) const {
        const int col = 256 * (u.pn & 1) + wc * 32 + 8 * fq;
        if (u.pn < 2) {
            EPI_FOR_ROWS { const int row = EPI_ROW;
#pragma unroll
                for (int bj = 0; bj < 2; ++bj) { float* p = KN + (size_t)row * 512 + col + 128 * bj; *(f32x4*)p = acc[ai][bj][m][0]; *(f32x4*)(p + 4) = acc[ai][bj][m][1]; }
            }
        } else {
            EPI_FOR_ROWS { const int row = EPI_ROW;
#pragma unroll
                for (int bj = 0; bj < 2; ++bj) *(v4u*)(V + (size_t)row * 512 + col + 128 * bj) = pack8(acc[ai][bj][m][0], acc[ai][bj][m][1]);
            }
        }
    }
};
__device__ __forceinline__ void unpack8(const v4u w, float (&f)[8]) {
    f[0] = __uint_as_float(w.x << 16); f[1] = __uint_as_float(w.x & 0xffff0000u); f[2] = __uint_as_float(w.y << 16); f[3] = __uint_as_float(w.y & 0xffff0000u);
    f[4] = __uint_as_float(w.z << 16); f[5] = __uint_as_float(w.z & 0xffff0000u); f[6] = __uint_as_float(w.w << 16); f[7] = __uint_as_float(w.w & 0xffff0000u);
}
struct EpiConv {
    static constexpr bool PERM = true, AFTER_DRAIN = false;
    const bf16* G; bf16* CONVO; int row0 = 0;
    __device__ __forceinline__ void operator()(const f32x4 (&acc)[2][2][4][2], const pg8::Unit& u, int wr, int wc, int fr, int fq) const {
        const int col = 256 * u.pn + wc * 32 + 8 * fq;
        v4u gw[2][4][2];
        EPI_FOR_ROWS { const int row = EPI_ROW;
#pragma unroll
            for (int bj = 0; bj < 2; ++bj) gw[ai][m][bj] = *(const v4u*)(G + (size_t)row * 2048 + col + 128 * bj); }
        EPI_FOR_ROWS { const int row = EPI_ROW;
#pragma unroll
            for (int bj = 0; bj < 2; ++bj) { float g[8]; unpack8(gw[ai][m][bj], g);
                f32x4 r0, r1;
#pragma unroll
                for (int e = 0; e < 4; ++e) { r0[e] = acc[ai][bj][m][0][e] * g[e]; r1[e] = acc[ai][bj][m][1][e] * g[4 + e]; }
                *(v4u*)(CONVO + (size_t)row * 1024 + col + 128 * bj) = pack8(r0, r1); }
        }
    }
};
struct EpiMerge {
    static constexpr bool PERM = true, AFTER_DRAIN = false;
    const bf16* G; const bf16* CONVO; bf16* MERGED; int row0 = 0;
    __device__ __forceinline__ void operator()(const f32x4 (&acc)[2][2][4][2], const pg8::Unit& u, int wr, int wc, int fr, int fq) const {
        const int col = 256 * u.pn + wc * 32 + 8 * fq;
#pragma unroll
        for (int ai = 0; ai < 2; ++ai) {
            v4u gw[4][2], cw[4][2];
#pragma unroll
            for (int m = 0; m < 4; ++m) { const int row = EPI_ROW;
#pragma unroll
                for (int bj = 0; bj < 2; ++bj) { gw[m][bj] = *(const v4u*)(G + (size_t)row * 2048 + 1024 + col + 128 * bj); cw[m][bj] = *(const v4u*)(CONVO + (size_t)row * 1024 + col + 128 * bj); } }
#pragma unroll
            for (int m = 0; m < 4; ++m) { const int row = EPI_ROW;
#pragma unroll
                for (int bj = 0; bj < 2; ++bj) { float g[8], cv[8]; unpack8(gw[m][bj], g); unpack8(cw[m][bj], cv);
                    f32x4 r0, r1;
#pragma unroll
                    for (int e = 0; e < 4; ++e) { r0[e] = cv[e] + acc[ai][bj][m][0][e] * g[e]; r1[e] = cv[4 + e] + acc[ai][bj][m][1][e] * g[4 + e]; }
                    *(v4u*)(MERGED + (size_t)row * 1024 + col + 128 * bj) = pack8(r0, r1); } }
        }
    }
};
struct EpiOut {
    static constexpr bool PERM = true, AFTER_DRAIN = false;
    const float* xp; const float* xs; float* Y; bf16* X1B; float* SSQ2; int row0 = 0;
    __device__ __forceinline__ void operator()(const f32x4 (&acc)[2][2][4][2], const pg8::Unit& u, int wr, int wc, int fr, int fq) const {
        const int col = 256 * u.pn + wc * 32 + 8 * fq;
#pragma unroll
        for (int ai = 0; ai < 2; ++ai) {
            f32x4 xv[4][2][2];
#pragma unroll
            for (int m = 0; m < 4; ++m) { const int row = EPI_ROW;
                const float* xrow = (row < MP) ? xp + (size_t)row * 1024 : xs + (size_t)(row - MP) * 1024;
#pragma unroll
                for (int bj = 0; bj < 2; ++bj) { xv[m][bj][0] = *(const f32x4*)(xrow + col + 128 * bj); xv[m][bj][1] = *(const f32x4*)(xrow + col + 128 * bj + 4); } }
#pragma unroll
            for (int m = 0; m < 4; ++m) { const int row = EPI_ROW;
                float ss = 0.f;
#pragma unroll
                for (int bj = 0; bj < 2; ++bj) {
                    const f32x4 r0 = xv[m][bj][0] + acc[ai][bj][m][0], r1 = xv[m][bj][1] + acc[ai][bj][m][1];
                    *(v4u*)(X1B + (size_t)row * 1024 + col + 128 * bj) = pack8(r0, r1);
                    ss += (r0[0] * r0[0] + r0[1] * r0[1]) + (r0[2] * r0[2] + r0[3] * r0[3]) + (r1[0] * r1[0] + r1[1] * r1[1]) + (r1[2] * r1[2] + r1[3] * r1[3]); }
                ss += __shfl_xor(ss, 16); ss += __shfl_xor(ss, 32);
                if (fq == 0) SSQ2[(size_t)row * 16 + 4 * u.pn + wc] = ss;
            }
        }
    }
};
struct EpiGateUp {
    static constexpr bool PERM = true, AFTER_DRAIN = false;
    const float* RINVF; bf16* ACT; int row0 = 0;
    __device__ __forceinline__ void operator()(const f32x4 (&acc)[2][2][4][2], const pg8::Unit& u, int wr, int wc, int fr, int fq) const {
        const int ch = 128 * u.pn + wc * 32 + 8 * fq;
        float rv[2][4];
        EPI_FOR_ROWS { const int row = EPI_ROW; rv[ai][m] = RINVF[row]; }
        EPI_FOR_ROWS { const int row = EPI_ROW;
            const float rinv = rv[ai][m];
            f32x4 r0, r1;
#pragma unroll
            for (int e = 0; e < 4; ++e) { const float g0 = acc[ai][0][m][0][e] * rinv, u0 = acc[ai][1][m][0][e] * rinv, g1 = acc[ai][0][m][1][e] * rinv, u1 = acc[ai][1][m][1][e] * rinv;
                r0[e] = g0 * sigm(g0) * u0; r1[e] = g1 * sigm(g1) * u1; }
            *(v4u*)(ACT + (size_t)row * DFF + ch) = pack8(r0, r1);
        }
    }
};
struct EpiDown {
    static constexpr bool PERM = true, AFTER_DRAIN = false;
    float* Y; const bf16* X1B; int row0 = 0;
    __device__ __forceinline__ void operator()(const f32x4 (&acc)[2][2][4][2], const pg8::Unit& u, int wr, int wc, int fr, int fq) const {
        const int col = 256 * u.pn + wc * 32 + 8 * fq;
        v4u xw[2][4][2];
        EPI_FOR_ROWS { const int row = EPI_ROW;
#pragma unroll
            for (int bj = 0; bj < 2; ++bj) xw[ai][m][bj] = *(const v4u*)(X1B + (size_t)row * 1024 + col + 128 * bj); }
        EPI_FOR_ROWS { const int row = EPI_ROW;
#pragma unroll
            for (int bj = 0; bj < 2; ++bj) { float* yp = Y + (size_t)row * 1024 + col + 128 * bj; float f[8]; unpack8(xw[ai][m][bj], f);
                *(f32x4*)yp = (f32x4){f[0], f[1], f[2], f[3]} + acc[ai][bj][m][0]; *(f32x4*)(yp + 4) = (f32x4){f[4], f[5], f[6], f[7]} + acc[ai][bj][m][1]; }
        }
    }
};

__device__ __forceinline__ float sum_fq(float v) {
    v += __uint_as_float(__builtin_amdgcn_ds_swizzle(__float_as_uint(v), 0x401F));
    const auto r = __builtin_amdgcn_permlane32_swap(__float_as_uint(v), __float_as_uint(v), false, false);
    return __uint_as_float(r[0]) + __uint_as_float(r[1]);
}
__device__ __forceinline__ float other_half(float v, bool upper) {
    const auto r = __builtin_amdgcn_permlane32_swap(__float_as_uint(v), __float_as_uint(v), false, false);
    return __uint_as_float(upper ? r[0] : r[1]);
}
struct EpiQ3 {
    static constexpr bool PERM = true, AFTER_DRAIN = false;
    bf16* Q; float* SSQQ; const float* TAB; int row0 = 0;
    __device__ __forceinline__ void operator()(const f32x4 (&acc)[2][2][4][2], const pg8::Unit& u, int wr, int wc, int fr_in, int fq_in) const {
        int ln_; asm volatile("v_mbcnt_lo_u32_b32 %0, -1, 0\n\tv_mbcnt_hi_u32_b32 %0, -1, %0" : "=v"(ln_)); const int fr = ln_ & 15, fq = ln_ >> 4; (void)fr_in; (void)fq_in;
        int rbase = row0 + u.pm * 256; asm volatile("" : "+s"(rbase));
        if (u.pn < 2) {
            const int head = 4 * u.pn + wc;
            EPI_FOR_ROWS { const int row = EPI_ROW_OPAQUE;
                float ss = 0.f;
#pragma unroll
                for (int bj = 0; bj < 2; ++bj) { const f32x4 a = acc[ai][bj][m][0], b = acc[ai][bj][m][1];
                    ss += ((a[0] * a[0] + a[1] * a[1]) + (a[2] * a[2] + a[3] * a[3])) + ((b[0] * b[0] + b[1] * b[1]) + (b[2] * b[2] + b[3] * b[3]));
                    *(v4u*)((char*)Q + (unsigned)(__mul24(row, 1536) + (head * 96 + 32 * bj + 8 * fq) * 2)) = pack8(a, b); }
                ss = sum_fq(ss);
                if (fq == 0) *(float*)((char*)SSQQ + (unsigned)(row * 64 + head * 4)) = ss;
                asm volatile("" ::: "memory"); __builtin_amdgcn_sched_barrier(0);
            }
        } else {
            const int e0 = 8 * (fq & 1);
#pragma unroll
            for (int ai = 0; ai < 2; ++ai) {
                f32x4 tc0[4], tc1[4], ts0[4], ts1[4];
#pragma unroll
                for (int m = 0; m < 4; ++m) { const int row = EPI_ROW_OPAQUE;
                    const float* tb = (const float*)((const char*)TAB + (unsigned)(pos_index(row) * 128 + e0 * 4));
                    tc0[m] = *(const f32x4*)tb; tc1[m] = *(const f32x4*)(tb + 4); ts0[m] = *(const f32x4*)(tb + 16); ts1[m] = *(const f32x4*)(tb + 20); }
#pragma unroll
                for (int m = 0; m < 4; ++m) { const int row = EPI_ROW_OPAQUE;
                    const f32x4 c0 = tc0[m], c1 = tc1[m], s0 = ts0[m], s1 = ts1[m];
#pragma unroll
                    for (int bj = 0; bj < 2; ++bj) { f32x4 a = acc[ai][bj][m][0], b = acc[ai][bj][m][1];
                        float ss = ((a[0] * a[0] + a[1] * a[1]) + (a[2] * a[2] + a[3] * a[3])) + ((b[0] * b[0] + b[1] * b[1]) + (b[2] * b[2] + b[3] * b[3]));
                        ss = sum_fq(ss);
                        if (fq == 0) *(float*)((char*)SSQQ + (unsigned)(row * 64 + (8 + 2 * wc + bj) * 4)) = ss;
                        f32x4 oa, ob;
#pragma unroll
                        for (int e = 0; e < 4; ++e) { oa[e] = other_half(a[e], fq >= 2); ob[e] = other_half(b[e], fq >= 2); }
                        if (fq < 2) { a = a * c0 - oa * s0; b = b * c1 - ob * s1; } else { a = a * c0 + oa * s0; b = b * c1 + ob * s1; }
                        *(v4u*)((char*)Q + (unsigned)(__mul24(row, 1536) + ((2 * wc + bj) * 96 + 64 + 8 * fq) * 2)) = pack8(a, b); }
                }
                asm volatile("" ::: "memory"); __builtin_amdgcn_sched_barrier(0);
            }
        }
    }
};
struct EpiKV3 {
    static constexpr bool PERM = true, AFTER_DRAIN = false;
    bf16* K; bf16* V; const float* KPE; const float* KPESSQ; int row0 = 0;
    __device__ __forceinline__ void operator()(const f32x4 (&acc)[2][2][4][2], const pg8::Unit& u, int wr, int wc, int fr_in, int fq_in) const {
        int ln_; asm volatile("v_mbcnt_lo_u32_b32 %0, -1, 0\n\tv_mbcnt_hi_u32_b32 %0, -1, %0" : "=v"(ln_)); const int fr = ln_ & 15, fq = ln_ >> 4; (void)fr_in; (void)fq_in;
        int rbase = row0 + u.pm * 256; asm volatile("" : "+s"(rbase));
        if (u.pn >= 2) {
            const int col = 256 * (u.pn & 1) + wc * 32 + 8 * fq;
            EPI_FOR_ROWS { const int row = EPI_ROW_OPAQUE;
#pragma unroll
                for (int bj = 0; bj < 2; ++bj) *(v4u*)((char*)V + (unsigned)(row * 1024 + (col + 128 * bj) * 2)) = pack8(acc[ai][bj][m][0], acc[ai][bj][m][1]);
            }
            return;
        }
        const int head = 4 * u.pn + wc;
#pragma unroll
        for (int ai = 0; ai < 2; ++ai) {
            float kq[4]; f32x4 kv0[4], kv1[4];
#pragma unroll
            for (int m = 0; m < 4; ++m) { const int row = EPI_ROW_OPAQUE;
                kq[m] = *(const float*)((const char*)KPESSQ + (unsigned)(row * 4));
                const float* kp = (const float*)((const char*)KPE + (unsigned)(row * 128 + 32 * fq)); kv0[m] = *(const f32x4*)kp; kv1[m] = *(const f32x4*)(kp + 4); }
#pragma unroll
            for (int m = 0; m < 4; ++m) { const int row = EPI_ROW_OPAQUE;
                float ss = 0.f;
#pragma unroll
                for (int bj = 0; bj < 2; ++bj) { const f32x4 a = acc[ai][bj][m][0], b = acc[ai][bj][m][1];
                    ss += ((a[0] * a[0] + a[1] * a[1]) + (a[2] * a[2] + a[3] * a[3])) + ((b[0] * b[0] + b[1] * b[1]) + (b[2] * b[2] + b[3] * b[3])); }
                ss = sum_fq(ss);
                const float rinv = 1.0f / sqrtf((ss + kq[m]) * (1.0f / 96.0f) + EPS);
#pragma unroll
                for (int bj = 0; bj < 2; ++bj) *(v4u*)((char*)K + (unsigned)(__mul24(row, 1536) + (head * 96 + 32 * bj + 8 * fq) * 2)) = pack8(acc[ai][bj][m][0] * rinv, acc[ai][bj][m][1] * rinv);
                *(v4u*)((char*)K + (unsigned)(__mul24(row, 1536) + (head * 96 + 64 + 8 * fq) * 2)) = pack8(kv0[m] * rinv, kv1[m] * rinv);
            }
            asm volatile("" ::: "memory"); __builtin_amdgcn_sched_barrier(0);
        }
    }
};
struct EpiPart {
    static constexpr bool PERM = true, AFTER_DRAIN = false;
    float* P; int row0 = 0;
    __device__ __forceinline__ void operator()(const f32x4 (&acc)[2][2][4][2], const pg8::Unit& u, int wr, int wc, int fr, int fq) const {
        const int col = 256 * u.pn + wc * 32 + 8 * fq;
        EPI_FOR_ROWS { const int row = EPI_ROW;
#pragma unroll
            for (int bj = 0; bj < 2; ++bj) { float* p = P + (size_t)row * 1024 + col + 128 * bj; *(f32x4*)p = acc[ai][bj][m][0]; *(f32x4*)(p + 4) = acc[ai][bj][m][1]; }
        }
    }
};
struct ExtraOrder {
    pg8::StaticOrder S; int nstatic, extra, nN;
    __device__ __forceinline__ void init(int N, int G, int c, int extra_) { S.init(MP, N, G, c); nN = N / 256; const int nwg = (MP / 256) * nN; nstatic = (c < nwg) ? (nwg - c + G - 1) / G : 0; extra = extra_; }
    __device__ __forceinline__ bool next(int i, pg8::Unit& u) const { if (i < nstatic) return S.next(i, u); if (extra >= 0 && i == nstatic) { u.pm = MP / 256 + extra / nN; u.pn = extra % nN; return true; } return false; }
    __device__ __forceinline__ void a_ready(const pg8::Unit&) const {}
    __device__ __forceinline__ void done(const pg8::Unit&) const {}
};
struct QOrder {
    int c, G, nstatic, extra;
    __device__ __forceinline__ void init(int G_, int c_, int extra_) { c = c_; G = G_; nstatic = (c < 192) ? (192 - c + G - 1) / G : 0; extra = extra_; }
    __device__ __forceinline__ bool next(int i, pg8::Unit& u) const {
        if (i < nstatic) { const int L = i * G + c; u.pm = L & 63; u.pn = L >> 6; return true; }
        if (extra >= 0 && i == nstatic) { const int hi3 = (extra >= 3) ? 1 : 0; u.pm = MP / 256 + hi3; u.pn = extra - 3 * hi3; return true; }
        return false; }
    __device__ __forceinline__ void a_ready(const pg8::Unit&) const {}
    __device__ __forceinline__ void done(const pg8::Unit&) const {}
};
struct ListOrder {
    int id, nN, cnt;
    __device__ __forceinline__ bool next(int i, pg8::Unit& u) const { if (i >= cnt) return false; u.pm = (id + i) / nN; u.pn = (id + i) % nN; return true; }
    __device__ __forceinline__ void a_ready(const pg8::Unit&) const {}
    __device__ __forceinline__ void done(const pg8::Unit&) const {}
};
constexpr int OUT_SPLIT = 4, DOWN_SPLIT = 11;
__device__ __forceinline__ void fixup_out_row(Frame& F, int r) {
    const int lane = F.lane; const float* part = wsp<float>(F, WS_PARTK) + (size_t)r * 1024;
    const float* xrow = INP(I_XS) + (size_t)r * 1024; float* y = F.out + O_YS + (size_t)r * 1024; bf16* xb = wsp<bf16>(F, WS_X1B) + (size_t)(MP + r) * 1024;
    f32x4 xv[4], pv[4][OUT_SPLIT];
#pragma unroll
    for (int j = 0; j < 4; ++j) { const int col = 4 * lane + 256 * j; xv[j] = *(const f32x4*)(xrow + col);
#pragma unroll
        for (int ch = 0; ch < OUT_SPLIT; ++ch) pv[j][ch] = *(const f32x4*)(part + (size_t)ch * 512 * 1024 + col); }
    float ss = 0.f;
#pragma unroll
    for (int j = 0; j < 4; ++j) { const int col = 4 * lane + 256 * j; f32x4 v = xv[j];
#pragma unroll
        for (int ch = 0; ch < OUT_SPLIT; ++ch) v += pv[j][ch];
        *(f32x4*)(y + col) = v; *(u32x2*)(xb + col) = (u32x2){pk2(v.x, v.y), pk2(v.z, v.w)}; ss += (v.x * v.x + v.y * v.y) + (v.z * v.z + v.w * v.w); }
    ss = wave_sum(ss);
    if (lane == 0) wsp<float>(F, WS_RINVF)[MP + r] = 1.0f / sqrtf(ss * (1.0f / 1024.0f) + EPS);
}
__device__ __forceinline__ void rinvf_rows(Frame& F, int t0, int nt) {
    for (int r = t0; r < MP; r += nt) { const f32x4* sp = (const f32x4*)(wsp<float>(F, WS_SSQ2) + (size_t)r * 16); const f32x4 s0 = sp[0], s1 = sp[1], s2 = sp[2], s3 = sp[3];
        const float ss = ((s0[0] + s0[1]) + (s0[2] + s0[3])) + ((s1[0] + s1[1]) + (s1[2] + s1[3])) + ((s2[0] + s2[1]) + (s2[2] + s2[3])) + ((s3[0] + s3[1]) + (s3[2] + s3[3]));
        wsp<float>(F, WS_RINVF)[r] = 1.0f / sqrtf(ss * (1.0f / 1024.0f) + EPS); }
}
__device__ __forceinline__ void fixup_down_row(Frame& F, int r) {
    const int lane = F.lane; const float* part = wsp<float>(F, WS_PARTK) + (size_t)r * 1024; float* y = F.out + O_YS + (size_t)r * 1024;
#pragma unroll
    for (int jh = 0; jh < 2; ++jh) {
        f32x4 yv[2], pv[2][DOWN_SPLIT];
#pragma unroll
        for (int jj = 0; jj < 2; ++jj) { const int col = 4 * lane + 256 * (2 * jh + jj); yv[jj] = *(const f32x4*)(y + col);
#pragma unroll
            for (int ch = 0; ch < DOWN_SPLIT; ++ch) pv[jj][ch] = *(const f32x4*)(part + (size_t)ch * 512 * 1024 + col); }
#pragma unroll
        for (int jj = 0; jj < 2; ++jj) { const int col = 4 * lane + 256 * (2 * jh + jj); f32x4 v = yv[jj];
#pragma unroll
            for (int ch = 0; ch < DOWN_SPLIT; ++ch) v += pv[jj][ch];
            *(f32x4*)(y + col) = v; }
    }
}

struct P2aIn { u32x2 vw; unsigned qw[3]; unsigned short x1, x2; float cs, sn; };
__device__ __forceinline__ void p2a_load(Frame& F, int row, P2aIn& in) {
    const int lane = F.lane, j = lane & 15;
    const bf16* raw = wsp<bf16>(F, WS_RAW) + (size_t)row * 768;
    in.vw = *(const u32x2*)(raw + 4 * lane);
#pragma unroll
    for (int i = 0; i < 3; ++i) in.qw[i] = *(const unsigned*)(raw + 256 + 2 * lane + 128 * i);
    in.x1 = raw[640 + j]; in.x2 = raw[656 + j];
    const float* tb = wsp<float>(F, WS_TAB) + pos_index(row) * 32; in.cs = tb[j]; in.sn = tb[16 + j];
}
__device__ __forceinline__ void p2a_row(Frame& F, int row, const P2aIn& in) {
    const int lane = F.lane;
    {
        const u32x2 vw = in.vw;
        const f32x4 v = (f32x4){__uint_as_float(vw.x << 16), __uint_as_float(vw.x & 0xffff0000u), __uint_as_float(vw.y << 16), __uint_as_float(vw.y & 0xffff0000u)};
        const float ss = wave_sum((v.x * v.x + v.y * v.y) + (v.z * v.z + v.w * v.w));
        const float rinv = 1.0f / sqrtf(ss * (1.0f / 256.0f) + EPS);
        const f32x4 g = *(const f32x4*)(INP(I_KVG) + 4 * lane);
        const f32x4 o = v * rinv * g;
        float* lat = (row < MP) ? F.out + O_LATP + (size_t)row * 256 : F.out + O_LATS + (size_t)(row - MP) * 256;
        *(f32x4*)(lat + 4 * lane) = o;
        *(u32x2*)(wsp<bf16>(F, WS_CKV) + (size_t)row * 256 + 4 * lane) = (u32x2){pk2(o.x, o.y), pk2(o.z, o.w)};
    }
    {
        f32x2 q[3]; float ss = 0.f;
#pragma unroll
        for (int i = 0; i < 3; ++i) { const unsigned w = in.qw[i]; q[i] = (f32x2){__uint_as_float(w << 16), __uint_as_float(w & 0xffff0000u)}; ss += q[i].x * q[i].x + q[i].y * q[i].y; }
        const float rinv = 1.0f / sqrtf(wave_sum(ss) * (1.0f / 384.0f) + EPS);
#pragma unroll
        for (int i = 0; i < 3; ++i) *(unsigned*)(wsp<bf16>(F, WS_CQN) + (size_t)row * 384 + 2 * lane + 128 * i) = pk2(q[i].x * rinv, q[i].y * rinv);
    }
    {
        const float x1 = bf2f(in.x1), x2 = bf2f(in.x2), cs = in.cs, s = in.sn;
        const float o = ((lane & 31) < 16) ? (x1 * cs - x2 * s) : (x2 * cs + x1 * s);
        float s2 = o * o; s2 += __shfl_xor(s2, 1); s2 += __shfl_xor(s2, 2); s2 += __shfl_xor(s2, 4); s2 += __shfl_xor(s2, 8); s2 += __shfl_xor(s2, 16);
        if (lane < 32) { float* kr = (row < MP) ? F.out + O_KRP + (size_t)row * 32 : F.out + O_KRS + (size_t)(row - MP) * 32;
            kr[lane] = o; wsp<float>(F, WS_KPE)[(size_t)row * 32 + lane] = o;
            if (lane == 0) wsp<float>(F, WS_KPESSQ)[row] = s2; }
    }
}
__device__ __forceinline__ void p2a_rows(Frame& F, int gw, int NGW) {
#pragma unroll 1
    for (int m0 = gw; m0 < M; m0 += 5 * NGW) {
        P2aIn in[5];
#pragma unroll
        for (int k = 0; k < 5; ++k) { const int mk = m0 + k * NGW; p2a_load(F, mk < M ? mk : m0, in[k]); }
#pragma unroll
        for (int k = 0; k < 5; ++k) { const int mk = m0 + k * NGW; if (mk < M) p2a_row(F, mk, in[k]); }
    }
}
__device__ __forceinline__ void qlat_job(Frame& F, int db, int h, bf16* qlat  ) {
    const int lane = F.lane; const float* GG = wsp<float>(F, WS_GG);
    float a[4], ar[4];
#pragma unroll
    for (int qi = 0; qi < 4; ++qi) { const size_t row = (size_t)(MP + db * 4 + qi); const bf16* q = wsp<bf16>(F, WS_Q) + row * 768 + h * 96; const float* sq = wsp<float>(F, WS_SSQQ) + row * 16;
        const float rinv = 1.0f / sqrtf((sq[h] + sq[8 + h]) * (1.0f / 96.0f) + EPS);
        a[qi] = bf2f(q[lane]) * rinv * GG[lane]; ar[qi] = bf2f(q[64 + (lane & 31)]) * rinv * GG[64 + (lane & 31)]; }
    const bf16* W = wsp<bf16>(F, WS_WKV) + (size_t)(256 * (h >> 2) + 32 * (h & 3)) * 256 + 2 * lane;
    float acc[4][2][2];
#pragma unroll
    for (int qi = 0; qi < 4; ++qi)
#pragma unroll
        for (int i = 0; i < 2; ++i) { acc[qi][i][0] = 0.f; acc[qi][i][1] = 0.f; }
#pragma unroll 1
    for (int half = 0; half < 2; ++half) {
        unsigned wv[32][2];
#pragma unroll
        for (int dd = 0; dd < 32; ++dd)
#pragma unroll
            for (int i = 0; i < 2; ++i) wv[dd][i] = *(const unsigned*)(W + (size_t)(128 * half + dd) * 256 + 128 * i);
#pragma unroll
        for (int dd = 0; dd < 32; ++dd)
#pragma unroll
            for (int qi = 0; qi < 4; ++qi) { const float ad = __uint_as_float(__builtin_amdgcn_readlane(__float_as_uint(a[qi]), 32 * half + dd));
#pragma unroll
                for (int i = 0; i < 2; ++i) { acc[qi][i][0] += ad * __uint_as_float(wv[dd][i] << 16); acc[qi][i][1] += ad * __uint_as_float(wv[dd][i] & 0xffff0000u); } }
    }
#pragma unroll
    for (int qi = 0; qi < 4; ++qi) { bf16* o = qlat + (h * 4 + qi) * 288;
#pragma unroll
        for (int i = 0; i < 2; ++i) *(unsigned*)(o + 2 * lane + 128 * i) = pk2(acc[qi][i][0], acc[qi][i][1]);
        if (lane < 32) o[256 + lane] = (bf16)f2bf(ar[qi]); }
}

constexpr int CONV_ITEMS = BATCH * (SEQ / 32) + DEC_BATCH;
__device__ __forceinline__ void conv_item(Frame& F, int item) {
    const int c = F.tid, lane = F.lane;
    const bf16* U = wsp<bf16>(F, WS_U);
    LAS float* Y = (LAS float*)(F.lds + RING_OFF);
    LAS bf16* UT = (LAS bf16*)(F.lds + RING_OFF + 65536);
    int rowbase, nrows;
    if (item < BATCH * (SEQ / 32)) {
        const int seq = item >> 7, t0 = (item & 127) * 32; rowbase = seq * SEQ + t0; nrows = 32;
#pragma unroll
        for (int i = 0; i < 8; ++i) { const int id = c + 512 * i; if (id < 62 * 64) { const int j = id >> 6, part = id & 63; const int tt = t0 - 30 + j;
            v4u v = (v4u){0u, 0u, 0u, 0u}; if (tt >= 0) v = *(const v4u*)(U + (size_t)(seq * SEQ + tt) * 512 + 8 * part);
            *(LAS v4u*)(UT + j * 512 + 8 * part) = v; } }
    } else {
        const int db = item - BATCH * (SEQ / 32); rowbase = MP + db * 4; nrows = 4;
#pragma unroll
        for (int i = 0; i < 8; ++i) { const int id = c + 512 * i; if (id < 62 * 64) { const int j = id >> 6, part = id & 63;
            v4u v = (v4u){0u, 0u, 0u, 0u};
            if (j < 30) { const float* s = INP(I_SCONV) + ((size_t)db * 30 + j) * 512 + 8 * part; const f32x4 a = *(const f32x4*)s, b2 = *(const f32x4*)(s + 4); v = (v4u){pk2(a.x, a.y), pk2(a.z, a.w), pk2(b2.x, b2.y), pk2(b2.z, b2.w)}; }
            else if (j < 34) v = *(const v4u*)(U + (size_t)(MP + db * 4 + (j - 30)) * 512 + 8 * part);
            *(LAS v4u*)(UT + j * 512 + 8 * part) = v; } }
    }
    float cw[CW];
#pragma unroll
    for (int w = 0; w < CW; ++w) cw[w] = INP(I_CVW)[w * 512 + c];
    const float bias = INP(I_CVB)[c];
    __syncthreads();
    float win[62];
#pragma unroll
    for (int j = 0; j < 62; ++j) win[j] = bf2f(UT[j * 512 + c]);
#pragma unroll
    for (int i = 0; i < 32; ++i) { float y = bias;
#pragma unroll
        for (int w = 0; w < CW; ++w) y += cw[w] * win[i + w];
        Y[i * 512 + c] = y; }
    __syncthreads();
    const f32x4 lg0 = *(const f32x4*)(INP(I_LNG) + 8 * lane), lg1 = *(const f32x4*)(INP(I_LNG) + 8 * lane + 4), lb0 = *(const f32x4*)(INP(I_LNB) + 8 * lane), lb1 = *(const f32x4*)(INP(I_LNB) + 8 * lane + 4);
#pragma unroll
    for (int rr = 0; rr < 4; ++rr) { const int i = 4 * F.wave + rr;
        if (i < nrows) {
            f32x4 a = *(const LAS f32x4*)(Y + i * 512 + 8 * lane), b = *(const LAS f32x4*)(Y + i * 512 + 8 * lane + 4);
            const float mean = wave_sum(((a.x + a.y) + (a.z + a.w)) + ((b.x + b.y) + (b.z + b.w))) * (1.0f / 512.0f);
            a = a - mean; b = b - mean;
            const float var = wave_sum(((a.x * a.x + a.y * a.y) + (a.z * a.z + a.w * a.w)) + ((b.x * b.x + b.y * b.y) + (b.z * b.z + b.w * b.w))) * (1.0f / 512.0f);
            const float rstd = 1.0f / sqrtf(var + EPS);
            f32x4 r0 = a * rstd * lg0 + lb0, r1 = b * rstd * lg1 + lb1;
#pragma unroll
            for (int e = 0; e < 4; ++e) { r0[e] = r0[e] * sigm(r0[e]); r1[e] = r1[e] * sigm(r1[e]); }
            *(v4u*)(wsp<bf16>(F, WS_T) + (size_t)(rowbase + i) * 512 + 8 * lane) = pack8(r0, r1);
        } }
    __syncthreads();
}
}
namespace mk {
typedef float f32x16 __attribute__((ext_vector_type(16)));
typedef short s16x4 __attribute__((ext_vector_type(4)));
typedef short v4i16_t __attribute__((ext_vector_type(4)));
typedef int v8i_t __attribute__((ext_vector_type(8)));
__device__ __forceinline__ int crow(int r, int hi) { return (r & 3) + 8 * (r >> 2) + 4 * hi; }
__device__ __forceinline__ s16x4 tr_read(const LAS unsigned char* p) { return __builtin_bit_cast(s16x4, __builtin_amdgcn_ds_read_tr16_b64_v4i16((LAS v4i16_t*)p)); }
__device__ __forceinline__ bf16x8 lds_b128(const LAS unsigned char* p) { return *(const LAS bf16x8*)p; }

__device__ __forceinline__ float attn_bound(Frame& F) {
    const int lane = F.lane;
    float gq = fabsf(INP(I_QNG)[lane]), gk = fabsf(INP(I_KNG)[lane]);
    if (lane < 16) { gq = fmaxf(gq, fabsf(INP(I_QNG)[64 + lane])); gk = fmaxf(gk, fabsf(INP(I_KNG)[64 + lane])); }
#pragma unroll
    for (int o = 1; o < 64; o <<= 1) { gq = fmaxf(gq, __shfl_xor(gq, o)); gk = fmaxf(gk, __shfl_xor(gk, o)); }
    return 9.7979589711f * gq * gk * LOG2E * 1.02f + 0.05f;
}

constexpr int PA_KP = 208, PA_VP = 144;
constexpr int PA_KB = 0, PA_KBSZ = 128 * PA_KP, PA_VB = 2 * PA_KBSZ, PA_VBSZ = 128 * PA_VP, PA_LW = PA_VB + 2 * PA_VBSZ;
__device__ __forceinline__ void attn_prompt_unit(Frame& F, int b, int h, int qb, float B2) {
    const int tid = F.tid, lane = F.lane, wave = F.wave, r32 = lane & 31, hi = lane >> 5;
    const bf16* Qg = wsp<bf16>(F, WS_Q); const bf16* Kg = wsp<bf16>(F, WS_K); const bf16* Vg = wsp<bf16>(F, WS_V); bf16* Og = wsp<bf16>(F, WS_O);
    const size_t rowbase = (size_t)b * SEQ;
    const int q0 = qb * 256 + wave * 32;
    LAS unsigned char* ring = F.lds + RING_OFF;
    bf16x8 qr[6];
#pragma unroll
    for (int s = 0; s < 6; ++s) qr[s] = *(const bf16x8*)(Qg + (rowbase + q0 + r32) * 768 + h * 96 + 16 * s + 8 * hi);
    {
        const float* sq = wsp<float>(F, WS_SSQQ) + (rowbase + q0 + r32) * 16; const float rq = 1.0f / sqrtf((sq[h] + sq[8 + h]) * (1.0f / 96.0f) + EPS);
#pragma unroll
        for (int s = 0; s < 6; ++s) { float f[8]; unpack8(__builtin_bit_cast(v4u, qr[s]), f);
            const float* gg = wsp<float>(F, WS_GG) + 16 * s + 8 * hi; const f32x4 g0 = *(const f32x4*)gg * rq, g1 = *(const f32x4*)(gg + 4) * rq;
            v4u w; w.x = cvtpk(f[0] * g0[0], f[1] * g0[1]); w.y = cvtpk(f[2] * g0[2], f[3] * g0[3]); w.z = cvtpk(f[4] * g1[0], f[5] * g1[1]); w.w = cvtpk(f[6] * g1[2], f[7] * g1[3]); qr[s] = __builtin_bit_cast(bf16x8, w); } }
    f32x16 o0, o1;
#pragma unroll
    for (int r = 0; r < 16; ++r) { o0[r] = 0.f; o1[r] = 0.f; }
    float lsum = 0.f;
    const int NT = 2 * qb + 2;
    unsigned koff[3]; int kdst[3]; unsigned voff[2]; int vdst[2];
#pragma unroll
    for (int i = 0; i < 3; ++i) { const int id = tid + 512 * i, key = id / 12, part = id % 12; koff[i] = (unsigned)(key * 768 + 8 * part); kdst[i] = PA_KB + key * PA_KP + part * 16; }
#pragma unroll
    for (int i = 0; i < 2; ++i) { const int id = tid + 512 * i, key = id >> 3, part = id & 7; voff[i] = (unsigned)(key * 512 + 8 * part); vdst[i] = PA_VB + key * PA_VP + part * 16; }
    const bf16* Kb0 = Kg + rowbase * 768 + h * 96; const bf16* Vb0 = Vg + rowbase * 512 + h * 64;
    v4u kreg[3], vreg[2];
#define PA_LOAD(t) do { const bf16* kt_ = Kb0 + (size_t)(t) * 128 * 768; const bf16* vt_ = Vb0 + (size_t)(t) * 128 * 512; \
                        _Pragma("unroll") for (int i_ = 0; i_ < 3; ++i_) kreg[i_] = *(const v4u*)(kt_ + koff[i_]); \
                        _Pragma("unroll") for (int i_ = 0; i_ < 2; ++i_) vreg[i_] = *(const v4u*)(vt_ + voff[i_]); } while (0)
#define PA_STORE(buf) do { _Pragma("unroll") for (int i_ = 0; i_ < 3; ++i_) *(LAS v4u*)(ring + (buf) * PA_KBSZ + kdst[i_]) = kreg[i_]; \
                           _Pragma("unroll") for (int i_ = 0; i_ < 2; ++i_) *(LAS v4u*)(ring + (buf) * PA_VBSZ + vdst[i_]) = vreg[i_]; } while (0)
    PA_LOAD(0);
    const int tl = lane & 15, g4 = lane >> 4;
    const int vtr_off = (4 * hi + (tl >> 2)) * PA_VP + (16 * (g4 & 1) + 4 * (tl & 3)) * 2;
    for (int t = 0; t < NT; ++t) {
        const int buf = t & 1;
        PA_STORE(buf);
        __syncthreads();
        if (t + 1 < NT) PA_LOAD(t + 1);
#pragma unroll 1
        for (int sub = 0; sub < 2; ++sub) {
            const int t64 = 2 * t + sub;
            if (64 * t64 > q0 + 31) continue;
            const LAS unsigned char* kb = ring + PA_KB + buf * PA_KBSZ + (64 * sub + r32) * PA_KP + hi * 16;
            f32x16 p0, p1;
#pragma unroll
            for (int r = 0; r < 16; ++r) { p0[r] = -B2; p1[r] = -B2; }
#pragma unroll
            for (int s = 0; s < 6; ++s) {
                const bf16x8 a0 = lds_b128(kb + s * 32), a1 = lds_b128(kb + 32 * PA_KP + s * 32);
                p0 = __builtin_amdgcn_mfma_f32_32x32x16_bf16(a0, qr[s], p0, 0, 0, 0);
                p1 = __builtin_amdgcn_mfma_f32_32x32x16_bf16(a1, qr[s], p1, 0, 0, 0);
            }
#pragma unroll
            for (int r = 0; r < 16; ++r) { p0[r] = __builtin_amdgcn_exp2f(p0[r]); p1[r] = __builtin_amdgcn_exp2f(p1[r]); }
            if (t64 >= 4 * qb) {
                const int qq = q0 + r32, k0 = 64 * t64 + 4 * hi;
#pragma unroll
                for (int r = 0; r < 16; ++r) { const int kk = k0 + (r & 3) + 8 * (r >> 2); if (kk > qq) p0[r] = 0.f; if (kk + 32 > qq) p1[r] = 0.f; }
            }
            float sacc = 0.f;
#pragma unroll
            for (int r = 0; r < 16; ++r) sacc += p0[r] + p1[r];
            lsum += sacc;
            const LAS unsigned char* vb = ring + PA_VB + buf * PA_VBSZ + 64 * sub * PA_VP + vtr_off;
#pragma unroll
            for (int mt = 0; mt < 2; ++mt)
#pragma unroll
                for (int s = 0; s < 2; ++s) {
                    const f32x16& p = mt ? p1 : p0;
                    v4u pw; pw.x = cvtpk(p[8 * s + 0], p[8 * s + 1]); pw.y = cvtpk(p[8 * s + 2], p[8 * s + 3]); pw.z = cvtpk(p[8 * s + 4], p[8 * s + 5]); pw.w = cvtpk(p[8 * s + 6], p[8 * s + 7]);
                    const bf16x8 pa = __builtin_bit_cast(bf16x8, pw);
                    const LAS unsigned char* vk = vb + (32 * mt + 16 * s) * PA_VP;
#pragma unroll
                    for (int d0 = 0; d0 < 2; ++d0) {
                        const s16x4 lo = tr_read(vk + d0 * 64), h4 = tr_read(vk + d0 * 64 + 8 * PA_VP);
                        const bf16x8 vf = (bf16x8){lo[0], lo[1], lo[2], lo[3], h4[0], h4[1], h4[2], h4[3]};
                        if (d0 == 0) o0 = __builtin_amdgcn_mfma_f32_32x32x16_bf16(pa, vf, o0, 0, 0, 0); else o1 = __builtin_amdgcn_mfma_f32_32x32x16_bf16(pa, vf, o1, 0, 0, 0);
                    }
                }
        }
    }
#undef PA_LOAD
#undef PA_STORE
    lsum += __shfl_xor(lsum, 32);
    LAS float* lw = (LAS float*)(ring + PA_LW) + wave * 32;
    if (hi == 0) lw[r32] = lsum;
    LDS_WAIT(); asm volatile("" ::: "memory");
    bf16* orow = Og + (rowbase + q0) * 512 + h * 64 + r32;
#pragma unroll
    for (int r = 0; r < 16; ++r) { const int q = crow(r, hi); const float inv = 1.0f / lw[q];
        orow[(size_t)q * 512] = (bf16)f2bf(o0[r] * inv); orow[(size_t)q * 512 + 32] = (bf16)f2bf(o1[r] * inv); }
    LDS_WAIT(); asm volatile("" ::: "memory");
}
__device__ __forceinline__ void attn_prompt_phase(Frame& F) {
    const float B2 = attn_bound(F);
    for (int p = blockIdx.x; p < BATCH * NH * 8; p += F.G) {
        const int bh = p >> 3, s = p & 7;
        attn_prompt_unit(F, bh >> 3, bh & 7, s, B2);
        attn_prompt_unit(F, bh >> 3, bh & 7, 15 - s, B2);
    }
    __syncthreads();
}

#ifndef SA_EXP
#define SA_EXP 0
#endif
#ifdef SA_PROF
#define SA_T(k) do { const unsigned t_ = (unsigned)__builtin_readcyclecounter(); if ((k) == SA_PROFK) prof_acc += (float)(t_ - prof_t); prof_t = t_; } while (0)
#else
#define SA_T(k) do {} while (0)
#endif
constexpr int SA_CP = 592;
constexpr int SA_CB = 0, SA_CBSZ = 64 * SA_CP, SA_PB = 2 * SA_CBSZ, SA_PP = 144, SA_RINV = SA_PB + 32 * SA_PP, SA_QL = SA_RINV + 8 * 64 * 4, SA_LSW = SA_QL + 32 * SA_CP, SA_C8 = SA_LSW + 8 * 16 * 4 + 64 * 4, SA_C8P = 272, SA_C8SZ = 64 * SA_C8P, SA_END = SA_C8 + 2 * SA_C8SZ;
static_assert(SA_END <= RING_BYTES, "sample attention LDS");
constexpr int SA_NUNITS = DEC_BATCH * SA_UNITS_PER_SEQ;
__device__ __forceinline__ bf16x8 fp8x8_to_bf16x8(const u32x2 w) {
    const f32x2 f0 = __builtin_amdgcn_cvt_pk_f32_fp8((int)w.x, false), f1 = __builtin_amdgcn_cvt_pk_f32_fp8((int)w.x, true), f2 = __builtin_amdgcn_cvt_pk_f32_fp8((int)w.y, false), f3 = __builtin_amdgcn_cvt_pk_f32_fp8((int)w.y, true);
    v4u o; o.x = cvtpk(f0.x, f0.y); o.y = cvtpk(f1.x, f1.y); o.z = cvtpk(f2.x, f2.y); o.w = cvtpk(f3.x, f3.y);
    return __builtin_bit_cast(bf16x8, o);
}
__device__ __forceinline__ void attn_combine_job(Frame& F, const int db, const int h);
template <int MODE  > __device__ __forceinline__ void attn_sample_phase(Frame& F) {
    const int tid = F.tid, lane = F.lane, wave = F.wave, r32 = lane & 31, hi = lane >> 5, tl = lane & 15, g4 = lane >> 4;
    const float B2 = attn_bound(F);
    LAS unsigned char* ring = F.lds + RING_OFF;
    const float* clat = INP(I_CLAT); const float* ckpe = INP(I_CKPE); const int* ptab = (const int*)INP(I_PT);
    LAS float* RINV = (LAS float*)(ring + SA_RINV);
    LAS float* LSW = (LAS float*)(ring + SA_LSW);
    LAS float* KSQ = (LAS float*)(ring + SA_LSW) + 8 * 16;
    const int slot = blockIdx.x, nslots = F.G;
    const int nunits_cu = (slot < SA_NUNITS) ? (SA_NUNITS - slot + nslots - 1) / nslots : 0;
#pragma unroll 1
    for (int k = 0; k < nunits_cu; ++k) { const int un = slot + k * nslots; qlat_job(F, un >> 1, wave, wsp<bf16>(F, WS_QLAT) + (size_t)un * 32 * 288); }
    __builtin_amdgcn_fence(__ATOMIC_RELEASE, "workgroup"); __syncthreads(); __builtin_amdgcn_fence(__ATOMIC_ACQUIRE, "workgroup");
    v8i_t wa8[2][4];
    { const unsigned char* W = wsp<unsigned char>(F, WS_WUK8) + (size_t)(wave * 64 + r32) * 256 + 32 * hi;
#pragma unroll
      for (int mt = 0; mt < 2; ++mt)
#pragma unroll
          for (int ks = 0; ks < 4; ++ks) { const v4u lo_ = *(const v4u*)(W + (size_t)(32 * mt) * 256 + 64 * ks), hi_ = *(const v4u*)(W + (size_t)(32 * mt) * 256 + 64 * ks + 16);
              wa8[mt][ks] = (v8i_t){(int)lo_.x, (int)lo_.y, (int)lo_.z, (int)lo_.w, (int)hi_.x, (int)hi_.y, (int)hi_.z, (int)hi_.w}; } }
    asm volatile("s_waitcnt vmcnt(0)" ::: "memory");
    const int sc_row = 16 * (wave & 1) + tl, sc_key = 16 * (wave >> 1) + tl;
    const int p_key = sc_key, p_hh = 4 * (wave & 1) + g4;
#ifdef SA_PROF
    float prof_acc = 0.f; unsigned prof_t = (unsigned)__builtin_readcyclecounter(); const unsigned prof_t0 = prof_t; const unsigned long long prof_rt0 = __builtin_amdgcn_s_memrealtime();
#endif
    f32x4 preA[9], preB[9];
    const unsigned voff16 = (unsigned)tid * 16u;
    const int st_b16 = (tid >> 6) * SA_CP + (tid & 63) * 8, st_b8 = (tid >> 6) * SA_C8P + (tid & 63) * 4, st_kpe = (tid >> 3) * SA_CP + 512 + (tid & 7) * 8;
    for (int k0 = 0; k0 < nunits_cu; k0 += 2) {
        const int nk = (nunits_cu - k0 < 2) ? nunits_cu - k0 : 2, NT = nk * 64;
        int physv = 0;
        { const int k = lane >> 5; if (k < nk) { const int un = slot + (k0 + k) * nslots; physv = ptab[(un >> 1) * NPAGES + 32 * (un & 1) + (lane & 31)]; } }
#define SA_LOAD(PRE, T) do { const int phys_ = __builtin_amdgcn_readlane(physv, (T) >> 1); \
            const float* lat_ = clat + ((size_t)phys_ * PAGE + ((T) & 1) * 64) * KVLORA; const float* kp_ = ckpe + ((size_t)phys_ * PAGE + ((T) & 1) * 64) * ROPE; \
            _Pragma("unroll") for (int j_ = 0; j_ < 8; ++j_) { const char* bj_ = (const char*)lat_ + 8192 * j_; PRE[j_] = __builtin_nontemporal_load((const f32x4*)(bj_ + voff16)); } \
            PRE[8] = __builtin_nontemporal_load((const f32x4*)((const char*)kp_ + voff16)); } while (0)
#define SA_STORE(PRE, buf) do { LAS unsigned char* cb_ = ring + SA_CB + (buf) * SA_CBSZ; \
            LAS unsigned char* c8_ = ring + SA_C8 + (buf) * SA_C8SZ; \
            _Pragma("unroll") for (int j_ = 0; j_ < 8; ++j_) { *(LAS u32x2*)(cb_ + st_b16 + j_ * 8 * SA_CP) = (u32x2){cvtpk(PRE[j_][0], PRE[j_][1]), cvtpk(PRE[j_][2], PRE[j_][3])}; \
                int p8_ = __builtin_amdgcn_cvt_pk_fp8_f32(PRE[j_][0], PRE[j_][1], 0, false); p8_ = __builtin_amdgcn_cvt_pk_fp8_f32(PRE[j_][2], PRE[j_][3], p8_, true); *(LAS int*)(c8_ + st_b8 + j_ * 8 * SA_C8P) = p8_; } \
            *(LAS u32x2*)(cb_ + st_kpe) = (u32x2){cvtpk(PRE[8][0], PRE[8][1]), cvtpk(PRE[8][2], PRE[8][3])}; } while (0)
        SA_LOAD(preA, 0);
        SA_LOAD(preB, 1);
        __syncthreads();
        SA_STORE(preA, 0);
        if (2 < NT) SA_LOAD(preA, 2);
        f32x16 oacc;
#pragma unroll
        for (int r = 0; r < 16; ++r) oacc[r] = 0.f;
        float lsum[4] = {0.f, 0.f, 0.f, 0.f};
        int unit = 0;
#define SA_RDB(DST, KP, KS) do { const v4u lo_ = *(const LAS v4u*)((KP) + 64 * (KS)), hi_ = *(const LAS v4u*)((KP) + 64 * (KS) + 16); DST = (v8i_t){(int)lo_.x, (int)lo_.y, (int)lo_.z, (int)lo_.w, (int)hi_.x, (int)hi_.y, (int)hi_.z, (int)hi_.w}; } while (0)
#define SA_STEP(T, PRE) do { const int buf = (T) & 1; \
            if ((T & 63) == 0) {    \
                unit = slot + (k0 + (T >> 6)) * nslots; const int db = unit >> 1; \
                {    \
                    const bf16* src = wsp<bf16>(F, WS_QLAT) + (size_t)unit * 32 * 288; (void)db; \
                    int t2_ = tid; asm volatile("" : "+v"(t2_)); \
_Pragma("unroll") \
                    for (int j = 0; j < 3; ++j) { const int id = t2_ + 512 * j; if (id < 1152) { const int row = id / 36, part = id % 36; *(LAS v4u*)(ring + SA_QL + row * SA_CP + part * 16) = *(const v4u*)(src + row * 288 + 8 * part); } } \
                } \
_Pragma("unroll") \
                for (int r = 0; r < 16; ++r) oacc[r] = 0.f; \
_Pragma("unroll") \
                for (int q = 0; q < 4; ++q) lsum[q] = 0.f; \
                __syncthreads(); \
            } \
            const LAS unsigned char* cb = ring + SA_CB + buf * SA_CBSZ; \
            SA_T(0); \
            {    \
                const LAS unsigned char* c8 = ring + SA_C8 + buf * SA_C8SZ + r32 * SA_C8P + hi * 32; \
                float ssq0 = 0.f, ssq1 = 0.f; \
_Pragma("unroll") \
                for (int kt = 0; kt < 2; ++kt) { \
                    const LAS unsigned char* kp = c8 + kt * 32 * SA_C8P; \
                    float ss = 0.f; \
_Pragma("unroll") \
                    for (int mt = 0; mt < 2; ++mt) { \
                        f32x16 a0; \
_Pragma("unroll") \
                        for (int r = 0; r < 16; ++r) a0[r] = 0.f; \
                        v8i_t bq[2]; \
                        SA_RDB(bq[0], kp, 0); \
                        __builtin_amdgcn_sched_barrier(0); \
_Pragma("unroll") \
                        for (int ks = 0; ks < 4; ++ks) { \
                            if (ks < 3) SA_RDB(bq[(ks + 1) & 1], kp, ks + 1); \
                            __builtin_amdgcn_sched_barrier(0); \
                            a0 = __builtin_amdgcn_mfma_scale_f32_32x32x64_f8f6f4(wa8[mt][ks], bq[ks & 1], a0, 0, 0, 0, 0x7F7F7F7F, 0, 0x7F7F7F7F); \
                            __builtin_amdgcn_sched_barrier(0); \
                        } \
_Pragma("unroll") \
                        for (int r = 0; r < 16; ++r) ss += a0[r] * a0[r]; \
                    } \
                    if (kt == 0) ssq0 = ss; else ssq1 = ss; \
                } \
                ssq0 *= (1.0f / 256.0f); ssq1 *= (1.0f / 256.0f); \
_Pragma("unroll") \
                for (int kt = 0; kt < 2; ++kt) { float kf[8]; float ss = 0.f; \
                    unpack8(*(const LAS v4u*)(cb + (32 * kt + r32) * SA_CP + 512 + hi * 32), kf); \
_Pragma("unroll") \
                    for (int e = 0; e < 8; ++e) ss += kf[e] * kf[e]; \
                    unpack8(*(const LAS v4u*)(cb + (32 * kt + r32) * SA_CP + 512 + hi * 32 + 16), kf); \
_Pragma("unroll") \
                    for (int e = 0; e < 8; ++e) ss += kf[e] * kf[e]; \
                    if (kt == 0) ssq0 += ss; else ssq1 += ss; } \
                ssq0 += __shfl_xor(ssq0, 32); ssq1 += __shfl_xor(ssq1, 32); \
                if (hi == 0) { RINV[wave * 64 + r32] = 1.0f / sqrtf(ssq0 * (1.0f / 96.0f) + EPS); RINV[wave * 64 + 32 + r32] = 1.0f / sqrtf(ssq1 * (1.0f / 96.0f) + EPS); } \
            } \
            f32x4 sc = (f32x4){0.f, 0.f, 0.f, 0.f}; \
_Pragma("unroll") \
            for (int ks = 0; ks < (MODE == 6 ? 0 : 9); ++ks) { \
                const bf16x8 af = lds_b128(ring + SA_QL + sc_row * SA_CP + (32 * ks + 8 * g4) * 2); \
                const bf16x8 bfr = lds_b128(cb + sc_key * SA_CP + (32 * ks + 8 * g4) * 2); \
                sc = __builtin_amdgcn_mfma_f32_16x16x32_bf16(af, bfr, sc, 0, 0, 0); \
            } \
            SA_T(2); \
            if (MODE != 4) __syncthreads(); \
            SA_T(3); \
            if (MODE != 6) {    \
                const float rinv = RINV[p_hh * 64 + p_key]; \
_Pragma("unroll") \
                for (int q = 0; q < 4; ++q) { const float p = __builtin_amdgcn_exp2f(sc[q] * rinv - B2); lsum[q] += p; \
                    *(LAS bf16*)(ring + SA_PB + (4 * p_hh + q) * SA_PP + p_key * 2) = (bf16)f2bf(p); } \
            } \
            if (T + 1 < NT) { SA_STORE(PRE, buf ^ 1); if (T + 3 < NT) SA_LOAD(PRE, T + 3); } \
            SA_T(4); \
            if (MODE != 4) __syncthreads(); \
            SA_T(5); \
_Pragma("unroll") \
            for (int s = 0; s < (MODE == 6 ? 0 : 4); ++s) { \
                const bf16x8 pa = lds_b128(ring + SA_PB + r32 * SA_PP + (16 * s + 8 * hi) * 2); \
                const LAS unsigned char* vb = cb + (16 * s + 8 * hi + (tl >> 2)) * SA_CP + (32 * wave + 16 * (g4 & 1) + 4 * (tl & 3)) * 2; \
                const s16x4 lo = tr_read(vb), h4 = tr_read(vb + 4 * SA_CP); \
                oacc = __builtin_amdgcn_mfma_f32_32x32x16_bf16(pa, (bf16x8){lo[0], lo[1], lo[2], lo[3], h4[0], h4[1], h4[2], h4[3]}, oacc, 0, 0, 0); \
            } \
            SA_T(6); \
            if (MODE == 0 && (T & 63) == 63) {    \
                int l2_ = lane; asm volatile("" : "+v"(l2_)); \
                float* part = wsp<float>(F, WS_SPART) + (size_t)unit * SA_PART_STRIDE + 32 * wave + (l2_ & 31); \
_Pragma("unroll") \
                for (int r = 0; r < 16; ++r) __hip_atomic_store((gu32*)(part + crow(r, l2_ >> 5) * 256), __float_as_uint(oacc[r]), RLX_AGENT);     \
_Pragma("unroll") \
                for (int q = 0; q < 4; ++q) { float v = lsum[q]; v += __shfl_xor(v, 1); v += __shfl_xor(v, 2); v += __shfl_xor(v, 4); v += __shfl_xor(v, 8); if ((l2_ & 15) == 0) LSW[wave * 16 + (l2_ >> 4) * 4 + q] = v; } \
                __syncthreads(); \
                if (tid < 32) { const int par = tid >> 4, idx = tid & 15; __hip_atomic_store((gu32*)(wsp<float>(F, WS_SPART) + (size_t)unit * SA_PART_STRIDE + 32 * 256 + tid), __float_as_uint((LSW[(0 + par) * 16 + idx] + LSW[(2 + par) * 16 + idx]) + (LSW[(4 + par) * 16 + idx] + LSW[(6 + par) * 16 + idx])), RLX_AGENT); } \
                  \
                asm volatile("s_waitcnt vmcnt(0)" ::: "memory"); __syncthreads(); \
                if (tid == 0) (void)xb_add((unsigned*)(F.ctl + CW_CFLAG + 64 * (unit >> 1)), 1u); \
            } \
        } while (0)
        for (int T0 = 0; T0 < NT; T0 += 2) { SA_STEP(T0, preB); SA_STEP(T0 + 1, preA); }
#undef SA_STEP
#undef SA_RDB
#undef SA_LOAD
#undef SA_STORE
    }
    if (MODE == 0) {
        __syncthreads();
#pragma unroll 1
        for (int k = 0; k < nunits_cu; ++k) { const int un = slot + k * nslots, db = un >> 1;
            if (tid == 0) { unsigned* fl = (unsigned*)(F.ctl + CW_CFLAG + 64 * db); unsigned* barw = (unsigned*)(F.ctl + CW_BAR);
                XB_SPIN(xb_ld(fl) < (unsigned)SA_UNITS_PER_SEQ, barw);
                __builtin_amdgcn_fence(__ATOMIC_ACQUIRE, "agent"); asm volatile("s_waitcnt vmcnt(0)" ::: "memory"); }
            __syncthreads();
            if (wave < 4) attn_combine_job(F, db, 4 * (un & 1) + wave);
            __syncthreads(); }
    }
#ifdef SA_PROF
    if (blockIdx.x == SA_PROF && tid == 64 * (SA_PROFW)) { float* st = (float*)(F.ws + WS_END); st[0] = prof_acc; st[1] = (float)((unsigned)__builtin_readcyclecounter() - prof_t0); if (SA_PROFK == 9) { st[0] = st[1]; st[1] = (float)(__builtin_amdgcn_s_memrealtime() - prof_rt0) * 40.0f; } if (SA_PROFK == 8) { st[0] = (float)(__builtin_amdgcn_s_memrealtime() - prof_rt0); st[1] = 100000.0f; } }
#endif
    __syncthreads();
}


__device__ __forceinline__ void attn_combine_job(Frame& F, const int db, const int h) {
    const int lane = F.lane, wave = F.wave;
    const float B2 = attn_bound(F);
    LAS float* LO = (LAS float*)(F.lds + RING_OFF) + wave * 1024;
    const bf16* Qg = wsp<bf16>(F, WS_Q); const bf16* Kg = wsp<bf16>(F, WS_K); const bf16* CKV = wsp<bf16>(F, WS_CKV);
    const float* wuv = INP(I_WUV); const float* GG = wsp<float>(F, WS_GG);
    {
        float ol[4][4], l[4];
#pragma unroll
        for (int q = 0; q < 4; ++q) { l[q] = 0.f;
#pragma unroll
            for (int i = 0; i < 4; ++i) ol[q][i] = 0.f; }
#pragma unroll
        for (int u = 0; u < SA_UNITS_PER_SEQ; ++u) {
            const float* part = wsp<float>(F, WS_SPART) + (size_t)(db * SA_UNITS_PER_SEQ + u) * SA_PART_STRIDE;
#pragma unroll
            for (int q = 0; q < 4; ++q) { l[q] += part[32 * 256 + 4 * h + q];
#pragma unroll
                for (int i = 0; i < 4; ++i) ol[q][i] += part[(4 * h + q) * 256 + lane + 64 * i]; }
        }
#pragma unroll
        for (int jn = 0; jn < 4; ++jn) {
            const size_t rk = (size_t)(MP + db * 4 + jn);
            const float kn = bf2f(Kg[rk * 768 + h * 96 + lane]); const float kr = (lane < 32) ? bf2f(Kg[rk * 768 + h * 96 + 64 + lane]) : 0.f;
            float c4[4];
#pragma unroll
            for (int i = 0; i < 4; ++i) c4[i] = bf2f(CKV[rk * 256 + lane + 64 * i]);
#pragma unroll
            for (int q = 0; q < 4; ++q) if (q >= jn) {
                const size_t rq = (size_t)(MP + db * 4 + q);
                const float qn = bf2f(Qg[rq * 768 + h * 96 + lane]); const float qr = (lane < 32) ? bf2f(Qg[rq * 768 + h * 96 + 64 + lane]) : 0.f;
                const float* sq = wsp<float>(F, WS_SSQQ) + rq * 16; const float rinvq = 1.0f / sqrtf((sq[h] + sq[8 + h]) * (1.0f / 96.0f) + EPS);
                const float s = wave_sum(qn * kn * GG[lane] + qr * kr * GG[64 + (lane & 31)]) * rinvq; const float p = __builtin_amdgcn_exp2f(s - B2);
                l[q] += p;
#pragma unroll
                for (int i = 0; i < 4; ++i) ol[q][i] += p * c4[i];
            }
        }
#pragma unroll
        for (int q = 0; q < 4; ++q)
#pragma unroll
            for (int i = 0; i < 4; ++i) LO[q * 256 + lane + 64 * i] = ol[q][i];
        LDS_WAIT(); asm volatile("" ::: "memory");
        float o[4] = {0.f, 0.f, 0.f, 0.f};
#pragma unroll 1
        for (int c0 = 0; c0 < KVLORA; c0 += 64) {
            float w[64];
#pragma unroll
            for (int cc = 0; cc < 64; ++cc) w[cc] = wuv[(size_t)(c0 + cc) * 512 + h * 64 + lane];
#pragma unroll
            for (int cc = 0; cc < 64; ++cc)
#pragma unroll
                for (int q = 0; q < 4; ++q) o[q] += LO[q * 256 + c0 + cc] * w[cc];
        }
#pragma unroll
        for (int q = 0; q < 4; ++q) wsp<bf16>(F, WS_O)[(size_t)(MP + db * 4 + q) * 512 + h * 64 + lane] = (bf16)f2bf(o[q] / l[q]);
        LDS_WAIT(); asm volatile("" ::: "memory");
    }
}
}
namespace mk {
struct Args { const float* in[26]; float* out; unsigned char* ws; int ph_lo, ph_hi, li, pad; };
#ifndef SA_VARIANT
#define SA_VARIANT 0
#endif
#ifndef REP_PHASE
#define REP_PHASE -1
#endif
#ifndef REP_COUNT
#define REP_COUNT 1
#endif
#define NREP(k) (((k) == REP_PHASE) ? REP_COUNT : 1)
enum { PH_PRO = 0, PH_INPROJ, PH_ROWA, PH_QKV, PH_ROWC, PH_ATTN, PH_COMB, PH_MERGE, PH_OUT, PH_GU, PH_DOWN, PH_N };

__global__ void __launch_bounds__(NTHREADS, 2) fused_fwd(Args args) {
    extern __shared__ __attribute__((aligned(16))) unsigned char lds[];
    Frame F;
    F.lds = (LAS unsigned char*)lds;
    F.MISC = (volatile LAS unsigned*)(F.lds + MISC_OFF);
    F.tid = threadIdx.x; F.lane = F.tid & 63; F.wave = __builtin_amdgcn_readfirstlane(F.tid >> 6);
    F.G = gridDim.x;
#pragma unroll
    for (int i = 0; i < 26; ++i) F.in[i] = args.in[i];
    F.out = args.out; F.ws = args.ws; F.ctl = (gu32*)(args.ws + WS_CTL);
    for (int u = F.tid; u < (LDS_BYTES - LDSCTL_OFF) / 4; u += NTHREADS) ((LAS unsigned*)(F.lds + LDSCTL_OFF))[u] = 0u;
    __syncthreads();
    XcdBarrier bar = xcd_barrier_post((unsigned*)(F.ctl + CW_BAR) + args.li * XCD_BAR_WORDS, F.MISC + 8);
    const int lo = args.ph_lo, hi = args.ph_hi;
#define IN(k) (lo <= (k) && (k) < hi)
#define SEAM(k) do { if (IN(k) && IN((k) + 1)) xcd_barrier(bar); } while (0)
#define PHASE_BEGIN() do { int t_; asm volatile("v_mbcnt_lo_u32_b32 %0, -1, 0\n\tv_mbcnt_hi_u32_b32 %0, -1, %0" : "=v"(t_)); F.lane = t_; F.tid = t_ + 64 * F.wave; } while (0)
    const int gw = blockIdx.x * NWAVES + F.wave, NGW = F.G * NWAVES;
    LAS unsigned char* ring = F.lds + RING_OFF;

    const int ip_rounds = (66 * 15 + F.G - 1) / F.G, ip_nfull = 66 * 15 - (ip_rounds - 1) * F.G; const bool late_in_ip = (F.G - ip_nfull >= 16) && IN(PH_INPROJ);
    if (IN(PH_PRO)) { PHASE_BEGIN(); p0_prologue(F, late_in_ip); }
    SEAM(PH_PRO);
    if (IN(PH_INPROJ)) { PHASE_BEGIN();
        pg8::Gemm g{wsp<bf16>(F, WS_H), wsp<bf16>(F, WS_WIN), M, NIN, 1024}; pg8::StaticOrder S; S.init(M, NIN, F.G, (int)blockIdx.x);
        EpiInProj E{wsp<bf16>(F, WS_U), wsp<bf16>(F, WS_G), wsp<bf16>(F, WS_RAW), F.out};
        pg8::gemm_phase<EpiInProj, pg8::StaticOrder, true, true>(ring, g, S, E, F.wave);
        if (late_in_ip && (int)blockIdx.x >= ip_nfull) { PHASE_BEGIN(); const int ci = (int)blockIdx.x - ip_nfull, nc = F.G - ip_nfull;
            p0_late(F, ci * NWAVES + F.wave, nc * NWAVES, ci * NTHREADS + F.tid, nc * NTHREADS); }
    }
    SEAM(PH_INPROJ);
    if (IN(PH_ROWA)) { PHASE_BEGIN();
        p2a_rows(F, gw, NGW);
        for (int it = blockIdx.x; it < CONV_ITEMS; it += F.G) conv_item(F, it);
    }
    SEAM(PH_ROWA);
    if (IN(PH_QKV)) { PHASE_BEGIN();
        const int sb = (int)blockIdx.x;
        const int xb = (F.G >= 214) ? 192 : 0, xe = sb - xb;
        { pg8::Gemm g{wsp<bf16>(F, WS_CQN), wsp<bf16>(F, WS_WUQ), M, NQP, 384}; QOrder S; S.init(F.G, sb, (xe >= 0 && xe < 6) ? xe : -1);
          EpiQ3 E{wsp<bf16>(F, WS_Q), wsp<float>(F, WS_SSQQ), wsp<float>(F, WS_TAB)}; pg8::gemm_phase<EpiQ3, QOrder, true, true>(ring, g, S, E, F.wave); }
        { pg8::Gemm g{wsp<bf16>(F, WS_CKV), wsp<bf16>(F, WS_WKV), M, 1024, 256}; ExtraOrder S; S.init(1024, F.G, sb, (xe >= 6 && xe < 14) ? xe - 6 : -1);
          EpiKV3 E{wsp<bf16>(F, WS_K), wsp<bf16>(F, WS_V), wsp<float>(F, WS_KPE), wsp<float>(F, WS_KPESSQ)}; pg8::gemm_phase<EpiKV3, ExtraOrder, true, true>(ring, g, S, E, F.wave); }
        { pg8::Gemm g{wsp<bf16>(F, WS_T), wsp<bf16>(F, WS_WC), M, 1024, 512}; ExtraOrder S; S.init(1024, F.G, sb, (xe >= 14 && xe < 22) ? xe - 14 : -1);
          EpiConv E{wsp<bf16>(F, WS_G), wsp<bf16>(F, WS_CONVO)}; pg8::gemm_phase<EpiConv, ExtraOrder, true, true>(ring, g, S, E, F.wave); }
        if (F.G > xb + 22) { if (sb >= xb + 22) { PHASE_BEGIN(); convert_weights<1>(F, (sb - xb - 22) * NWAVES + F.wave, (F.G - xb - 22) * NWAVES); } }
        else { PHASE_BEGIN(); convert_weights<1>(F, gw, NGW); }
    }
    SEAM(PH_QKV);
    if (IN(PH_ATTN)) { PHASE_BEGIN();
        attn_prompt_phase(F);
        PHASE_BEGIN(); attn_sample_phase<0>(F);
    }
    SEAM(PH_ATTN);
    if (IN(PH_MERGE)) { PHASE_BEGIN();
        pg8::Gemm g{wsp<bf16>(F, WS_O), wsp<bf16>(F, WS_WO), M, 1024, 512}; pg8::StaticOrder S; S.init(M, 1024, F.G, (int)blockIdx.x);
        EpiMerge E{wsp<bf16>(F, WS_G), wsp<bf16>(F, WS_CONVO), wsp<bf16>(F, WS_MERGED)}; pg8::gemm_phase<EpiMerge, pg8::StaticOrder, true, true>(ring, g, S, E, F.wave);
        { const int nfirst = (66 * 4 > F.G) ? 66 * 4 - F.G : 0;
          const int sb2 = (int)blockIdx.x;
          if (F.G > nfirst && nfirst < F.G) { if (sb2 >= nfirst) { PHASE_BEGIN(); convert_weights<2>(F, (sb2 - nfirst) * NWAVES + F.wave, (F.G - nfirst) * NWAVES); css_copy(F, (sb2 - nfirst) * NTHREADS + F.tid, (F.G - nfirst) * NTHREADS); } }
          else { PHASE_BEGIN(); convert_weights<2>(F, gw, NGW); css_copy(F, (int)blockIdx.x * NTHREADS + F.tid, F.G * NTHREADS); } }
    }
    SEAM(PH_MERGE);
    if (IN(PH_OUT)) { PHASE_BEGIN();
        { pg8::Gemm g{wsp<bf16>(F, WS_MERGED), wsp<bf16>(F, WS_WOUT), MP, 1024, 1024}; pg8::StaticOrder S; S.init(MP, 1024, F.G, (int)blockIdx.x);
          EpiOut E{INP(I_XP), INP(I_XS), F.out + O_YP, wsp<bf16>(F, WS_X1B), wsp<float>(F, WS_SSQ2)}; pg8::gemm_phase<EpiOut, pg8::StaticOrder, true, true>(ring, g, S, E, F.wave); }
        {
            const int sb = (int)blockIdx.x, ch = sb >> 3;
            pg8::Gemm g{wsp<bf16>(F, WS_MERGED) + (size_t)MP * 1024 + 256 * (ch & 3), wsp<bf16>(F, WS_WOUT) + 256 * (ch & 3), MS, 1024, 256, 1024, 1024}; ListOrder S{sb & 7, 4, sb < 8 * OUT_SPLIT ? 1 : 0};
            EpiPart E{wsp<float>(F, WS_PARTK) + (size_t)(ch & 3) * 512 * 1024}; pg8::gemm_phase<EpiPart, ListOrder, true, true>(ring, g, S, E, F.wave); }
        xcd_barrier(bar);
        PHASE_BEGIN();
        for (int r = gw; r < MS; r += NGW) fixup_out_row(F, r);
        rinvf_rows(F, (int)blockIdx.x * NTHREADS + F.tid, F.G * NTHREADS);
    }
    SEAM(PH_OUT);
    if (IN(PH_GU)) { PHASE_BEGIN();
        pg8::Gemm g{wsp<bf16>(F, WS_X1B), wsp<bf16>(F, WS_WGU), M, NGU, 1024}; pg8::StaticOrder S; S.init(M, NGU, F.G, (int)blockIdx.x);
        EpiGateUp E{wsp<float>(F, WS_RINVF), wsp<bf16>(F, WS_ACT)}; pg8::gemm_phase<EpiGateUp, pg8::StaticOrder, true, true>(ring, g, S, E, F.wave);
    }
    SEAM(PH_GU);
    if (IN(PH_DOWN)) { PHASE_BEGIN();
        { pg8::Gemm g{wsp<bf16>(F, WS_ACT), wsp<bf16>(F, WS_WD), MP, 1024, DFF}; pg8::StaticOrder S; S.init(MP, 1024, F.G, (int)blockIdx.x);
          EpiDown E{F.out + O_YP, wsp<bf16>(F, WS_X1B)}; pg8::gemm_phase<EpiDown, pg8::StaticOrder, true, true>(ring, g, S, E, F.wave); }
        {
            const int sb = (int)blockIdx.x; int ch = sb >> 3; if (ch >= DOWN_SPLIT) ch = 0;
            pg8::Gemm g{wsp<bf16>(F, WS_ACT) + (size_t)MP * DFF + 256 * ch, wsp<bf16>(F, WS_WD) + 256 * ch, MS, 1024, 256, DFF, DFF}; ListOrder S{sb & 7, 4, sb < 8 * DOWN_SPLIT ? 1 : 0};
            EpiPart E{wsp<float>(F, WS_PARTK) + (size_t)ch * 512 * 1024}; pg8::gemm_phase<EpiPart, ListOrder, true, true>(ring, g, S, E, F.wave); }
        xcd_barrier(bar);
        PHASE_BEGIN();
        for (int r = gw; r < MS; r += NGW) fixup_down_row(F, r);
    }
#undef IN
#undef SEAM
}

static int g_grid = 0;
inline bool setup_once() {
    if (g_grid == 0) {
        int dev = 0, cus = 0, per_cu = 0;
        if (hipGetDevice(&dev) != hipSuccess || hipDeviceGetAttribute(&cus, hipDeviceAttributeMultiprocessorCount, dev) != hipSuccess) { g_grid = -1; return false; }
        if (hipFuncSetAttribute((const void*)fused_fwd, hipFuncAttributeMaxDynamicSharedMemorySize, LDS_BYTES) != hipSuccess) { g_grid = -1; return false; }
        if (hipOccupancyMaxActiveBlocksPerMultiprocessor(&per_cu, (const void*)fused_fwd, NTHREADS, LDS_BYTES) != hipSuccess || per_cu < 1) { fprintf(stderr, "occupancy query says %d\n", per_cu); }
        (void)hipGetLastError();
        g_grid = cus;
    }
    return g_grid > 0;
}
inline void launch_phases(void* const* d_in, void* d_out, void* d_ws, hipStream_t stream, int lo, int hi, int li) {
    Args a{};
    for (int i = 0; i < 26; ++i) a.in[i] = (const float*)d_in[i];
    a.out = (float*)d_out; a.ws = (unsigned char*)d_ws; a.ph_lo = lo; a.ph_hi = hi; a.li = li; a.pad = 0;
    hipLaunchKernelGGL(fused_fwd, dim3(g_grid), dim3(NTHREADS), LDS_BYTES, stream, a);
}
}
extern "C" void kernel_launch(void* const* d_in, const int* in_sizes, int n_in, void* d_out, int out_size, void* d_ws, size_t ws_size, hipStream_t stream) {
    if (!mk::setup_once()) return;
    if (n_in != 26 || (size_t)out_size != mk::O_END || ws_size < mk::WS_END) { fprintf(stderr, "kernel_launch: unexpected shapes\n"); return; }
    if (hipMemsetAsync((char*)d_ws + mk::WS_CTL, 0, mk::CTL_ZERO_BYTES, stream) != hipSuccess) return;
    mk::launch_phases(d_in, d_out, d_ws, stream, 0, mk::PH_N, 0);
}
```

```cpp
#include <hip/hip_runtime.h>
#include <cstdio>
#include <cstdint>
#include <math.h>
#define MK_HAVE_ATTN 1
namespace pg8 {
#define PG8_LAS __attribute__((address_space(3)))
typedef unsigned short bf16_t;
typedef short bf16x8 __attribute__((ext_vector_type(8)));
typedef float f32x4 __attribute__((ext_vector_type(4)));
typedef unsigned u32x4 __attribute__((ext_vector_type(4)));
constexpr int BM = 256, BK = 64, HALF = 128, HTB = HALF * BK * 2  , STAGE_BYTES = 8 * HTB, NXCD = 8, WGM = 4;

__host__ __device__ __forceinline__ int lds_byte(int r, int c) { const int st = (r >> 4) * 2 + (c >> 5), rr = r & 15, cc = c & 31, ob = rr * 64 + cc * 2; return st * 1024 + (ob ^ (((ob >> 9) & 1) << 5)); }
__host__ __device__ __forceinline__ void stage_rc(int b, int& R, int& C) { const int st = b / 1024, sb = b % 1024, swz = sb ^ (((sb >> 9) & 1) << 5); R = (st >> 1) * 16 + swz / 64; C = (st & 1) * 32 + (swz % 64) / 2; }
__host__ __device__ __forceinline__ int perm32(int rho) { const int n = rho >> 4, i = rho & 15; return 8 * (i >> 2) + 4 * n + (i & 3); }

struct Unit { int pm, pn; };
struct Gemm { const bf16_t* A; const bf16_t* Bt; int M, N, K; int lda = 0, ldb = 0; };

struct StaticOrder {
    int nM, nN, nwg, G, c;
    __host__ __device__ void init(int M, int N, int G_, int c_) { nM = M / BM; nN = N / BM; nwg = nM * nN; G = G_; c = c_; }
    __host__ __device__ bool next(int i, Unit& u) const {
        const long L = (long)i * G + c; if (L >= nwg) return false;
        int wgid = (int)L; { const int q = nwg / NXCD, r = nwg % NXCD, xcd = wgid % NXCD, off = wgid / NXCD; wgid = (xcd < r ? xcd * (q + 1) : r * (q + 1) + (xcd - r) * q) + off; }
        const int nig = WGM * nN, gid = wgid / nig, fm = gid * WGM, gsz = (nM - fm) < WGM ? (nM - fm) : WGM;
        u.pm = fm + ((wgid % nig) % gsz); u.pn = (wgid % nig) / gsz; return true;
    }
    __device__ __forceinline__ void a_ready(const Unit&) const {}
    __device__ __forceinline__ void done(const Unit&) const {}
};

__device__ __forceinline__ unsigned cvt_pk_bf16(float lo, float hi) { unsigned r; asm volatile("v_cvt_pk_bf16_f32 %0, %1, %2" : "=v"(r) : "v"(lo), "v"(hi)); return r; }
typedef float f32x2 __attribute__((ext_vector_type(2)));
__device__ __forceinline__ f32x2 gelu_pk(f32x2 v) {
    const f32x2 av = __builtin_elementwise_abs(v), d = av * 0.2316418882f + 1.0f;
    f32x2 t; t.x = __builtin_amdgcn_rcpf(d.x); t.y = __builtin_amdgcn_rcpf(d.y);
    f32x2 q = t * 0.5307027145f + (-0.7265760135f); q = q * t + 0.7107068705f; q = q * t + (-0.142248368f); q = q * t + 0.127414796f; q = q * t;
    const f32x2 s = (v * v) * (-0.72134752044f);
    f32x2 e; e.x = __builtin_amdgcn_exp2f(s.x); e.y = __builtin_amdgcn_exp2f(s.y);
    const f32x2 m = v * (q * e), r = v - m;
    f32x2 o; o.x = v.x < 0.f ? m.x : r.x; o.y = v.y < 0.f ? m.y : r.y; return o;
}

template <int ACT  > struct EpiBf16 {
    static constexpr bool PERM = true, AFTER_DRAIN = false; static_assert(ACT == 0 || ACT == 1, "EpiBf16: ACT is 0 (none) or 1 (gelu_pk)");
    bf16_t* O; int ldc; const float* bias; int split_cols; size_t split_stride; float scale0;
    __device__ __forceinline__ void operator()(const f32x4 (&acc)[2][2][4][2], const Unit& u, int wr, int wc, int fr, int fq) const {
        const int row0 = u.pm * BM + wr * 64 + fr; int colt = u.pn * BM; bf16_t* base = O;
        float sc = 1.f; if (split_cols) { const int t = colt / split_cols; base += (size_t)t * split_stride; colt -= t * split_cols; if (t == 0) sc = scale0; }
        const int col0 = colt + wc * 32 + 8 * fq, bcol0 = u.pn * BM + wc * 32 + 8 * fq;
        f32x4 bv[2][2];
#pragma unroll
        for (int bj = 0; bj < 2; ++bj)
#pragma unroll
            for (int n = 0; n < 2; ++n) bv[bj][n] = bias ? *(const f32x4*)(bias + bcol0 + bj * HALF + 4 * n) : (f32x4){0.f, 0.f, 0.f, 0.f};
#pragma unroll
        for (int ai = 0; ai < 2; ++ai)
#pragma unroll
            for (int m = 0; m < 4; ++m) { bf16_t* rowp = base + (size_t)(row0 + ai * HALF + m * 16) * ldc + col0;
#pragma unroll
                for (int bj = 0; bj < 2; ++bj) { f32x4 v0 = acc[ai][bj][m][0] + bv[bj][0], v1 = acc[ai][bj][m][1] + bv[bj][1];
                    if (ACT == 1) { f32x2 a = gelu_pk((f32x2){v0[0], v0[1]}), b = gelu_pk((f32x2){v0[2], v0[3]}), c = gelu_pk((f32x2){v1[0], v1[1]}), d = gelu_pk((f32x2){v1[2], v1[3]});
                        v0 = (f32x4){a.x, a.y, b.x, b.y}; v1 = (f32x4){c.x, c.y, d.x, d.y}; }
                    v0 = v0 * sc; v1 = v1 * sc; u32x4 w; w.x = cvt_pk_bf16(v0[0], v0[1]); w.y = cvt_pk_bf16(v0[2], v0[3]); w.z = cvt_pk_bf16(v1[0], v1[1]); w.w = cvt_pk_bf16(v1[2], v1[3]);
                    *(u32x4*)(rowp + bj * HALF) = w; } }
    }
};

template <class Epi, class Sched, bool ALIGN_EPI = false, bool SP2 = false>
__device__ __forceinline__ void gemm_phase(PG8_LAS unsigned char* lds, const Gemm g, const Sched& S, const Epi& E, const int wave_in  ) {
    int tid_; asm volatile("v_mbcnt_lo_u32_b32 %0, -1, 0\n\tv_mbcnt_hi_u32_b32 %0, -1, %0" : "=v"(tid_)); tid_ += 64 * wave_in;
    const int tid = tid_, wid = __builtin_amdgcn_readfirstlane(tid >> 6), lane = tid & 63, wr = wid >> 2, wc = wid & 3, fr = lane & 15, fq = lane >> 4;
    const int K = g.K, nt = K / BK, lda = g.lda ? g.lda : K, ldb = g.ldb ? g.ldb : K;
    unsigned voffA[2], voffB[2];
#pragma unroll
    for (int i = 0; i < 2; ++i) { int R, C; stage_rc(tid * 16 + i * 8192, R, C); const int Rb = Epi::PERM ? ((R & ~31) + perm32(R & 31)) : R;
        voffA[i] = (unsigned)(R * lda + C) * 2u; voffB[i] = (unsigned)(Rb * ldb + C) * 2u; }
    const size_t kstep = (size_t)(BK * 2);
    const size_t hstepA = (size_t)HALF * lda * 2, hstepB = (size_t)HALF * ldb * 2;
    const size_t tstepA = 2 * hstepA, tstepB = 2 * hstepB;
    const unsigned ldsw = (unsigned)wid * 1024u;
    const int aoff = lds_byte(wr * 64 + fr, fq * 8), boff = lds_byte(wc * 32 + fr, fq * 8);
#define PG8_SA(b, h) (((b) * 2 + (h)) * HTB)
#define PG8_SB(b, h) ((4 + (b) * 2 + (h)) * HTB)
#define PG8_STAGE(bufoff, gbase, voff) do { _Pragma("unroll") for (int _i = 0; _i < 2; ++_i) \
        __builtin_amdgcn_global_load_lds((const unsigned*)((const char*)(gbase) + (voff)[_i]), (PG8_LAS unsigned*)(lds + (bufoff) + ldsw + _i * 8192), 16, 0, 0); } while (0)
#define PG8_LDA(dst, b, h) do { _Pragma("unroll") for (int m = 0; m < 4; ++m) _Pragma("unroll") for (int k = 0; k < 2; ++k) dst[m][k] = *(const PG8_LAS bf16x8*)(lds + PG8_SA(b, h) + aoff + m * 2048 + k * 1024); } while (0)
#define PG8_LDB(dst, b, h) do { _Pragma("unroll") for (int n = 0; n < 2; ++n) _Pragma("unroll") for (int k = 0; k < 2; ++k) dst[n][k] = *(const PG8_LAS bf16x8*)(lds + PG8_SB(b, h) + boff + n * 2048 + k * 1024); } while (0)
#define PG8_MMA(ai, bj, At, Bt) do { __builtin_amdgcn_s_setprio(1); _Pragma("unroll") for (int m = 0; m < 4; ++m) _Pragma("unroll") for (int n = 0; n < 2; ++n) _Pragma("unroll") for (int k = 0; k < 2; ++k) \
        acc[ai][bj][m][n] = __builtin_amdgcn_mfma_f32_16x16x32_bf16(Bt[n][k], At[m][k], acc[ai][bj][m][n], 0, 0, 0); __builtin_amdgcn_s_setprio(0); } while (0)
#define PG8_WAIT_V(n) asm volatile("s_waitcnt vmcnt(" #n ")" ::: "memory")
#define PG8_WAIT_L(n) asm volatile("s_waitcnt lgkmcnt(" #n ")" ::: "memory")
#define PG8_BAR __builtin_amdgcn_s_barrier()
#define PG8_SCHED __builtin_amdgcn_sched_barrier(0)
    Unit cur, nxt; int ui = 0;
    if (!S.next(0, cur)) return;
    f32x4 acc[2][2][4][2];
#pragma unroll
    for (int a = 0; a < 2; ++a)
#pragma unroll
        for (int b = 0; b < 2; ++b)
#pragma unroll
            for (int m = 0; m < 4; ++m)
#pragma unroll
                for (int n = 0; n < 2; ++n) acc[a][b][m][n] = (f32x4){0.f, 0.f, 0.f, 0.f};
    bf16x8 At[4][2], B0[2][2], B1[2][2];
    const char* cA = (const char*)g.A + (size_t)cur.pm * tstepA; const char* cB = (const char*)g.Bt + (size_t)cur.pn * tstepB;
    S.a_ready(cur);
    if constexpr (SP2) {
        PG8_STAGE(PG8_SB(0, 0), cB, voffB); PG8_STAGE(PG8_SB(0, 1), cB + hstepB, voffB); PG8_STAGE(PG8_SA(0, 0), cA, voffA); PG8_STAGE(PG8_SA(0, 1), cA + hstepA, voffA);
        if (wr == 1) PG8_BAR;
        PG8_WAIT_V(2); PG8_BAR;
        PG8_STAGE(PG8_SB(1, 0), cB + kstep, voffB); PG8_STAGE(PG8_SA(1, 0), cA + kstep, voffA); PG8_STAGE(PG8_SB(1, 1), cB + hstepB + kstep, voffB);
        PG8_WAIT_V(6); PG8_BAR;
    } else {
        PG8_STAGE(PG8_SB(0, 0), cB, voffB); PG8_STAGE(PG8_SA(0, 0), cA, voffA); PG8_STAGE(PG8_SB(0, 1), cB + hstepB, voffB); PG8_STAGE(PG8_SA(0, 1), cA + hstepA, voffA);
        if (wr == 1) PG8_BAR;
        PG8_WAIT_V(4); PG8_BAR;
        PG8_STAGE(PG8_SB(1, 0), cB + kstep, voffB); PG8_STAGE(PG8_SA(1, 0), cA + kstep, voffA); PG8_STAGE(PG8_SB(1, 1), cB + hstepB + kstep, voffB);
        PG8_WAIT_V(6); PG8_BAR;
    }
    for (;;) {
        const bool has_next = S.next(ui + 1, nxt);
        const char* nA = has_next ? (const char*)g.A + (size_t)nxt.pm * tstepA : cA; const char* nB = has_next ? (const char*)g.Bt + (size_t)nxt.pn * tstepB : cB;
        for (int t = 0; t < nt; t += 2) {
            const bool last = (t == nt - 2);
            const char* a1 = cA + (size_t)(t + 1) * kstep;
            const char* a2 = last ? nA : cA + (size_t)(t + 2) * kstep; const char* b2 = last ? nB : cB + (size_t)(t + 2) * kstep;
            const char* a3 = a2 + kstep; const char* b3 = b2 + kstep;
            if (last && has_next) S.a_ready(nxt);
            if constexpr (SP2) {
            PG8_LDB(B0, 0, 0); PG8_LDB(B1, 0, 1); PG8_SCHED; PG8_LDA(At, 0, 0); PG8_STAGE(PG8_SA(1, 1), a1 + hstepA, voffA);
            PG8_WAIT_V(8); PG8_WAIT_L(0); PG8_BAR; PG8_MMA(0, 0, At, B0); PG8_MMA(0, 1, At, B1); PG8_BAR; PG8_SCHED;
            PG8_LDA(At, 0, 1); PG8_STAGE(PG8_SB(0, 0), b2, voffB); PG8_STAGE(PG8_SB(0, 1), b2 + hstepB, voffB); PG8_STAGE(PG8_SA(0, 0), a2, voffA);
            PG8_WAIT_V(8); PG8_WAIT_L(0); PG8_BAR; PG8_MMA(1, 0, At, B0); PG8_MMA(1, 1, At, B1); PG8_BAR; PG8_SCHED;
            PG8_LDB(B0, 1, 0); PG8_LDB(B1, 1, 1); PG8_SCHED; PG8_LDA(At, 1, 0); PG8_STAGE(PG8_SA(0, 1), a2 + hstepA, voffA);
            PG8_WAIT_V(8); PG8_WAIT_L(0); PG8_BAR; PG8_MMA(0, 0, At, B0); PG8_MMA(0, 1, At, B1); PG8_BAR; PG8_SCHED;
            PG8_LDA(At, 1, 1); PG8_STAGE(PG8_SB(1, 0), b3, voffB); PG8_STAGE(PG8_SB(1, 1), b3 + hstepB, voffB); PG8_STAGE(PG8_SA(1, 0), a3, voffA);
            PG8_WAIT_V(8); PG8_WAIT_L(0); PG8_BAR; PG8_MMA(1, 0, At, B0); PG8_MMA(1, 1, At, B1); PG8_BAR; PG8_SCHED;
            } else {
            PG8_LDB(B0, 0, 0); PG8_SCHED; PG8_LDA(At, 0, 0); PG8_STAGE(PG8_SA(1, 1), a1 + hstepA, voffA);
            PG8_WAIT_L(8); PG8_BAR; PG8_WAIT_L(0); PG8_MMA(0, 0, At, B0); PG8_BAR; PG8_SCHED;
            PG8_LDB(B1, 0, 1); PG8_STAGE(PG8_SB(0, 0), b2, voffB);
            PG8_BAR; PG8_WAIT_L(0); PG8_MMA(0, 1, At, B1); PG8_BAR;
            PG8_LDA(At, 0, 1); PG8_STAGE(PG8_SA(0, 0), a2, voffA);
            PG8_BAR; PG8_WAIT_L(0); PG8_MMA(1, 0, At, B0); PG8_BAR; PG8_SCHED;
            PG8_STAGE(PG8_SB(0, 1), b2 + hstepB, voffB);
            PG8_WAIT_V(6); PG8_BAR; PG8_MMA(1, 1, At, B1); PG8_BAR;
            PG8_LDB(B0, 1, 0); PG8_SCHED; PG8_LDA(At, 1, 0); PG8_STAGE(PG8_SA(0, 1), a2 + hstepA, voffA);
            PG8_WAIT_L(8); PG8_BAR; PG8_WAIT_L(0); PG8_MMA(0, 0, At, B0); PG8_BAR; PG8_SCHED;
            PG8_LDB(B1, 1, 1); PG8_STAGE(PG8_SB(1, 0), b3, voffB);
            PG8_BAR; PG8_WAIT_L(0); PG8_MMA(0, 1, At, B1); PG8_BAR;
            PG8_LDA(At, 1, 1); PG8_STAGE(PG8_SA(1, 0), a3, voffA);
            PG8_BAR; PG8_WAIT_L(0); PG8_MMA(1, 0, At, B0); PG8_BAR; PG8_SCHED;
            PG8_STAGE(PG8_SB(1, 1), b3 + hstepB, voffB);
            PG8_WAIT_V(6); PG8_BAR; PG8_MMA(1, 1, At, B1); PG8_BAR;
            }
        }
        if constexpr (ALIGN_EPI) { if (wr == 0) PG8_BAR; }
        if constexpr (!Epi::AFTER_DRAIN) { E(acc, cur, wr, wc, fr, fq); S.done(cur); }
        if (!has_next) break;
#pragma unroll
        for (int a = 0; a < 2; ++a)
#pragma unroll
            for (int b = 0; b < 2; ++b)
#pragma unroll
                for (int m = 0; m < 4; ++m)
#pragma unroll
                    for (int n = 0; n < 2; ++n) acc[a][b][m][n] = (f32x4){0.f, 0.f, 0.f, 0.f};
        cur = nxt; cA = nA; cB = nB; ++ui;
        if constexpr (ALIGN_EPI) { if (wr == 1) PG8_BAR; }
    }
    PG8_WAIT_V(0);
    if constexpr (!ALIGN_EPI) { if (wr == 0) PG8_BAR; }
    PG8_BAR;
    if constexpr (Epi::AFTER_DRAIN) { E.fused(acc, cur, wr, wc, fr, fq, lds, wid, lane); S.done(cur); }
#undef PG8_SA
#undef PG8_SB
#undef PG8_STAGE
#undef PG8_LDA
#undef PG8_LDB
#undef PG8_MMA
#undef PG8_WAIT_V
#undef PG8_WAIT_L
#undef PG8_BAR
#undef PG8_SCHED
}
}
#define GAS __attribute__((address_space(1)))
#define LAS __attribute__((address_space(3)))
typedef unsigned short bf16;
typedef unsigned v4u __attribute__((ext_vector_type(4)));
typedef float f32x4 __attribute__((ext_vector_type(4)));
typedef short bf16x8 __attribute__((ext_vector_type(8)));
typedef GAS unsigned gu32;
typedef GAS unsigned long long gu64;
#define RLX_AGENT __ATOMIC_RELAXED, __HIP_MEMORY_SCOPE_AGENT
#define LDS_WAIT() asm volatile("s_waitcnt lgkmcnt(0)" ::: "memory")
#define VM_WAIT() asm volatile("s_waitcnt vmcnt(0)" ::: "memory")
__device__ __forceinline__ unsigned long long rt() { return __builtin_amdgcn_s_memrealtime(); }
__device__ __forceinline__ unsigned f2bf(float f) { unsigned u = __builtin_bit_cast(unsigned, f); return (u + 0x7fffu + ((u >> 16) & 1u)) >> 16; }
__device__ __forceinline__ unsigned pk2(float lo, float hi) { return f2bf(lo) | (f2bf(hi) << 16); }

#define XB_TMO      128
#define XB_XCNT(j)  (256  + 64 * (j))
#define XB_XSUB(j)  (1280 + 64 * (j))
#define XB_XGEN(j)  (2304 + 64 * (j))
#define XB_TOP      3328
#define XB_TOPGEN   3392
#define XCD_BAR_WORDS 3456
#define XB_SPIN_CAP (1u << 18)

__device__ __forceinline__ unsigned xb_ld(unsigned* p)              { return __hip_atomic_load(p, __ATOMIC_RELAXED, __HIP_MEMORY_SCOPE_AGENT); }
__device__ __forceinline__ unsigned xb_add(unsigned* p, unsigned v) { return __hip_atomic_fetch_add(p, v, __ATOMIC_RELAXED, __HIP_MEMORY_SCOPE_AGENT); }
__device__ __forceinline__ unsigned xb_xcc_id() { return (unsigned)__builtin_amdgcn_s_getreg((3 << 11) | 20) & 0xFu; }
#define XB_SPIN(cond, bar) do { unsigned _sp = 0; while (cond) { __builtin_amdgcn_s_sleep(1); \
    if ((++_sp & 255u) == 0u) { if (xb_ld(&(bar)[XB_TMO])) break; if (_sp > XB_SPIN_CAP) { atomicAdd(&(bar)[XB_TMO], 1u); break; } } } } while (0)

struct XcdBarrier {
    unsigned* bar; unsigned x;
    volatile LAS unsigned* st;
};

__device__ __forceinline__ XcdBarrier xcd_barrier_post(unsigned* bar, volatile LAS unsigned* st) {
    XcdBarrier b; b.bar = bar; b.x = xb_xcc_id(); b.st = st;
    if (threadIdx.x == 0) (void)xb_add(&bar[XB_XCNT(b.x)], 1u);
    return b;
}
__device__ __forceinline__ void xcd_barrier_complete(unsigned* bar, unsigned x, unsigned& nloc, unsigned& nx) {
    const unsigned G = gridDim.x * gridDim.y * gridDim.z;
    unsigned sum, cnt, mine, sp = 0u;
    for (;;) {
        sum = 0u; cnt = 0u; mine = 0u;
#pragma unroll
        for (unsigned j = 0; j < 16; ++j) { const unsigned c = xb_ld(&bar[XB_XCNT(j)]); sum += c; cnt += (c > 0u) ? 1u : 0u; mine = (j == x) ? c : mine; }
        if (sum == G) break;
        __builtin_amdgcn_s_sleep(1);
        if ((++sp & 255u) == 0u) { if (xb_ld(&bar[XB_TMO])) break; if (sp > XB_SPIN_CAP) { atomicAdd(&bar[XB_TMO], 1u); break; } }
    }
    nloc = mine > 0u ? mine : 1u; nx = cnt > 0u ? cnt : 1u;
}

__device__ __forceinline__ void xcd_barrier(const XcdBarrier& b) {
    asm volatile("s_waitcnt vmcnt(0)" ::: "memory");
    __syncthreads();
    if (threadIdx.x == 0) {
        unsigned* bar = b.bar;
        __builtin_amdgcn_s_waitcnt(0);
        unsigned nloc = b.st[0], nx = b.st[1];
        if (nloc == 0u) { xcd_barrier_complete(bar, b.x, nloc, nx); b.st[0] = nloc; b.st[1] = nx; }
        const unsigned old = xb_add(&bar[XB_XSUB(b.x)], 1u);
        const unsigned gen = old / nloc;
        if (old + 1u == (gen + 1u) * nloc) {
            __builtin_amdgcn_fence(__ATOMIC_RELEASE, "agent");
            asm volatile("s_waitcnt vmcnt(0)" ::: "memory");
            const unsigned og = xb_add(&bar[XB_TOP], 1u);
            const unsigned tg = og / nx;
            if (og + 1u == (tg + 1u) * nx) xb_add(&bar[XB_TOPGEN], 1u);
            else XB_SPIN(xb_ld(&bar[XB_TOPGEN]) == tg, bar);
            __builtin_amdgcn_fence(__ATOMIC_ACQUIRE, "agent");
            xb_add(&bar[XB_XGEN(b.x)], 1u);
            asm volatile("s_waitcnt vmcnt(0)" ::: "memory");
        } else {
            XB_SPIN(xb_ld(&bar[XB_XGEN(b.x)]) == gen, bar);
            __builtin_amdgcn_fence(__ATOMIC_ACQUIRE, "agent");
            asm volatile("s_waitcnt vmcnt(0)" ::: "memory");
        }
    }
    __syncthreads();
}
namespace mk {
constexpr int D_MODEL = 1024, BATCH = 4, SEQ = 4096, DEC_BATCH = 128, DEC_SEQ = 4, PAST = 8192, PAGE = 128, NPAGES = 64;
constexpr int NH = 8, NOPE = 64, ROPE = 32, QKH = 96, VH = 64, QLORA = 384, KVLORA = 256;
constexpr int DCONV = 512, CW = 31, DFF = 2816, DIN = 3744;
constexpr int MP = BATCH * SEQ, MS = DEC_BATCH * DEC_SEQ, M = MP + MS;
constexpr float EPS = 1e-6f;
constexpr float LOG2E = 1.4426950408889634f;
constexpr float QSCALE = 0.10206207261596577f * LOG2E;
constexpr size_t O_YP = 0, O_YS = O_YP + (size_t)MP * 1024, O_LATP = O_YS + (size_t)MS * 1024, O_KRP = O_LATP + (size_t)MP * 256,
                 O_CSP = O_KRP + (size_t)MP * 32, O_LATS = O_CSP + (size_t)BATCH * 30 * 512, O_KRS = O_LATS + (size_t)MS * 256,
                 O_CSS = O_KRS + (size_t)MS * 32, O_END = O_CSS + (size_t)DEC_BATCH * 30 * 512;
constexpr int NIN = 3840;
constexpr int NQP = 768;
constexpr int NGU = 2 * DFF;
constexpr int NPOS = SEQ + DEC_SEQ;

constexpr size_t al(size_t x) { return (x + 4095) / 4096 * 4096; }
constexpr size_t WS_CTL = 0, CTL_ZERO_BYTES = 1u << 20;
constexpr size_t WS_WIN = CTL_ZERO_BYTES;
constexpr size_t WS_WUQ = WS_WIN + al((size_t)NIN * 1024 * 2);
constexpr size_t WS_WKV = WS_WUQ + al((size_t)NQP * 384 * 2);
constexpr size_t WS_WC = WS_WKV + al((size_t)1024 * 256 * 2);
constexpr size_t WS_WO = WS_WC + al((size_t)1024 * 512 * 2);
constexpr size_t WS_WOUT = WS_WO + al((size_t)1024 * 512 * 2);
constexpr size_t WS_WGU = WS_WOUT + al((size_t)1024 * 1024 * 2);
constexpr size_t WS_WD = WS_WGU + al((size_t)NGU * 1024 * 2);
constexpr size_t WS_TAB = WS_WD + al((size_t)1024 * DFF * 2);
constexpr size_t WS_H = WS_TAB + al((size_t)NPOS * 32 * 4);
constexpr size_t WS_U = WS_H + al((size_t)M * 1024 * 2);
constexpr size_t WS_G = WS_U + al((size_t)M * 512 * 2);
constexpr size_t WS_RAW = WS_G + al((size_t)M * 2048 * 2);
constexpr size_t WS_CKV = WS_RAW + al((size_t)M * 768 * 4);
constexpr size_t WS_CQN = WS_CKV + al((size_t)M * 256 * 2);
constexpr size_t WS_KPE = WS_CQN + al((size_t)M * 384 * 2);
constexpr size_t WS_T = WS_KPE + al((size_t)M * 32 * 4);
constexpr size_t WS_QRAW = WS_T + al((size_t)M * 512 * 2);
constexpr size_t WS_KN = WS_QRAW + al((size_t)M * 1024 * 4);
constexpr size_t WS_V = WS_KN + al((size_t)M * 512 * 4);
constexpr size_t WS_Q = WS_V + al((size_t)M * 512 * 2);
constexpr size_t WS_K = WS_Q + al((size_t)M * 768 * 2);
constexpr size_t WS_O = WS_K + al((size_t)M * 768 * 2);
constexpr size_t WS_CONVO = WS_O + al((size_t)M * 512 * 2);
constexpr size_t WS_MERGED = WS_CONVO + al((size_t)M * 1024 * 2);
constexpr size_t WS_X1B = WS_MERGED + al((size_t)M * 1024 * 2);
constexpr size_t WS_SSQ2 = WS_X1B + al((size_t)M * 1024 * 2);
constexpr size_t WS_ACT = WS_SSQ2 + al((size_t)M * 16 * 4);
constexpr size_t WS_QLAT = WS_ACT + al((size_t)M * DFF * 2);
constexpr size_t WS_SPART = WS_QLAT + al((size_t)DEC_BATCH * 2 * 32 * 288 * 2);
constexpr size_t WS_WUK8_DECL = 0;
constexpr int SA_UNITS_PER_SEQ = 2; static_assert(SA_UNITS_PER_SEQ == 2, "WS_QLAT is sized for two units per sequence");
constexpr int SA_PART_STRIDE = 32 * 256 + 32;
constexpr size_t WS_WUK8 = WS_SPART + al((size_t)DEC_BATCH * SA_UNITS_PER_SEQ * SA_PART_STRIDE * 4);
constexpr size_t WS_PARTK = WS_WUK8 + al((size_t)512 * 256);
constexpr size_t WS_KPESSQ = WS_PARTK + al((size_t)11 * 512 * 1024 * 4);
constexpr size_t WS_SSQQ = WS_KPESSQ + al((size_t)M * 4);
constexpr size_t WS_GG = WS_SSQQ + al((size_t)M * 16 * 4);
constexpr size_t WS_RINVF = WS_GG + al(96 * 4);
constexpr size_t WS_END = WS_RINVF + al((size_t)M * 4);
constexpr int CW_BAR = 4096;
constexpr int CW_CFLAG = 32768;
constexpr int CW_DFLAG = 192;
constexpr int CW_QFLAG = 64;

constexpr int NWAVES = 8, NTHREADS = 512;
constexpr int RING_OFF = 0, RING_BYTES = 155648;
constexpr int LDSCTL_OFF = RING_BYTES, MISC_OFF = LDSCTL_OFF + 320;
constexpr int LDS_BYTES = 163840;

typedef unsigned u32x2 __attribute__((ext_vector_type(2)));
typedef float f32x2 __attribute__((ext_vector_type(2)));

__device__ __forceinline__ float bf2f(bf16 b) { return __uint_as_float((unsigned)b << 16); }
__device__ __forceinline__ float sigm(float x) { return __builtin_amdgcn_rcpf(1.0f + __builtin_amdgcn_exp2f(-x * LOG2E)); }
__device__ __forceinline__ float wave_sum(float v) {
#pragma unroll
    for (int o = 1; o < 64; o <<= 1) v += __shfl_xor(v, o);
    return v;
}
typedef __bf16 bf16x2_t __attribute__((ext_vector_type(2)));
__device__ __forceinline__ unsigned cvtpk(float lo, float hi) { f32x2 v = {lo, hi}; bf16x2_t b = __builtin_convertvector(v, bf16x2_t); return __builtin_bit_cast(unsigned, b); }
__device__ __forceinline__ v4u pack8(const f32x4 a, const f32x4 b) { v4u w; w.x = cvtpk(a[0], a[1]); w.y = cvtpk(a[2], a[3]); w.z = cvtpk(b[0], b[1]); w.w = cvtpk(b[2], b[3]); return w; }

struct Frame {
    LAS unsigned char* lds;
    volatile LAS unsigned* MISC;
    gu32* ctl;
    int tid, lane, wave, G;
    const float* in[26];
    float* out;
    unsigned char* ws;
};
#define INP(i) (F.in[i])
enum { I_XP = 0, I_XS, I_CLAT, I_CKPE, I_SCONV, I_PT, I_NMG, I_WIN, I_QAG, I_WUQ, I_KVG, I_WUK, I_WUV, I_QNG, I_KNG, I_WOM, I_CVW, I_CVB, I_LNG, I_LNB, I_WCO, I_WOUT, I_NFG, I_WG, I_WU, I_WDN };
template <class T> __device__ __forceinline__ T* wsp(const Frame& F, size_t off) { return (T*)(F.ws + off); }

__device__ __forceinline__ void tr_item(const float* Wc0, int ldw, const float* kscale, bf16* WTr0, int K, int k0, LAS float* scr, int lane) {
    float wv[32];
#pragma unroll
    for (int i = 0; i < 32; ++i) { const int kk = 2 * i + (lane >> 5); wv[i] = Wc0 ? Wc0[(size_t)(k0 + kk) * ldw + (lane & 31)] : 0.f; }
    if (kscale) {
#pragma unroll
        for (int i = 0; i < 32; ++i) wv[i] *= kscale[k0 + 2 * i + (lane >> 5)]; }
#pragma unroll
    for (int i = 0; i < 32; ++i) scr[(2 * i + (lane >> 5)) * 33 + (lane & 31)] = wv[i];
    LDS_WAIT(); asm volatile("" ::: "memory");
    const int c = lane & 7;
#pragma unroll
    for (int j = 0; j < 4; ++j) { const int n = (lane >> 3) + 8 * j; const LAS float* s = scr + (8 * c) * 33 + n;
        v4u o; o.x = pk2(s[0 * 33], s[1 * 33]); o.y = pk2(s[2 * 33], s[3 * 33]); o.z = pk2(s[4 * 33], s[5 * 33]); o.w = pk2(s[6 * 33], s[7 * 33]);
        *(GAS v4u*)(WTr0 + (size_t)n * K + k0 + 8 * c) = o; }
    LDS_WAIT(); asm volatile("" ::: "memory");
}
__device__ __forceinline__ int wuk_src_col(int n0) { const int t = n0 >> 8, bj = (n0 >> 7) & 1, wc = (n0 >> 5) & 3; return (4 * t + wc) * 64 + 32 * bj; }
__device__ __forceinline__ int wuq_src_col(int n0) { const int t = n0 >> 8, bj = (n0 >> 7) & 1, wc = (n0 >> 5) & 3;
    return (t < 2) ? (4 * t + wc) * 96 + 32 * bj : (2 * wc + bj) * 96 + 64; }
__device__ __forceinline__ int wkvt_row(int h, int d) { return 256 * (h >> 2) + 128 * (d >> 5) + 32 * (h & 3) + (d & 31); }
__device__ __forceinline__ int win_src_col(int n0) {
    if (n0 < 1024) { const int t = n0 >> 8, j = n0 & 255; return (j < 128) ? 128 * t + j : 512 + 128 * t + (j - 128); }
    if (n0 < 2048) return 1696 + (n0 - 1024);
    if (n0 < 3072) return 2720 + (n0 - 2048);
    if (n0 < 3328) return 1408 + (n0 - 3072);
    if (n0 < 3584) return 1024 + (n0 - 3328);
    if (n0 < 3712) return 1280 + (n0 - 3584);
    if (n0 < 3744) return 1664 + (n0 - 3712);
    return -1;
}
template <int SET> __device__ __forceinline__ void convert_weights(Frame& F, int gwl, int ngw) {
    LAS float* scr = (LAS float*)(F.lds + RING_OFF + F.wave * 16384);
    const int lane = F.lane;
    constexpr int I_A = 120 * 16, I_B = 24 * 6, I_C = 32 * 4, I_D = 32 * 8, I_E = 32 * 8, I_F = 32 * 16, I_G = 176 * 16, I_H = 32 * 44;
    if (SET == 0) {
        for (int it = gwl; it < I_A; it += ngw) { const int g = it / 16, kb = it % 16; const int sc = win_src_col(32 * g);
            tr_item(sc >= 0 ? INP(I_WIN) + sc : nullptr, DIN, INP(I_NMG), wsp<bf16>(F, WS_WIN) + (size_t)(32 * g) * 1024, 1024, 64 * kb, scr, lane); }
    } else if (SET == 3) {
        for (int it = gwl; it < I_B + I_C + I_D; it += ngw) {
            int r = it;
            if (r < I_B) { const int g = r / 6, kb = r % 6;
                tr_item(INP(I_WUQ) + wuq_src_col(32 * g), 768, INP(I_QAG), wsp<bf16>(F, WS_WUQ) + (size_t)(32 * g) * 384, 384, 64 * kb, scr, lane); continue; } r -= I_B;
            if (r < I_C) { const int g = r / 4, kb = r % 4;
                tr_item(g < 16 ? INP(I_WUK) + wuk_src_col(32 * g) : INP(I_WUV) + 32 * (g - 16), 512, nullptr, wsp<bf16>(F, WS_WKV) + (size_t)(32 * g) * 256, 256, 64 * kb, scr, lane); continue; } r -= I_C;
            { const int g = r / 8, kb = r % 8;
                tr_item(INP(I_WCO) + 32 * g, 1024, nullptr, wsp<bf16>(F, WS_WC) + (size_t)(32 * g) * 512, 512, 64 * kb, scr, lane); }
        }
    } else if (SET == 1) {
        for (int it = gwl; it < I_E + I_F; it += ngw) {
            int r = it;
            if (r < I_E) { const int g = r / 8, kb = r % 8;
                tr_item(INP(I_WOM) + 32 * g, 1024, nullptr, wsp<bf16>(F, WS_WO) + (size_t)(32 * g) * 512, 512, 64 * kb, scr, lane); continue; } r -= I_E;
            { const int g = r / 16, kb = r % 16;
                tr_item(INP(I_WOUT) + 32 * g, 1024, nullptr, wsp<bf16>(F, WS_WOUT) + (size_t)(32 * g) * 1024, 1024, 64 * kb, scr, lane); }
        }
    } else {
        for (int it = gwl; it < I_G + I_H; it += ngw) {
            int r = it;
            if (r < I_G) { const int g = r / 16, kb = r % 16; const int n0 = 32 * g, t = n0 >> 8, j = n0 & 255;
                tr_item(j < 128 ? INP(I_WG) + 128 * t + j : INP(I_WU) + 128 * t + (j - 128), DFF, INP(I_NFG), wsp<bf16>(F, WS_WGU) + (size_t)n0 * 1024, 1024, 64 * kb, scr, lane); continue; } r -= I_G;
            { const int g = r / 44, kb = r % 44;
                tr_item(INP(I_WDN) + 32 * g, 1024, nullptr, wsp<bf16>(F, WS_WD) + (size_t)(32 * g) * DFF, DFF, 64 * kb, scr, lane); }
        }
    }
}
__device__ __forceinline__ void css_copy(Frame& F, int first, int T) {
    const f32x4* src = (const f32x4*)INP(I_SCONV); f32x4* dst = (f32x4*)(F.out + O_CSS);
    const int total = DEC_BATCH * 26 * 128;
#pragma unroll 1
    for (int i0 = first; i0 < total; i0 += 4 * T) {
        f32x4 v[4];
#pragma unroll
        for (int k = 0; k < 4; ++k) { const int idx = i0 + k * T; if (idx < total) { const int db = idx / (26 * 128), rem = idx % (26 * 128); v[k] = src[(size_t)db * 30 * 128 + 4 * 128 + rem]; } }
#pragma unroll
        for (int k = 0; k < 4; ++k) { const int idx = i0 + k * T; if (idx < total) { const int db = idx / (26 * 128), rem = idx % (26 * 128); dst[(size_t)db * 30 * 128 + rem] = v[k]; } } }
}
__device__ __forceinline__ void p0_late(Frame& F, int gwl, int ngw, int t0, int nt);
__device__ __forceinline__ void p0_prologue(Frame& F, bool late_elsewhere) {
    const int gw = blockIdx.x * NWAVES + F.wave, NGW = F.G * NWAVES, lane = F.lane;
    convert_weights<0>(F, gw, NGW);
    bf16* H = wsp<bf16>(F, WS_H);
#pragma unroll 1
    for (int m0 = gw; m0 < M; m0 += 5 * NGW) {
        f32x4 v[5][4]; int mr[5];
#pragma unroll
        for (int k = 0; k < 5; ++k) { const int mk = m0 + k * NGW; mr[k] = (mk < M) ? mk : m0;
            const float* x = (mr[k] < MP) ? INP(I_XP) + (size_t)mr[k] * 1024 : INP(I_XS) + (size_t)(mr[k] - MP) * 1024;
#pragma unroll
            for (int j = 0; j < 4; ++j) v[k][j] = ((const GAS f32x4*)x)[lane + 64 * j]; }
#pragma unroll
        for (int k = 0; k < 5; ++k) {
            float s = 0.f;
#pragma unroll
            for (int j = 0; j < 4; ++j) s += (v[k][j].x * v[k][j].x + v[k][j].y * v[k][j].y) + (v[k][j].z * v[k][j].z + v[k][j].w * v[k][j].w);
#pragma unroll
            for (int o = 1; o < 64; o <<= 1) s += __shfl_xor(s, o);
            const float r = 1.0f / sqrtf(s * (1.0f / 1024.0f) + EPS);
            if (m0 + k * NGW < M) { GAS unsigned long long* op = (GAS unsigned long long*)(H + (size_t)mr[k] * 1024) + lane;
#pragma unroll
                for (int j = 0; j < 4; ++j) op[64 * j] = (unsigned long long)pk2(v[k][j].x * r, v[k][j].y * r) | ((unsigned long long)pk2(v[k][j].z * r, v[k][j].w * r) << 32); }
        }
    }
    if (!late_elsewhere) p0_late(F, gw, NGW, blockIdx.x * NTHREADS + F.tid, F.G * NTHREADS);
}
__device__ __forceinline__ void p0_late(Frame& F, int gwl, int ngw, int t0, int nt) {
    convert_weights<3>(F, gwl, ngw);
    { unsigned* W8 = wsp<unsigned>(F, WS_WUK8);
      for (int idx = t0; idx < 64 * 512; idx += nt) { const int cg = idx >> 9, n = idx & 511; const float* w = INP(I_WUK) + (size_t)(4 * cg) * 512 + n;
          int p = 0; p = __builtin_amdgcn_cvt_pk_fp8_f32(16.0f * w[0], 16.0f * w[512], p, false); p = __builtin_amdgcn_cvt_pk_fp8_f32(16.0f * w[1024], 16.0f * w[1536], p, true);
          W8[n * 64 + cg] = (unsigned)p; } }
    if (t0 < 96) { const int dm = (t0 < 64) ? t0 : 64 + ((t0 - 64) & 15); wsp<float>(F, WS_GG)[t0] = INP(I_QNG)[dm] * INP(I_KNG)[dm] * QSCALE; }
    float* TAB = wsp<float>(F, WS_TAB);
    for (int idx = t0; idx < NPOS * 16; idx += nt) {
        const int p = idx >> 4, j = idx & 15; const int pos = (p < SEQ) ? p : PAST + (p - SEQ);
        const float invf = 1.0f / powf(10000.0f, (float)(2 * j) / 32.0f);
        const float angf = (float)pos * invf;
        float sn_, cs_; sincosf(angf, &sn_, &cs_);
        TAB[p * 32 + j] = cs_; TAB[p * 32 + 16 + j] = sn_;
    }
}

__device__ __forceinline__ int pos_index(int row) { return row < MP ? (row & (SEQ - 1)) : SEQ + ((row - MP) & 3); }
#define EPI_FOR_ROWS _Pragma("unroll") for (int ai = 0; ai < 2; ++ai) _Pragma("unroll") for (int m = 0; m < 4; ++m)
#define EPI_ROW (row0 + u.pm * 256 + ai * 128 + wr * 64 + m * 16 + fr)
#define EPI_ROW_OPAQUE (rbase + ai * 128 + wr * 64 + m * 16 + fr)
struct EpiInProj {
    static constexpr bool PERM = true, AFTER_DRAIN = false;
    bf16* U; bf16* G; bf16* RAW; float* out; int row0 = 0;
    __device__ __forceinline__ void operator()(const f32x4 (&acc)[2][2][4][2], const pg8::Unit& u, int wr, int wc, int fr, int fq) const {
        const int cb = wc * 32 + 8 * fq;
        if (u.pn < 4) {
            const int ch = 128 * u.pn + cb;
            EPI_FOR_ROWS { const int row = EPI_ROW;
                f32x4 r0, r1;
#pragma unroll
                for (int e = 0; e < 4; ++e) { r0[e] = acc[ai][0][m][0][e] * sigm(acc[ai][1][m][0][e]); r1[e] = acc[ai][0][m][1][e] * sigm(acc[ai][1][m][1][e]); }
                *(v4u*)(U + (size_t)row * 512 + ch) = pack8(r0, r1);
                float* cs = nullptr;
                if (row < MP) { const int t = row & (SEQ - 1); if (t >= SEQ - 30) cs = out + O_CSP + ((size_t)(row >> 12) * 30 + (t - (SEQ - 30))) * 512 + ch; }
                else { const int rs = row - MP; cs = out + O_CSS + ((size_t)(rs >> 2) * 30 + 26 + (rs & 3)) * 512 + ch; }
                if (cs) { *(f32x4*)cs = r0; *(f32x4*)(cs + 4) = r1; }
            }
        } else if (u.pn < 12) {
            const int col = 256 * (u.pn - 4) + cb;
            EPI_FOR_ROWS { const int row = EPI_ROW;
#pragma unroll
                for (int bj = 0; bj < 2; ++bj) { f32x4 r0, r1;
#pragma unroll
                    for (int e = 0; e < 4; ++e) { r0[e] = sigm(acc[ai][bj][m][0][e]); r1[e] = sigm(acc[ai][bj][m][1][e]); }
                    *(v4u*)(G + (size_t)row * 2048 + col + 128 * bj) = pack8(r0, r1); }
            }
        } else {
            const int col = 256 * (u.pn - 12) + cb;
            EPI_FOR_ROWS { const int row = EPI_ROW;
#pragma unroll
                for (int bj = 0; bj < 2; ++bj) *(v4u*)(RAW + (size_t)row * 768 + col + 128 * bj) = pack8(acc[ai][bj][m][0], acc[ai][bj][m][1]);
            }
        }
    }
};
struct EpiF32 {
    static constexpr bool PERM = true, AFTER_DRAIN = false;
    float* C; int ldc; int row0 = 0;
    __device__ __forceinline__ void operator()(const f32x4 (&acc)[2][2][4][2], const pg8::Unit& u, int wr, int wc, int fr, int fq) const {
        const int col = 256 * u.pn + wc * 32 + 8 * fq;
        EPI_FOR_ROWS { const int row = EPI_ROW;
#pragma unroll
            for (int bj = 0; bj < 2; ++bj) { float* p = C + (size_t)row * ldc + col + 128 * bj; *(f32x4*)p = acc[ai][bj][m][0]; *(f32x4*)(p + 4) = acc[ai][bj][m][1]; }
        }
    }
};
struct EpiKV {
    static constexpr bool PERM = true, AFTER_DRAIN = false;
    float* KN; bf16* V; int row0 = 0;
    __device__ __forceinline__ void operator()(const f32x4 (&acc)[2][2][4][2], const pg8::Unit& u, int wr, int wc, int fr, int fq) const {
        const int col = 256 * (u.pn & 1) + wc * 32 + 8 * fq;
        if (u.pn < 2) {
            EPI_FOR_ROWS { const int row = EPI_ROW;
#pragma unroll
                for (int bj = 0; bj < 2; ++bj) { float* p = KN + (size_t)row * 512 + col + 128 * bj; *(f32x4*)p = acc[ai][bj][m][0]; *(f32x4*)(p + 4) = acc[ai][bj][m][1]; }
            }
        } else {
            EPI_FOR_ROWS { const int row = EPI_ROW;
#pragma unroll
                for (int bj = 0; bj < 2; ++bj) *(v4u*)(V + (size_t)row * 512 + col + 128 * bj) = pack8(acc[ai][bj][m][0], acc[ai][bj][m][1]);
            }
        }
    }
};
__device__ __forceinline__ void unpack8(const v4u w, float (&f)[8]) {
    f[0] = __uint_as_float(w.x << 16); f[1] = __uint_as_float(w.x & 0xffff0000u); f[2] = __uint_as_float(w.y << 16); f[3] = __uint_as_float(w.y & 0xffff0000u);
    f[4] = __uint_as_float(w.z << 16); f[5] = __uint_as_float(w.z & 0xffff0000u); f[6] = __uint_as_float(w.w << 16); f[7] = __uint_as_float(w.w & 0xffff0000u);
}
struct EpiConv {
    static constexpr bool PERM = true, AFTER_DRAIN = false;
    const bf16* G; bf16* CONVO; int row0 = 0;
    __device__ __forceinline__ void operator()(const f32x4 (&acc)[2][2][4][2], const pg8::Unit& u, int wr, int wc, int fr, int fq) const {
        const int col = 256 * u.pn + wc * 32 + 8 * fq;
        v4u gw[2][4][2];
        EPI_FOR_ROWS { const int row = EPI_ROW;
#pragma unroll
            for (int bj = 0; bj < 2; ++bj) gw[ai][m][bj] = *(const v4u*)(G + (size_t)row * 2048 + col + 128 * bj); }
        EPI_FOR_ROWS { const int row = EPI_ROW;
#pragma unroll
            for (int bj = 0; bj < 2; ++bj) { float g[8]; unpack8(gw[ai][m][bj], g);
                f32x4 r0, r1;
#pragma unroll
                for (int e = 0; e < 4; ++e) { r0[e] = acc[ai][bj][m][0][e] * g[e]; r1[e] = acc[ai][bj][m][1][e] * g[4 + e]; }
                *(v4u*)(CONVO + (size_t)row * 1024 + col + 128 * bj) = pack8(r0, r1); }
        }
    }
};
struct EpiMerge {
    static constexpr bool PERM = true, AFTER_DRAIN = false;
    const bf16* G; const bf16* CONVO; bf16* MERGED; int row0 = 0;
    __device__ __forceinline__ void operator()(const f32x4 (&acc)[2][2][4][2], const pg8::Unit& u, int wr, int wc, int fr, int fq) const {
        const int col = 256 * u.pn + wc * 32 + 8 * fq;
#pragma unroll
        for (int ai = 0; ai < 2; ++ai) {
            v4u gw[4][2], cw[4][2];
#pragma unroll
            for (int m = 0; m < 4; ++m) { const int row = EPI_ROW;
#pragma unroll
                for (int bj = 0; bj < 2; ++bj) { gw[m][bj] = *(const v4u*)(G + (size_t)row * 2048 + 1024 + col + 128 * bj); cw[m][bj] = *(const v4u*)(CONVO + (size_t)row * 1024 + col + 128 * bj); } }
#pragma unroll
            for (int m = 0; m < 4; ++m) { const int row = EPI_ROW;
#pragma unroll
                for (int bj = 0; bj < 2; ++bj) { float g[8], cv[8]; unpack8(gw[m][bj], g); unpack8(cw[m][bj], cv);
                    f32x4 r0, r1;
#pragma unroll
                    for (int e = 0; e < 4; ++e) { r0[e] = cv[e] + acc[ai][bj][m][0][e] * g[e]; r1[e] = cv[4 + e] + acc[ai][bj][m][1][e] * g[4 + e]; }
                    *(v4u*)(MERGED + (size_t)row * 1024 + col + 128 * bj) = pack8(r0, r1); } }
        }
    }
};
struct EpiOut {
    static constexpr bool PERM = true, AFTER_DRAIN = false;
    const float* xp; const float* xs; float* Y; bf16* X1B; float* SSQ2; int row0 = 0;
    __device__ __forceinline__ void operator()(const f32x4 (&acc)[2][2][4][2], const pg8::Unit& u, int wr, int wc, int fr, int fq) const {
        const int col = 256 * u.pn + wc * 32 + 8 * fq;
#pragma unroll
        for (int ai = 0; ai < 2; ++ai) {
            f32x4 xv[4][2][2];
#pragma unroll
            for (int m = 0; m < 4; ++m) { const int row = EPI_ROW;
                const float* xrow = (row < MP) ? xp + (size_t)row * 1024 : xs + (size_t)(row - MP) * 1024;
#pragma unroll
                for (int bj = 0; bj < 2; ++bj) { xv[m][bj][0] = *(const f32x4*)(xrow + col + 128 * bj); xv[m][bj][1] = *(const f32x4*)(xrow + col + 128 * bj + 4); } }
#pragma unroll
            for (int m = 0; m < 4; ++m) { const int row = EPI_ROW;
                float ss = 0.f;
#pragma unroll
                for (int bj = 0; bj < 2; ++bj) {
                    const f32x4 r0 = xv[m][bj][0] + acc[ai][bj][m][0], r1 = xv[m][bj][1] + acc[ai][bj][m][1];
                    *(v4u*)(X1B + (size_t)row * 1024 + col + 128 * bj) = pack8(r0, r1);
                    ss += (r0[0] * r0[0] + r0[1] * r0[1]) + (r0[2] * r0[2] + r0[3] * r0[3]) + (r1[0] * r1[0] + r1[1] * r1[1]) + (r1[2] * r1[2] + r1[3] * r1[3]); }
                ss += __shfl_xor(ss, 16); ss += __shfl_xor(ss, 32);
                if (fq == 0) SSQ2[(size_t)row * 16 + 4 * u.pn + wc] = ss;
            }
        }
    }
};
struct EpiGateUp {
    static constexpr bool PERM = true, AFTER_DRAIN = false;
    const float* RINVF; bf16* ACT; int row0 = 0;
    __device__ __forceinline__ void operator()(const f32x4 (&acc)[2][2][4][2], const pg8::Unit& u, int wr, int wc, int fr, int fq) const {
        const int ch = 128 * u.pn + wc * 32 + 8 * fq;
        float rv[2][4];
        EPI_FOR_ROWS { const int row = EPI_ROW; rv[ai][m] = RINVF[row]; }
        EPI_FOR_ROWS { const int row = EPI_ROW;
            const float rinv = rv[ai][m];
            f32x4 r0, r1;
#pragma unroll
            for (int e = 0; e < 4; ++e) { const float g0 = acc[ai][0][m][0][e] * rinv, u0 = acc[ai][1][m][0][e] * rinv, g1 = acc[ai][0][m][1][e] * rinv, u1 = acc[ai][1][m][1][e] * rinv;
                r0[e] = g0 * sigm(g0) * u0; r1[e] = g1 * sigm(g1) * u1; }
            *(v4u*)(ACT + (size_t)row * DFF + ch) = pack8(r0, r1);
        }
    }
};
struct EpiDown {
    static constexpr bool PERM = true, AFTER_DRAIN = false;
    float* Y; const bf16* X1B; int row0 = 0;
    __device__ __forceinline__ void operator()(const f32x4 (&acc)[2][2][4][2], const pg8::Unit& u, int wr, int wc, int fr, int fq) const {
        const int col = 256 * u.pn + wc * 32 + 8 * fq;
        v4u xw[2][4][2];
        EPI_FOR_ROWS { const int row = EPI_ROW;
#pragma unroll
            for (int bj = 0; bj < 2; ++bj) xw[ai][m][bj] = *(const v4u*)(X1B + (size_t)row * 1024 + col + 128 * bj); }
        EPI_FOR_ROWS { const int row = EPI_ROW;
#pragma unroll
            for (int bj = 0; bj < 2; ++bj) { float* yp = Y + (size_t)row * 1024 + col + 128 * bj; float f[8]; unpack8(xw[ai][m][bj], f);
                *(f32x4*)yp = (f32x4){f[0], f[1], f[2], f[3]} + acc[ai][bj][m][0]; *(f32x4*)(yp + 4) = (f32x4){f[4], f[5], f[6], f[7]} + acc[ai][bj][m][1]; }
        }
    }
};

__device__ __forceinline__ float sum_fq(float v) {
    v += __uint_as_float(__builtin_amdgcn_ds_swizzle(__float_as_uint(v), 0x401F));
    const auto r = __builtin_amdgcn_permlane32_swap(__float_as_uint(v), __float_as_uint(v), false, false);
    return __uint_as_float(r[0]) + __uint_as_float(r[1]);
}
__device__ __forceinline__ float other_half(float v, bool upper) {
    const auto r = __builtin_amdgcn_permlane32_swap(__float_as_uint(v), __float_as_uint(v), false, false);
    return __uint_as_float(upper ? r[0] : r[1]);
}
struct EpiQ3 {
    static constexpr bool PERM = true, AFTER_DRAIN = false;
    bf16* Q; float* SSQQ; const float* TAB; int row0 = 0;
    __device__ __forceinline__ void operator()(const f32x4 (&acc)[2][2][4][2], const pg8::Unit& u, int wr, int wc, int fr_in, int fq_in) const {
        int ln_; asm volatile("v_mbcnt_lo_u32_b32 %0, -1, 0\n\tv_mbcnt_hi_u32_b32 %0, -1, %0" : "=v"(ln_)); const int fr = ln_ & 15, fq = ln_ >> 4; (void)fr_in; (void)fq_in;
        int rbase = row0 + u.pm * 256; asm volatile("" : "+s"(rbase));
        if (u.pn < 2) {
            const int head = 4 * u.pn + wc;
            EPI_FOR_ROWS { const int row = EPI_ROW_OPAQUE;
                float ss = 0.f;
#pragma unroll
                for (int bj = 0; bj < 2; ++bj) { const f32x4 a = acc[ai][bj][m][0], b = acc[ai][bj][m][1];
                    ss += ((a[0] * a[0] + a[1] * a[1]) + (a[2] * a[2] + a[3] * a[3])) + ((b[0] * b[0] + b[1] * b[1]) + (b[2] * b[2] + b[3] * b[3]));
                    *(v4u*)((char*)Q + (unsigned)(__mul24(row, 1536) + (head * 96 + 32 * bj + 8 * fq) * 2)) = pack8(a, b); }
                ss = sum_fq(ss);
                if (fq == 0) *(float*)((char*)SSQQ + (unsigned)(row * 64 + head * 4)) = ss;
                asm volatile("" ::: "memory"); __builtin_amdgcn_sched_barrier(0);
            }
        } else {
            const int e0 = 8 * (fq & 1);
#pragma unroll
            for (int ai = 0; ai < 2; ++ai) {
                f32x4 tc0[4], tc1[4], ts0[4], ts1[4];
#pragma unroll
                for (int m = 0; m < 4; ++m) { const int row = EPI_ROW_OPAQUE;
                    const float* tb = (const float*)((const char*)TAB + (unsigned)(pos_index(row) * 128 + e0 * 4));
                    tc0[m] = *(const f32x4*)tb; tc1[m] = *(const f32x4*)(tb + 4); ts0[m] = *(const f32x4*)(tb + 16); ts1[m] = *(const f32x4*)(tb + 20); }
#pragma unroll
                for (int m = 0; m < 4; ++m) { const int row = EPI_ROW_OPAQUE;
                    const f32x4 c0 = tc0[m], c1 = tc1[m], s0 = ts0[m], s1 = ts1[m];
#pragma unroll
                    for (int bj = 0; bj < 2; ++bj) { f32x4 a = acc[ai][bj][m][0], b = acc[ai][bj][m][1];
                        float ss = ((a[0] * a[0] + a[1] * a[1]) + (a[2] * a[2] + a[3] * a[3])) + ((b[0] * b[0] + b[1] * b[1]) + (b[2] * b[2] + b[3] * b[3]));
                        ss = sum_fq(ss);
                        if (fq == 0) *(float*)((char*)SSQQ + (unsigned)(row * 64 + (8 + 2 * wc + bj) * 4)) = ss;
                        f32x4 oa, ob;
#pragma unroll
                        for (int e = 0; e < 4; ++e) { oa[e] = other_half(a[e], fq >= 2); ob[e] = other_half(b[e], fq >= 2); }
                        if (fq < 2) { a = a * c0 - oa * s0; b = b * c1 - ob * s1; } else { a = a * c0 + oa * s0; b = b * c1 + ob * s1; }
                        *(v4u*)((char*)Q + (unsigned)(__mul24(row, 1536) + ((2 * wc + bj) * 96 + 64 + 8 * fq) * 2)) = pack8(a, b); }
                }
                asm volatile("" ::: "memory"); __builtin_amdgcn_sched_barrier(0);
            }
        }
    }
};
struct EpiKV3 {
    static constexpr bool PERM = true, AFTER_DRAIN = false;
    bf16* K; bf16* V; const float* KPE; const float* KPESSQ; int row0 = 0;
    __device__ __forceinline__ void operator()(const f32x4 (&acc)[2][2][4][2], const pg8::Unit& u, int wr, int wc, int fr_in, int fq_in) const {
        int ln_; asm volatile("v_mbcnt_lo_u32_b32 %0, -1, 0\n\tv_mbcnt_hi_u32_b32 %0, -1, %0" : "=v"(ln_)); const int fr = ln_ & 15, fq = ln_ >> 4; (void)fr_in; (void)fq_in;
        int rbase = row0 + u.pm * 256; asm volatile("" : "+s"(rbase));
        if (u.pn >= 2) {
            const int col = 256 * (u.pn & 1) + wc * 32 + 8 * fq;
            EPI_FOR_ROWS { const int row = EPI_ROW_OPAQUE;
#pragma unroll
                for (int bj = 0; bj < 2; ++bj) *(v4u*)((char*)V + (unsigned)(row * 1024 + (col + 128 * bj) * 2)) = pack8(acc[ai][bj][m][0], acc[ai][bj][m][1]);
            }
            return;
        }
        const int head = 4 * u.pn + wc;
#pragma unroll
        for (int ai = 0; ai < 2; ++ai) {
            float kq[4]; f32x4 kv0[4], kv1[4];
#pragma unroll
            for (int m = 0; m < 4; ++m) { const int row = EPI_ROW_OPAQUE;
                kq[m] = *(const float*)((const char*)KPESSQ + (unsigned)(row * 4));
                const float* kp = (const float*)((const char*)KPE + (unsigned)(row * 128 + 32 * fq)); kv0[m] = *(const f32x4*)kp; kv1[m] = *(const f32x4*)(kp + 4); }
#pragma unroll
            for (int m = 0; m < 4; ++m) { const int row = EPI_ROW_OPAQUE;
                float ss = 0.f;
#pragma unroll
                for (int bj = 0; bj < 2; ++bj) { const f32x4 a = acc[ai][bj][m][0], b = acc[ai][bj][m][1];
                    ss += ((a[0] * a[0] + a[1] * a[1]) + (a[2] * a[2] + a[3] * a[3])) + ((b[0] * b[0] + b[1] * b[1]) + (b[2] * b[2] + b[3] * b[3])); }
                ss = sum_fq(ss);
                const float rinv = 1.0f / sqrtf((ss + kq[m]) * (1.0f / 96.0f) + EPS);
#pragma unroll
                for (int bj = 0; bj < 2; ++bj) *(v4u*)((char*)K + (unsigned)(__mul24(row, 1536) + (head * 96 + 32 * bj + 8 * fq) * 2)) = pack8(acc[ai][bj][m][0] * rinv, acc[ai][bj][m][1] * rinv);
                *(v4u*)((char*)K + (unsigned)(__mul24(row, 1536) + (head * 96 + 64 + 8 * fq) * 2)) = pack8(kv0[m] * rinv, kv1[m] * rinv);
            }
            asm volatile("" ::: "memory"); __builtin_amdgcn_sched_barrier(0);
        }
    }
};
struct EpiPart {
    static constexpr bool PERM = true, AFTER_DRAIN = false;
    float* P; int row0 = 0;
    __device__ __forceinline__ void operator()(const f32x4 (&acc)[2][2][4][2], const pg8::Unit& u, int wr, int wc, int fr, int fq) const {
        const int col = 256 * u.pn + wc * 32 + 8 * fq;
        EPI_FOR_ROWS { const int row = EPI_ROW;
#pragma unroll
            for (int bj = 0; bj < 2; ++bj) { float* p = P + (size_t)row * 1024 + col + 128 * bj; *(f32x4*)p = acc[ai][bj][m][0]; *(f32x4*)(p + 4) = acc[ai][bj][m][1]; }
        }
    }
};
struct EpiPartWT {
    static constexpr bool PERM = true, AFTER_DRAIN = false;
    float* P; int row0 = 0;
    __device__ __forceinline__ void operator()(const f32x4 (&acc)[2][2][4][2], const pg8::Unit& u, int wr, int wc, int fr, int fq) const {
        const __amdgpu_buffer_rsrc_t rs = __builtin_amdgcn_make_buffer_rsrc((void*)P, (short)0, 512 * 1024 * 4, 0x00020000);
        const int col = 256 * u.pn + wc * 32 + 8 * fq;
        EPI_FOR_ROWS { const int row = EPI_ROW;
#pragma unroll
            for (int bj = 0; bj < 2; ++bj) { const int off = (row * 1024 + col + 128 * bj) * 4;
                __builtin_amdgcn_raw_buffer_store_b128(__builtin_bit_cast(v4u, acc[ai][bj][m][0]), rs, off, 0, 16);
                __builtin_amdgcn_raw_buffer_store_b128(__builtin_bit_cast(v4u, acc[ai][bj][m][1]), rs, off + 16, 0, 16); }
        }
    }
};
struct ExtraOrder {
    pg8::StaticOrder S; int nstatic, extra, nN;
    __device__ __forceinline__ void init(int N, int G, int c, int extra_) { S.init(MP, N, G, c); nN = N / 256; const int nwg = (MP / 256) * nN; nstatic = (c < nwg) ? (nwg - c + G - 1) / G : 0; extra = extra_; }
    __device__ __forceinline__ bool next(int i, pg8::Unit& u) const { if (i < nstatic) return S.next(i, u); if (extra >= 0 && i == nstatic) { u.pm = MP / 256 + extra / nN; u.pn = extra % nN; return true; } return false; }
    __device__ __forceinline__ void a_ready(const pg8::Unit&) const {}
    __device__ __forceinline__ void done(const pg8::Unit&) const {}
};
struct QOrder {
    int c, G, nstatic, extra;
    __device__ __forceinline__ void init(int G_, int c_, int extra_) { c = c_; G = G_; nstatic = (c < 192) ? (192 - c + G - 1) / G : 0; extra = extra_; }
    __device__ __forceinline__ bool next(int i, pg8::Unit& u) const {
        if (i < nstatic) { const int L = i * G + c; u.pm = L & 63; u.pn = L >> 6; return true; }
        if (extra >= 0 && i == nstatic) { const int hi3 = (extra >= 3) ? 1 : 0; u.pm = MP / 256 + hi3; u.pn = extra - 3 * hi3; return true; }
        return false; }
    __device__ __forceinline__ void a_ready(const pg8::Unit&) const {}
    __device__ __forceinline__ void done(const pg8::Unit&) const {}
};
struct ListOrder {
    int id, nN, cnt;
    __device__ __forceinline__ bool next(int i, pg8::Unit& u) const { if (i >= cnt) return false; u.pm = (id + i) / nN; u.pn = (id + i) % nN; return true; }
    __device__ __forceinline__ void a_ready(const pg8::Unit&) const {}
    __device__ __forceinline__ void done(const pg8::Unit&) const {}
};
constexpr int OUT_SPLIT = 4, DOWN_SPLIT = 11;
__device__ __forceinline__ void fixup_out_row(Frame& F, int r) {
    const int lane = F.lane; const float* part = wsp<float>(F, WS_PARTK) + (size_t)r * 1024;
    const float* xrow = INP(I_XS) + (size_t)r * 1024; float* y = F.out + O_YS + (size_t)r * 1024; bf16* xb = wsp<bf16>(F, WS_X1B) + (size_t)(MP + r) * 1024;
    f32x4 xv[4], pv[4][OUT_SPLIT];
#pragma unroll
    for (int j = 0; j < 4; ++j) { const int col = 4 * lane + 256 * j; xv[j] = *(const f32x4*)(xrow + col);
#pragma unroll
        for (int ch = 0; ch < OUT_SPLIT; ++ch) pv[j][ch] = *(const f32x4*)(part + (size_t)ch * 512 * 1024 + col); }
    float ss = 0.f;
#pragma unroll
    for (int j = 0; j < 4; ++j) { const int col = 4 * lane + 256 * j; f32x4 v = xv[j];
#pragma unroll
        for (int ch = 0; ch < OUT_SPLIT; ++ch) v += pv[j][ch];
        *(f32x4*)(y + col) = v; *(u32x2*)(xb + col) = (u32x2){pk2(v.x, v.y), pk2(v.z, v.w)}; ss += (v.x * v.x + v.y * v.y) + (v.z * v.z + v.w * v.w); }
    ss = wave_sum(ss);
    if (lane == 0) wsp<float>(F, WS_RINVF)[MP + r] = 1.0f / sqrtf(ss * (1.0f / 1024.0f) + EPS);
}
__device__ __forceinline__ void rinvf_rows(Frame& F, int t0, int nt) {
    for (int r = t0; r < MP; r += nt) { const f32x4* sp = (const f32x4*)(wsp<float>(F, WS_SSQ2) + (size_t)r * 16); const f32x4 s0 = sp[0], s1 = sp[1], s2 = sp[2], s3 = sp[3];
        const float ss = ((s0[0] + s0[1]) + (s0[2] + s0[3])) + ((s1[0] + s1[1]) + (s1[2] + s1[3])) + ((s2[0] + s2[1]) + (s2[2] + s2[3])) + ((s3[0] + s3[1]) + (s3[2] + s3[3]));
        wsp<float>(F, WS_RINVF)[r] = 1.0f / sqrtf(ss * (1.0f / 1024.0f) + EPS); }
}
__device__ __forceinline__ void fixup_down_row(Frame& F, int r) {
    const int lane = F.lane; const float* part = wsp<float>(F, WS_PARTK) + (size_t)r * 1024; float* y = F.out + O_YS + (size_t)r * 1024;
#pragma unroll
    for (int jh = 0; jh < 2; ++jh) {
        f32x4 yv[2], pv[2][DOWN_SPLIT];
#pragma unroll
        for (int jj = 0; jj < 2; ++jj) { const int col = 4 * lane + 256 * (2 * jh + jj); yv[jj] = *(const f32x4*)(y + col);
#pragma unroll
            for (int ch = 0; ch < DOWN_SPLIT; ++ch) pv[jj][ch] = *(const f32x4*)(part + (size_t)ch * 512 * 1024 + col); }
#pragma unroll
        for (int jj = 0; jj < 2; ++jj) { const int col = 4 * lane + 256 * (2 * jh + jj); f32x4 v = yv[jj];
#pragma unroll
            for (int ch = 0; ch < DOWN_SPLIT; ++ch) v += pv[jj][ch];
            *(f32x4*)(y + col) = v; }
    }
}

struct P2aIn { u32x2 vw; unsigned qw[3]; unsigned short x1, x2; float cs, sn; };
__device__ __forceinline__ void p2a_load(Frame& F, int row, P2aIn& in) {
    const int lane = F.lane, j = lane & 15;
    const bf16* raw = wsp<bf16>(F, WS_RAW) + (size_t)row * 768;
    in.vw = *(const u32x2*)(raw + 4 * lane);
#pragma unroll
    for (int i = 0; i < 3; ++i) in.qw[i] = *(const unsigned*)(raw + 256 + 2 * lane + 128 * i);
    in.x1 = raw[640 + j]; in.x2 = raw[656 + j];
    const float* tb = wsp<float>(F, WS_TAB) + pos_index(row) * 32; in.cs = tb[j]; in.sn = tb[16 + j];
}
__device__ __forceinline__ void p2a_row(Frame& F, int row, const P2aIn& in) {
    const int lane = F.lane;
    {
        const u32x2 vw = in.vw;
        const f32x4 v = (f32x4){__uint_as_float(vw.x << 16), __uint_as_float(vw.x & 0xffff0000u), __uint_as_float(vw.y << 16), __uint_as_float(vw.y & 0xffff0000u)};
        const float ss = wave_sum((v.x * v.x + v.y * v.y) + (v.z * v.z + v.w * v.w));
        const float rinv = 1.0f / sqrtf(ss * (1.0f / 256.0f) + EPS);
        const f32x4 g = *(const f32x4*)(INP(I_KVG) + 4 * lane);
        const f32x4 o = v * rinv * g;
        float* lat = (row < MP) ? F.out + O_LATP + (size_t)row * 256 : F.out + O_LATS + (size_t)(row - MP) * 256;
        *(f32x4*)(lat + 4 * lane) = o;
        *(u32x2*)(wsp<bf16>(F, WS_CKV) + (size_t)row * 256 + 4 * lane) = (u32x2){pk2(o.x, o.y), pk2(o.z, o.w)};
    }
    {
        f32x2 q[3]; float ss = 0.f;
#pragma unroll
        for (int i = 0; i < 3; ++i) { const unsigned w = in.qw[i]; q[i] = (f32x2){__uint_as_float(w << 16), __uint_as_float(w & 0xffff0000u)}; ss += q[i].x * q[i].x + q[i].y * q[i].y; }
        const float rinv = 1.0f / sqrtf(wave_sum(ss) * (1.0f / 384.0f) + EPS);
#pragma unroll
        for (int i = 0; i < 3; ++i) *(unsigned*)(wsp<bf16>(F, WS_CQN) + (size_t)row * 384 + 2 * lane + 128 * i) = pk2(q[i].x * rinv, q[i].y * rinv);
    }
    {
        const float x1 = bf2f(in.x1), x2 = bf2f(in.x2), cs = in.cs, s = in.sn;
        const float o = ((lane & 31) < 16) ? (x1 * cs - x2 * s) : (x2 * cs + x1 * s);
        float s2 = o * o; s2 += __shfl_xor(s2, 1); s2 += __shfl_xor(s2, 2); s2 += __shfl_xor(s2, 4); s2 += __shfl_xor(s2, 8); s2 += __shfl_xor(s2, 16);
        if (lane < 32) { float* kr = (row < MP) ? F.out + O_KRP + (size_t)row * 32 : F.out + O_KRS + (size_t)(row - MP) * 32;
            kr[lane] = o; wsp<float>(F, WS_KPE)[(size_t)row * 32 + lane] = o;
            if (lane == 0) wsp<float>(F, WS_KPESSQ)[row] = s2; }
    }
}
__device__ __forceinline__ void p2a_rows(Frame& F, int gw, int NGW) {
#pragma unroll 1
    for (int m0 = gw; m0 < M; m0 += 5 * NGW) {
        P2aIn in[5];
#pragma unroll
        for (int k = 0; k < 5; ++k) { const int mk = m0 + k * NGW; p2a_load(F, mk < M ? mk : m0, in[k]); }
#pragma unroll
        for (int k = 0; k < 5; ++k) { const int mk = m0 + k * NGW; if (mk < M) p2a_row(F, mk, in[k]); }
    }
}
__device__ __forceinline__ void qlat_job(Frame& F, int db, int h, bf16* qlat  ) {
    const int lane = F.lane; const float* GG = wsp<float>(F, WS_GG);
    float a[4], ar[4];
#pragma unroll
    for (int qi = 0; qi < 4; ++qi) { const size_t row = (size_t)(MP + db * 4 + qi); const bf16* q = wsp<bf16>(F, WS_Q) + row * 768 + h * 96; const float* sq = wsp<float>(F, WS_SSQQ) + row * 16;
        const float rinv = 1.0f / sqrtf((sq[h] + sq[8 + h]) * (1.0f / 96.0f) + EPS);
        a[qi] = bf2f(q[lane]) * rinv * GG[lane]; ar[qi] = bf2f(q[64 + (lane & 31)]) * rinv * GG[64 + (lane & 31)]; }
    const bf16* W = wsp<bf16>(F, WS_WKV) + (size_t)(256 * (h >> 2) + 32 * (h & 3)) * 256 + 2 * lane;
    float acc[4][2][2];
#pragma unroll
    for (int qi = 0; qi < 4; ++qi)
#pragma unroll
        for (int i = 0; i < 2; ++i) { acc[qi][i][0] = 0.f; acc[qi][i][1] = 0.f; }
#pragma unroll 1
    for (int half = 0; half < 2; ++half) {
        unsigned wv[32][2];
#pragma unroll
        for (int dd = 0; dd < 32; ++dd)
#pragma unroll
            for (int i = 0; i < 2; ++i) wv[dd][i] = *(const unsigned*)(W + (size_t)(128 * half + dd) * 256 + 128 * i);
#pragma unroll
        for (int dd = 0; dd < 32; ++dd)
#pragma unroll
            for (int qi = 0; qi < 4; ++qi) { const float ad = __uint_as_float(__builtin_amdgcn_readlane(__float_as_uint(a[qi]), 32 * half + dd));
#pragma unroll
                for (int i = 0; i < 2; ++i) { acc[qi][i][0] += ad * __uint_as_float(wv[dd][i] << 16); acc[qi][i][1] += ad * __uint_as_float(wv[dd][i] & 0xffff0000u); } }
    }
#pragma unroll
    for (int qi = 0; qi < 4; ++qi) { bf16* o = qlat + (h * 4 + qi) * 288;
#pragma unroll
        for (int i = 0; i < 2; ++i) *(unsigned*)(o + 2 * lane + 128 * i) = pk2(acc[qi][i][0], acc[qi][i][1]);
        if (lane < 32) o[256 + lane] = (bf16)f2bf(ar[qi]); }
}

constexpr int CONV_ITEMS = BATCH * (SEQ / 32) + DEC_BATCH;
__device__ __forceinline__ void conv_item(Frame& F, int item) {
    const int c = F.tid, lane = F.lane;
    const bf16* U = wsp<bf16>(F, WS_U);
    LAS float* Y = (LAS float*)(F.lds + RING_OFF);
    LAS bf16* UT = (LAS bf16*)(F.lds + RING_OFF + 65536);
    int rowbase, nrows;
    if (item < BATCH * (SEQ / 32)) {
        const int seq = item >> 7, t0 = (item & 127) * 32; rowbase = seq * SEQ + t0; nrows = 32;
#pragma unroll
        for (int i = 0; i < 8; ++i) { const int id = c + 512 * i; if (id < 62 * 64) { const int j = id >> 6, part = id & 63; const int tt = t0 - 30 + j;
            v4u v = (v4u){0u, 0u, 0u, 0u}; if (tt >= 0) v = *(const v4u*)(U + (size_t)(seq * SEQ + tt) * 512 + 8 * part);
            *(LAS v4u*)(UT + j * 512 + 8 * part) = v; } }
    } else {
        const int db = item - BATCH * (SEQ / 32); rowbase = MP + db * 4; nrows = 4;
#pragma unroll
        for (int i = 0; i < 8; ++i) { const int id = c + 512 * i; if (id < 62 * 64) { const int j = id >> 6, part = id & 63;
            v4u v = (v4u){0u, 0u, 0u, 0u};
            if (j < 30) { const float* s = INP(I_SCONV) + ((size_t)db * 30 + j) * 512 + 8 * part; const f32x4 a = *(const f32x4*)s, b2 = *(const f32x4*)(s + 4); v = (v4u){pk2(a.x, a.y), pk2(a.z, a.w), pk2(b2.x, b2.y), pk2(b2.z, b2.w)}; }
            else if (j < 34) v = *(const v4u*)(U + (size_t)(MP + db * 4 + (j - 30)) * 512 + 8 * part);
            *(LAS v4u*)(UT + j * 512 + 8 * part) = v; } }
    }
    float cw[CW];
#pragma unroll
    for (int w = 0; w < CW; ++w) cw[w] = INP(I_CVW)[w * 512 + c];
    const float bias = INP(I_CVB)[c];
    __syncthreads();
    float win[62];
#pragma unroll
    for (int j = 0; j < 62; ++j) win[j] = bf2f(UT[j * 512 + c]);
#pragma unroll
    for (int i = 0; i < 32; ++i) { float y = bias;
#pragma unroll
        for (int w = 0; w < CW; ++w) y += cw[w] * win[i + w];
        Y[i * 512 + c] = y; }
    __syncthreads();
    const f32x4 lg0 = *(const f32x4*)(INP(I_LNG) + 8 * lane), lg1 = *(const f32x4*)(INP(I_LNG) + 8 * lane + 4), lb0 = *(const f32x4*)(INP(I_LNB) + 8 * lane), lb1 = *(const f32x4*)(INP(I_LNB) + 8 * lane + 4);
#pragma unroll
    for (int rr = 0; rr < 4; ++rr) { const int i = 4 * F.wave + rr;
        if (i < nrows) {
            f32x4 a = *(const LAS f32x4*)(Y + i * 512 + 8 * lane), b = *(const LAS f32x4*)(Y + i * 512 + 8 * lane + 4);
            const float mean = wave_sum(((a.x + a.y) + (a.z + a.w)) + ((b.x + b.y) + (b.z + b.w))) * (1.0f / 512.0f);
            a = a - mean; b = b - mean;
            const float var = wave_sum(((a.x * a.x + a.y * a.y) + (a.z * a.z + a.w * a.w)) + ((b.x * b.x + b.y * b.y) + (b.z * b.z + b.w * b.w))) * (1.0f / 512.0f);
            const float rstd = 1.0f / sqrtf(var + EPS);
            f32x4 r0 = a * rstd * lg0 + lb0, r1 = b * rstd * lg1 + lb1;
#pragma unroll
            for (int e = 0; e < 4; ++e) { r0[e] = r0[e] * sigm(r0[e]); r1[e] = r1[e] * sigm(r1[e]); }
            *(v4u*)(wsp<bf16>(F, WS_T) + (size_t)(rowbase + i) * 512 + 8 * lane) = pack8(r0, r1);
        } }
    __syncthreads();
}
}
namespace mk {
typedef float f32x16 __attribute__((ext_vector_type(16)));
typedef short s16x4 __attribute__((ext_vector_type(4)));
typedef short v4i16_t __attribute__((ext_vector_type(4)));
typedef int v8i_t __attribute__((ext_vector_type(8)));
__device__ __forceinline__ int crow(int r, int hi) { return (r & 3) + 8 * (r >> 2) + 4 * hi; }
__device__ __forceinline__ s16x4 tr_read(const LAS unsigned char* p) { return __builtin_bit_cast(s16x4, __builtin_amdgcn_ds_read_tr16_b64_v4i16((LAS v4i16_t*)p)); }
__device__ __forceinline__ bf16x8 lds_b128(const LAS unsigned char* p) { return *(const LAS bf16x8*)p; }

__device__ __forceinline__ float attn_bound(Frame& F) {
    const int lane = F.lane;
    float gq = fabsf(INP(I_QNG)[lane]), gk = fabsf(INP(I_KNG)[lane]);
    if (lane < 16) { gq = fmaxf(gq, fabsf(INP(I_QNG)[64 + lane])); gk = fmaxf(gk, fabsf(INP(I_KNG)[64 + lane])); }
#pragma unroll
    for (int o = 1; o < 64; o <<= 1) { gq = fmaxf(gq, __shfl_xor(gq, o)); gk = fmaxf(gk, __shfl_xor(gk, o)); }
    return 9.7979589711f * gq * gk * LOG2E * 1.02f + 0.05f;
}

constexpr int PA_KP = 208, PA_VP = 144;
constexpr int PA_KB = 0, PA_KBSZ = 128 * PA_KP, PA_VB = 2 * PA_KBSZ, PA_VBSZ = 128 * PA_VP, PA_LW = PA_VB + 2 * PA_VBSZ;
__device__ __forceinline__ void attn_prompt_unit(Frame& F, int b, int h, int qb, float B2) {
    const int tid = F.tid, lane = F.lane, wave = F.wave, r32 = lane & 31, hi = lane >> 5;
    const bf16* Qg = wsp<bf16>(F, WS_Q); const bf16* Kg = wsp<bf16>(F, WS_K); const bf16* Vg = wsp<bf16>(F, WS_V); bf16* Og = wsp<bf16>(F, WS_O);
    const size_t rowbase = (size_t)b * SEQ;
    const int q0 = qb * 256 + wave * 32;
    LAS unsigned char* ring = F.lds + RING_OFF;
    bf16x8 qr[6];
#pragma unroll
    for (int s = 0; s < 6; ++s) qr[s] = *(const bf16x8*)(Qg + (rowbase + q0 + r32) * 768 + h * 96 + 16 * s + 8 * hi);
    {
        const float* sq = wsp<float>(F, WS_SSQQ) + (rowbase + q0 + r32) * 16; const float rq = 1.0f / sqrtf((sq[h] + sq[8 + h]) * (1.0f / 96.0f) + EPS);
#pragma unroll
        for (int s = 0; s < 6; ++s) { float f[8]; unpack8(__builtin_bit_cast(v4u, qr[s]), f);
            const float* gg = wsp<float>(F, WS_GG) + 16 * s + 8 * hi; const f32x4 g0 = *(const f32x4*)gg * rq, g1 = *(const f32x4*)(gg + 4) * rq;
            v4u w; w.x = cvtpk(f[0] * g0[0], f[1] * g0[1]); w.y = cvtpk(f[2] * g0[2], f[3] * g0[3]); w.z = cvtpk(f[4] * g1[0], f[5] * g1[1]); w.w = cvtpk(f[6] * g1[2], f[7] * g1[3]); qr[s] = __builtin_bit_cast(bf16x8, w); } }
    f32x16 o0, o1;
#pragma unroll
    for (int r = 0; r < 16; ++r) { o0[r] = 0.f; o1[r] = 0.f; }
    float lsum = 0.f;
    const int NT = 2 * qb + 2;
    unsigned koff[3]; int kdst[3]; unsigned voff[2]; int vdst[2];
#pragma unroll
    for (int i = 0; i < 3; ++i) { const int id = tid + 512 * i, key = id / 12, part = id % 12; koff[i] = (unsigned)(key * 768 + 8 * part); kdst[i] = PA_KB + key * PA_KP + part * 16; }
#pragma unroll
    for (int i = 0; i < 2; ++i) { const int id = tid + 512 * i, key = id >> 3, part = id & 7; voff[i] = (unsigned)(key * 512 + 8 * part); vdst[i] = PA_VB + key * PA_VP + part * 16; }
    const bf16* Kb0 = Kg + rowbase * 768 + h * 96; const bf16* Vb0 = Vg + rowbase * 512 + h * 64;
    v4u kreg[3], vreg[2];
#define PA_LOAD(t) do { const bf16* kt_ = Kb0 + (size_t)(t) * 128 * 768; const bf16* vt_ = Vb0 + (size_t)(t) * 128 * 512; \
                        _Pragma("unroll") for (int i_ = 0; i_ < 3; ++i_) kreg[i_] = *(const v4u*)(kt_ + koff[i_]); \
                        _Pragma("unroll") for (int i_ = 0; i_ < 2; ++i_) vreg[i_] = *(const v4u*)(vt_ + voff[i_]); } while (0)
#define PA_STORE(buf) do { _Pragma("unroll") for (int i_ = 0; i_ < 3; ++i_) *(LAS v4u*)(ring + (buf) * PA_KBSZ + kdst[i_]) = kreg[i_]; \
                           _Pragma("unroll") for (int i_ = 0; i_ < 2; ++i_) *(LAS v4u*)(ring + (buf) * PA_VBSZ + vdst[i_]) = vreg[i_]; } while (0)
    PA_LOAD(0);
    const int tl = lane & 15, g4 = lane >> 4;
    const int vtr_off = (4 * hi + (tl >> 2)) * PA_VP + (16 * (g4 & 1) + 4 * (tl & 3)) * 2;
    for (int t = 0; t < NT; ++t) {
        const int buf = t & 1;
        PA_STORE(buf);
        __syncthreads();
        if (t + 1 < NT) PA_LOAD(t + 1);
#pragma unroll 1
        for (int sub = 0; sub < 2; ++sub) {
            const int t64 = 2 * t + sub;
            if (64 * t64 > q0 + 31) continue;
            const LAS unsigned char* kb = ring + PA_KB + buf * PA_KBSZ + (64 * sub + r32) * PA_KP + hi * 16;
            f32x16 p0, p1;
#pragma unroll
            for (int r = 0; r < 16; ++r) { p0[r] = -B2; p1[r] = -B2; }
#pragma unroll
            for (int s = 0; s < 6; ++s) {
                const bf16x8 a0 = lds_b128(kb + s * 32), a1 = lds_b128(kb + 32 * PA_KP + s * 32);
                p0 = __builtin_amdgcn_mfma_f32_32x32x16_bf16(a0, qr[s], p0, 0, 0, 0);
                p1 = __builtin_amdgcn_mfma_f32_32x32x16_bf16(a1, qr[s], p1, 0, 0, 0);
            }
#pragma unroll
            for (int r = 0; r < 16; ++r) { p0[r] = __builtin_amdgcn_exp2f(p0[r]); p1[r] = __builtin_amdgcn_exp2f(p1[r]); }
            if (t64 >= 4 * qb) {
                const int qq = q0 + r32, k0 = 64 * t64 + 4 * hi;
#pragma unroll
                for (int r = 0; r < 16; ++r) { const int kk = k0 + (r & 3) + 8 * (r >> 2); if (kk > qq) p0[r] = 0.f; if (kk + 32 > qq) p1[r] = 0.f; }
            }
            float sacc = 0.f;
#pragma unroll
            for (int r = 0; r < 16; ++r) sacc += p0[r] + p1[r];
            lsum += sacc;
            const LAS unsigned char* vb = ring + PA_VB + buf * PA_VBSZ + 64 * sub * PA_VP + vtr_off;
#pragma unroll
            for (int mt = 0; mt < 2; ++mt)
#pragma unroll
                for (int s = 0; s < 2; ++s) {
                    const f32x16& p = mt ? p1 : p0;
                    v4u pw; pw.x = cvtpk(p[8 * s + 0], p[8 * s + 1]); pw.y = cvtpk(p[8 * s + 2], p[8 * s + 3]); pw.z = cvtpk(p[8 * s + 4], p[8 * s + 5]); pw.w = cvtpk(p[8 * s + 6], p[8 * s + 7]);
                    const bf16x8 pa = __builtin_bit_cast(bf16x8, pw);
                    const LAS unsigned char* vk = vb + (32 * mt + 16 * s) * PA_VP;
#pragma unroll
                    for (int d0 = 0; d0 < 2; ++d0) {
                        const s16x4 lo = tr_read(vk + d0 * 64), h4 = tr_read(vk + d0 * 64 + 8 * PA_VP);
                        const bf16x8 vf = (bf16x8){lo[0], lo[1], lo[2], lo[3], h4[0], h4[1], h4[2], h4[3]};
                        if (d0 == 0) o0 = __builtin_amdgcn_mfma_f32_32x32x16_bf16(pa, vf, o0, 0, 0, 0); else o1 = __builtin_amdgcn_mfma_f32_32x32x16_bf16(pa, vf, o1, 0, 0, 0);
                    }
                }
        }
    }
#undef PA_LOAD
#undef PA_STORE
    lsum += __shfl_xor(lsum, 32);
    LAS float* lw = (LAS float*)(ring + PA_LW) + wave * 32;
    if (hi == 0) lw[r32] = lsum;
    LDS_WAIT(); asm volatile("" ::: "memory");
    bf16* orow = Og + (rowbase + q0) * 512 + h * 64 + r32;
#pragma unroll
    for (int r = 0; r < 16; ++r) { const int q = crow(r, hi); const float inv = 1.0f / lw[q];
        orow[(size_t)q * 512] = (bf16)f2bf(o0[r] * inv); orow[(size_t)q * 512 + 32] = (bf16)f2bf(o1[r] * inv); }
    LDS_WAIT(); asm volatile("" ::: "memory");
}
__device__ __forceinline__ void attn_prompt_phase(Frame& F) {
    const float B2 = attn_bound(F);
    for (int p = blockIdx.x; p < BATCH * NH * 8; p += F.G) {
        const int bh = p >> 3, s = p & 7;
        attn_prompt_unit(F, bh >> 3, bh & 7, s, B2);
        attn_prompt_unit(F, bh >> 3, bh & 7, 15 - s, B2);
    }
    __syncthreads();
}

#ifndef SA_EXP
#define SA_EXP 0
#endif
#ifdef SA_PROF
#define SA_T(k) do { const unsigned t_ = (unsigned)__builtin_readcyclecounter(); if ((k) == SA_PROFK) prof_acc += (float)(t_ - prof_t); prof_t = t_; } while (0)
#else
#define SA_T(k) do {} while (0)
#endif
constexpr int SA_CP = 592;
constexpr int SA_CB = 0, SA_CBSZ = 64 * SA_CP, SA_PB = 2 * SA_CBSZ, SA_PP = 144, SA_RINV = SA_PB + 32 * SA_PP, SA_QL = SA_RINV + 8 * 64 * 4, SA_LSW = SA_QL + 32 * SA_CP, SA_C8 = SA_LSW + 8 * 16 * 4 + 64 * 4, SA_C8P = 272, SA_C8SZ = 64 * SA_C8P, SA_END = SA_C8 + 2 * SA_C8SZ;
static_assert(SA_END <= RING_BYTES, "sample attention LDS");
constexpr int SA_NUNITS = DEC_BATCH * SA_UNITS_PER_SEQ;
__device__ __forceinline__ bf16x8 fp8x8_to_bf16x8(const u32x2 w) {
    const f32x2 f0 = __builtin_amdgcn_cvt_pk_f32_fp8((int)w.x, false), f1 = __builtin_amdgcn_cvt_pk_f32_fp8((int)w.x, true), f2 = __builtin_amdgcn_cvt_pk_f32_fp8((int)w.y, false), f3 = __builtin_amdgcn_cvt_pk_f32_fp8((int)w.y, true);
    v4u o; o.x = cvtpk(f0.x, f0.y); o.y = cvtpk(f1.x, f1.y); o.z = cvtpk(f2.x, f2.y); o.w = cvtpk(f3.x, f3.y);
    return __builtin_bit_cast(bf16x8, o);
}
__device__ __forceinline__ void attn_combine_job(Frame& F, const int db, const int h);
template <int MODE  > __device__ __forceinline__ void attn_sample_phase(Frame& F) {
    const int tid = F.tid, lane = F.lane, wave = F.wave, r32 = lane & 31, hi = lane >> 5, tl = lane & 15, g4 = lane >> 4;
    const float B2 = attn_bound(F);
    LAS unsigned char* ring = F.lds + RING_OFF;
    const float* clat = INP(I_CLAT); const float* ckpe = INP(I_CKPE); const int* ptab = (const int*)INP(I_PT);
    LAS float* RINV = (LAS float*)(ring + SA_RINV);
    LAS float* LSW = (LAS float*)(ring + SA_LSW);
    LAS float* KSQ = (LAS float*)(ring + SA_LSW) + 8 * 16;
    const int slot = blockIdx.x, nslots = F.G;
    const int nunits_cu = (slot < SA_NUNITS) ? (SA_NUNITS - slot + nslots - 1) / nslots : 0;
#pragma unroll 1
    for (int k = 0; k < nunits_cu; ++k) { const int un = slot + k * nslots; qlat_job(F, un >> 1, wave, wsp<bf16>(F, WS_QLAT) + (size_t)un * 32 * 288); }
    __builtin_amdgcn_fence(__ATOMIC_RELEASE, "workgroup"); __syncthreads(); __builtin_amdgcn_fence(__ATOMIC_ACQUIRE, "workgroup");
    v8i_t wa8[2][4];
    { const unsigned char* W = wsp<unsigned char>(F, WS_WUK8) + (size_t)(wave * 64 + r32) * 256 + 32 * hi;
#pragma unroll
      for (int mt = 0; mt < 2; ++mt)
#pragma unroll
          for (int ks = 0; ks < 4; ++ks) { const v4u lo_ = *(const v4u*)(W + (size_t)(32 * mt) * 256 + 64 * ks), hi_ = *(const v4u*)(W + (size_t)(32 * mt) * 256 + 64 * ks + 16);
              wa8[mt][ks] = (v8i_t){(int)lo_.x, (int)lo_.y, (int)lo_.z, (int)lo_.w, (int)hi_.x, (int)hi_.y, (int)hi_.z, (int)hi_.w}; } }
    asm volatile("s_waitcnt vmcnt(0)" ::: "memory");
    const int sc_row = 16 * (wave & 1) + tl, sc_key = 16 * (wave >> 1) + tl;
    const int p_key = sc_key, p_hh = 4 * (wave & 1) + g4;
#ifdef SA_PROF
    float prof_acc = 0.f; unsigned prof_t = (unsigned)__builtin_readcyclecounter(); const unsigned prof_t0 = prof_t; const unsigned long long prof_rt0 = __builtin_amdgcn_s_memrealtime();
#endif
    f32x4 preA[9], preB[9];
    const unsigned voff16 = (unsigned)tid * 16u;
    const int st_b16 = (tid >> 6) * SA_CP + (tid & 63) * 8, st_b8 = (tid >> 6) * SA_C8P + (tid & 63) * 4, st_kpe = (tid >> 3) * SA_CP + 512 + (tid & 7) * 8;
    for (int k0 = 0; k0 < nunits_cu; k0 += 2) {
        const int nk = (nunits_cu - k0 < 2) ? nunits_cu - k0 : 2, NT = nk * 64;
        int physv = 0;
        { const int k = lane >> 5; if (k < nk) { const int un = slot + (k0 + k) * nslots; physv = ptab[(un >> 1) * NPAGES + 32 * (un & 1) + (lane & 31)]; } }
#define SA_LOAD(PRE, T) do { const int phys_ = __builtin_amdgcn_readlane(physv, (T) >> 1); \
            const float* lat_ = clat + ((size_t)phys_ * PAGE + ((T) & 1) * 64) * KVLORA; const float* kp_ = ckpe + ((size_t)phys_ * PAGE + ((T) & 1) * 64) * ROPE; \
            _Pragma("unroll") for (int j_ = 0; j_ < 8; ++j_) { const char* bj_ = (const char*)lat_ + 8192 * j_; PRE[j_] = __builtin_nontemporal_load((const f32x4*)(bj_ + voff16)); } \
            PRE[8] = __builtin_nontemporal_load((const f32x4*)((const char*)kp_ + voff16)); } while (0)
#define SA_STORE(PRE, buf) do { LAS unsigned char* cb_ = ring + SA_CB + (buf) * SA_CBSZ; \
            LAS unsigned char* c8_ = ring + SA_C8 + (buf) * SA_C8SZ; \
            _Pragma("unroll") for (int j_ = 0; j_ < 8; ++j_) { *(LAS u32x2*)(cb_ + st_b16 + j_ * 8 * SA_CP) = (u32x2){cvtpk(PRE[j_][0], PRE[j_][1]), cvtpk(PRE[j_][2], PRE[j_][3])}; \
                int p8_ = __builtin_amdgcn_cvt_pk_fp8_f32(PRE[j_][0], PRE[j_][1], 0, false); p8_ = __builtin_amdgcn_cvt_pk_fp8_f32(PRE[j_][2], PRE[j_][3], p8_, true); *(LAS int*)(c8_ + st_b8 + j_ * 8 * SA_C8P) = p8_; } \
            *(LAS u32x2*)(cb_ + st_kpe) = (u32x2){cvtpk(PRE[8][0], PRE[8][1]), cvtpk(PRE[8][2], PRE[8][3])}; } while (0)
        SA_LOAD(preA, 0);
        SA_LOAD(preB, 1);
        __syncthreads();
        SA_STORE(preA, 0);
        if (2 < NT) SA_LOAD(preA, 2);
        f32x16 oacc;
#pragma unroll
        for (int r = 0; r < 16; ++r) oacc[r] = 0.f;
        float lsum[4] = {0.f, 0.f, 0.f, 0.f};
        int unit = 0;
#define SA_RDB(DST, KP, KS) do { const v4u lo_ = *(const LAS v4u*)((KP) + 64 * (KS)), hi_ = *(const LAS v4u*)((KP) + 64 * (KS) + 16); DST = (v8i_t){(int)lo_.x, (int)lo_.y, (int)lo_.z, (int)lo_.w, (int)hi_.x, (int)hi_.y, (int)hi_.z, (int)hi_.w}; } while (0)
#define SA_STEP(T, PRE) do { const int buf = (T) & 1; \
            if ((T & 63) == 0) {    \
                unit = slot + (k0 + (T >> 6)) * nslots; const int db = unit >> 1; \
                {    \
                    const bf16* src = wsp<bf16>(F, WS_QLAT) + (size_t)unit * 32 * 288; (void)db; \
                    int t2_ = tid; asm volatile("" : "+v"(t2_)); \
_Pragma("unroll") \
                    for (int j = 0; j < 3; ++j) { const int id = t2_ + 512 * j; if (id < 1152) { const int row = id / 36, part = id % 36; *(LAS v4u*)(ring + SA_QL + row * SA_CP + part * 16) = *(const v4u*)(src + row * 288 + 8 * part); } } \
                } \
_Pragma("unroll") \
                for (int r = 0; r < 16; ++r) oacc[r] = 0.f; \
_Pragma("unroll") \
                for (int q = 0; q < 4; ++q) lsum[q] = 0.f; \
                __syncthreads(); \
            } \
            const LAS unsigned char* cb = ring + SA_CB + buf * SA_CBSZ; \
            SA_T(0); \
            {    \
                const LAS unsigned char* c8 = ring + SA_C8 + buf * SA_C8SZ + r32 * SA_C8P + hi * 32; \
                float ssq0 = 0.f, ssq1 = 0.f; \
_Pragma("unroll") \
                for (int kt = 0; kt < 2; ++kt) { \
                    const LAS unsigned char* kp = c8 + kt * 32 * SA_C8P; \
                    float ss = 0.f; \
_Pragma("unroll") \
                    for (int mt = 0; mt < 2; ++mt) { \
                        f32x16 a0; \
_Pragma("unroll") \
                        for (int r = 0; r < 16; ++r) a0[r] = 0.f; \
                        v8i_t bq[2]; \
                        SA_RDB(bq[0], kp, 0); \
                        __builtin_amdgcn_sched_barrier(0); \
_Pragma("unroll") \
                        for (int ks = 0; ks < 4; ++ks) { \
                            if (ks < 3) SA_RDB(bq[(ks + 1) & 1], kp, ks + 1); \
                            __builtin_amdgcn_sched_barrier(0); \
                            a0 = __builtin_amdgcn_mfma_scale_f32_32x32x64_f8f6f4(wa8[mt][ks], bq[ks & 1], a0, 0, 0, 0, 0x7F7F7F7F, 0, 0x7F7F7F7F); \
                            __builtin_amdgcn_sched_barrier(0); \
                        } \
_Pragma("unroll") \
                        for (int r = 0; r < 16; ++r) ss += a0[r] * a0[r]; \
                    } \
                    if (kt == 0) ssq0 = ss; else ssq1 = ss; \
                } \
                ssq0 *= (1.0f / 256.0f); ssq1 *= (1.0f / 256.0f); \
_Pragma("unroll") \
                for (int kt = 0; kt < 2; ++kt) { float kf[8]; float ss = 0.f; \
                    unpack8(*(const LAS v4u*)(cb + (32 * kt + r32) * SA_CP + 512 + hi * 32), kf); \
_Pragma("unroll") \
                    for (int e = 0; e < 8; ++e) ss += kf[e] * kf[e]; \
                    unpack8(*(const LAS v4u*)(cb + (32 * kt + r32) * SA_CP + 512 + hi * 32 + 16), kf); \
_Pragma("unroll") \
                    for (int e = 0; e < 8; ++e) ss += kf[e] * kf[e]; \
                    if (kt == 0) ssq0 += ss; else ssq1 += ss; } \
                ssq0 += __shfl_xor(ssq0, 32); ssq1 += __shfl_xor(ssq1, 32); \
                if (hi == 0) { RINV[wave * 64 + r32] = 1.0f / sqrtf(ssq0 * (1.0f / 96.0f) + EPS); RINV[wave * 64 + 32 + r32] = 1.0f / sqrtf(ssq1 * (1.0f / 96.0f) + EPS); } \
            } \
            f32x4 sc = (f32x4){0.f, 0.f, 0.f, 0.f}; \
_Pragma("unroll") \
            for (int ks = 0; ks < (MODE == 6 ? 0 : 9); ++ks) { \
                const bf16x8 af = lds_b128(ring + SA_QL + sc_row * SA_CP + (32 * ks + 8 * g4) * 2); \
                const bf16x8 bfr = lds_b128(cb + sc_key * SA_CP + (32 * ks + 8 * g4) * 2); \
                sc = __builtin_amdgcn_mfma_f32_16x16x32_bf16(af, bfr, sc, 0, 0, 0); \
            } \
            SA_T(2); \
            if (MODE != 4) __syncthreads(); \
            SA_T(3); \
            if (MODE != 6) {    \
                const float rinv = RINV[p_hh * 64 + p_key]; \
_Pragma("unroll") \
                for (int q = 0; q < 4; ++q) { const float p = __builtin_amdgcn_exp2f(sc[q] * rinv - B2); lsum[q] += p; \
                    *(LAS bf16*)(ring + SA_PB + (4 * p_hh + q) * SA_PP + p_key * 2) = (bf16)f2bf(p); } \
            } \
            if (T + 1 < NT) { SA_STORE(PRE, buf ^ 1); if (T + 3 < NT) SA_LOAD(PRE, T + 3); } \
            SA_T(4); \
            if (MODE != 4) __syncthreads(); \
            SA_T(5); \
_Pragma("unroll") \
            for (int s = 0; s < (MODE == 6 ? 0 : 4); ++s) { \
                const bf16x8 pa = lds_b128(ring + SA_PB + r32 * SA_PP + (16 * s + 8 * hi) * 2); \
                const LAS unsigned char* vb = cb + (16 * s + 8 * hi + (tl >> 2)) * SA_CP + (32 * wave + 16 * (g4 & 1) + 4 * (tl & 3)) * 2; \
                const s16x4 lo = tr_read(vb), h4 = tr_read(vb + 4 * SA_CP); \
                oacc = __builtin_amdgcn_mfma_f32_32x32x16_bf16(pa, (bf16x8){lo[0], lo[1], lo[2], lo[3], h4[0], h4[1], h4[2], h4[3]}, oacc, 0, 0, 0); \
            } \
            SA_T(6); \
            if (MODE == 0 && (T & 63) == 63) {    \
                int l2_ = lane; asm volatile("" : "+v"(l2_)); \
                float* part = wsp<float>(F, WS_SPART) + (size_t)unit * SA_PART_STRIDE + 32 * wave + (l2_ & 31); \
_Pragma("unroll") \
                for (int r = 0; r < 16; ++r) __hip_atomic_store((gu32*)(part + crow(r, l2_ >> 5) * 256), __float_as_uint(oacc[r]), RLX_AGENT);     \
_Pragma("unroll") \
                for (int q = 0; q < 4; ++q) { float v = lsum[q]; v += __shfl_xor(v, 1); v += __shfl_xor(v, 2); v += __shfl_xor(v, 4); v += __shfl_xor(v, 8); if ((l2_ & 15) == 0) LSW[wave * 16 + (l2_ >> 4) * 4 + q] = v; } \
                __syncthreads(); \
                if (tid < 32) { const int par = tid >> 4, idx = tid & 15; __hip_atomic_store((gu32*)(wsp<float>(F, WS_SPART) + (size_t)unit * SA_PART_STRIDE + 32 * 256 + tid), __float_as_uint((LSW[(0 + par) * 16 + idx] + LSW[(2 + par) * 16 + idx]) + (LSW[(4 + par) * 16 + idx] + LSW[(6 + par) * 16 + idx])), RLX_AGENT); } \
                  \
                asm volatile("s_waitcnt vmcnt(0)" ::: "memory"); __syncthreads(); \
                if (tid == 0) (void)xb_add((unsigned*)(F.ctl + CW_CFLAG + 64 * (unit >> 1)), 1u); \
            } \
        } while (0)
        for (int T0 = 0; T0 < NT; T0 += 2) { SA_STEP(T0, preB); SA_STEP(T0 + 1, preA); }
#undef SA_STEP
#undef SA_RDB
#undef SA_LOAD
#undef SA_STORE
    }
    if (MODE == 0) {
        __syncthreads();
#pragma unroll 1
        for (int k = 0; k < nunits_cu; ++k) { const int un = slot + k * nslots, db = un >> 1;
            if (tid == 0) { unsigned* fl = (unsigned*)(F.ctl + CW_CFLAG + 64 * db); unsigned* barw = (unsigned*)(F.ctl + CW_BAR);
                XB_SPIN(xb_ld(fl) < (unsigned)SA_UNITS_PER_SEQ, barw);
                __builtin_amdgcn_fence(__ATOMIC_ACQUIRE, "agent"); asm volatile("s_waitcnt vmcnt(0)" ::: "memory"); }
            __syncthreads();
            if (wave < 4) attn_combine_job(F, db, 4 * (un & 1) + wave);
            __syncthreads(); }
    }
#ifdef SA_PROF
    if (blockIdx.x == SA_PROF && tid == 64 * (SA_PROFW)) { float* st = (float*)(F.ws + WS_END); st[0] = prof_acc; st[1] = (float)((unsigned)__builtin_readcyclecounter() - prof_t0); if (SA_PROFK == 9) { st[0] = st[1]; st[1] = (float)(__builtin_amdgcn_s_memrealtime() - prof_rt0) * 40.0f; } if (SA_PROFK == 8) { st[0] = (float)(__builtin_amdgcn_s_memrealtime() - prof_rt0); st[1] = 100000.0f; } }
#endif
    __syncthreads();
}


__device__ __forceinline__ void attn_combine_job(Frame& F, const int db, const int h) {
    const int lane = F.lane, wave = F.wave;
    const float B2 = attn_bound(F);
    LAS float* LO = (LAS float*)(F.lds + RING_OFF) + wave * 1024;
    const bf16* Qg = wsp<bf16>(F, WS_Q); const bf16* Kg = wsp<bf16>(F, WS_K); const bf16* CKV = wsp<bf16>(F, WS_CKV);
    const float* wuv = INP(I_WUV); const float* GG = wsp<float>(F, WS_GG);
    {
        float ol[4][4], l[4];
#pragma unroll
        for (int q = 0; q < 4; ++q) { l[q] = 0.f;
#pragma unroll
            for (int i = 0; i < 4; ++i) ol[q][i] = 0.f; }
#pragma unroll
        for (int u = 0; u < SA_UNITS_PER_SEQ; ++u) {
            const float* part = wsp<float>(F, WS_SPART) + (size_t)(db * SA_UNITS_PER_SEQ + u) * SA_PART_STRIDE;
#pragma unroll
            for (int q = 0; q < 4; ++q) { l[q] += part[32 * 256 + 4 * h + q];
#pragma unroll
                for (int i = 0; i < 4; ++i) ol[q][i] += part[(4 * h + q) * 256 + lane + 64 * i]; }
        }
#pragma unroll
        for (int jn = 0; jn < 4; ++jn) {
            const size_t rk = (size_t)(MP + db * 4 + jn);
            const float kn = bf2f(Kg[rk * 768 + h * 96 + lane]); const float kr = (lane < 32) ? bf2f(Kg[rk * 768 + h * 96 + 64 + lane]) : 0.f;
            float c4[4];
#pragma unroll
            for (int i = 0; i < 4; ++i) c4[i] = bf2f(CKV[rk * 256 + lane + 64 * i]);
#pragma unroll
            for (int q = 0; q < 4; ++q) if (q >= jn) {
                const size_t rq = (size_t)(MP + db * 4 + q);
                const float qn = bf2f(Qg[rq * 768 + h * 96 + lane]); const float qr = (lane < 32) ? bf2f(Qg[rq * 768 + h * 96 + 64 + lane]) : 0.f;
                const float* sq = wsp<float>(F, WS_SSQQ) + rq * 16; const float rinvq = 1.0f / sqrtf((sq[h] + sq[8 + h]) * (1.0f / 96.0f) + EPS);
                const float s = wave_sum(qn * kn * GG[lane] + qr * kr * GG[64 + (lane & 31)]) * rinvq; const float p = __builtin_amdgcn_exp2f(s - B2);
                l[q] += p;
#pragma unroll
                for (int i = 0; i < 4; ++i) ol[q][i] += p * c4[i];
            }
        }
#pragma unroll
        for (int q = 0; q < 4; ++q)
#pragma unroll
            for (int i = 0; i < 4; ++i) LO[q * 256 + lane + 64 * i] = ol[q][i];
        LDS_WAIT(); asm volatile("" ::: "memory");
        float o[4] = {0.f, 0.f, 0.f, 0.f};
#pragma unroll 1
        for (int c0 = 0; c0 < KVLORA; c0 += 64) {
            float w[64];
#pragma unroll
            for (int cc = 0; cc < 64; ++cc) w[cc] = wuv[(size_t)(c0 + cc) * 512 + h * 64 + lane];
#pragma unroll
            for (int cc = 0; cc < 64; ++cc)
#pragma unroll
                for (int q = 0; q < 4; ++q) o[q] += LO[q * 256 + c0 + cc] * w[cc];
        }
#pragma unroll
        for (int q = 0; q < 4; ++q) wsp<bf16>(F, WS_O)[(size_t)(MP + db * 4 + q) * 512 + h * 64 + lane] = (bf16)f2bf(o[q] / l[q]);
        LDS_WAIT(); asm volatile("" ::: "memory");
    }
}
}
namespace mk {
struct Args { const float* in[26]; float* out; unsigned char* ws; int ph_lo, ph_hi, li, pad; };
#ifndef SA_VARIANT
#define SA_VARIANT 0
#endif
#ifndef REP_PHASE
#define REP_PHASE -1
#endif
#ifndef REP_COUNT
#define REP_COUNT 1
#endif
#define NREP(k) (((k) == REP_PHASE) ? REP_COUNT : 1)
enum { PH_PRO = 0, PH_INPROJ, PH_ROWA, PH_QKV, PH_ROWC, PH_ATTN, PH_COMB, PH_MERGE, PH_OUT, PH_GU, PH_DOWN, PH_N };

__global__ void __launch_bounds__(NTHREADS, 2) fused_fwd(Args args) {
    extern __shared__ __attribute__((aligned(16))) unsigned char lds[];
    Frame F;
    F.lds = (LAS unsigned char*)lds;
    F.MISC = (volatile LAS unsigned*)(F.lds + MISC_OFF);
    F.tid = threadIdx.x; F.lane = F.tid & 63; F.wave = __builtin_amdgcn_readfirstlane(F.tid >> 6);
    F.G = gridDim.x;
#pragma unroll
    for (int i = 0; i < 26; ++i) F.in[i] = args.in[i];
    F.out = args.out; F.ws = args.ws; F.ctl = (gu32*)(args.ws + WS_CTL);
    for (int u = F.tid; u < (LDS_BYTES - LDSCTL_OFF) / 4; u += NTHREADS) ((LAS unsigned*)(F.lds + LDSCTL_OFF))[u] = 0u;
    __syncthreads();
    XcdBarrier bar = xcd_barrier_post((unsigned*)(F.ctl + CW_BAR) + args.li * XCD_BAR_WORDS, F.MISC + 8);
    const int lo = args.ph_lo, hi = args.ph_hi;
#define IN(k) (lo <= (k) && (k) < hi)
#define SEAM(k) do { if (IN(k) && IN((k) + 1)) xcd_barrier(bar); } while (0)
#define PHASE_BEGIN() do { int t_; asm volatile("v_mbcnt_lo_u32_b32 %0, -1, 0\n\tv_mbcnt_hi_u32_b32 %0, -1, %0" : "=v"(t_)); F.lane = t_; F.tid = t_ + 64 * F.wave; } while (0)
    const int gw = blockIdx.x * NWAVES + F.wave, NGW = F.G * NWAVES;
    LAS unsigned char* ring = F.lds + RING_OFF;

    const int ip_rounds = (66 * 15 + F.G - 1) / F.G, ip_nfull = 66 * 15 - (ip_rounds - 1) * F.G; const bool late_in_ip = (F.G - ip_nfull >= 16) && IN(PH_INPROJ);
    if (IN(PH_PRO)) { PHASE_BEGIN(); p0_prologue(F, late_in_ip); }
    SEAM(PH_PRO);
    if (IN(PH_INPROJ)) { PHASE_BEGIN();
        pg8::Gemm g{wsp<bf16>(F, WS_H), wsp<bf16>(F, WS_WIN), M, NIN, 1024}; pg8::StaticOrder S; S.init(M, NIN, F.G, (int)blockIdx.x);
        EpiInProj E{wsp<bf16>(F, WS_U), wsp<bf16>(F, WS_G), wsp<bf16>(F, WS_RAW), F.out};
        pg8::gemm_phase<EpiInProj, pg8::StaticOrder, true, true>(ring, g, S, E, F.wave);
        if (late_in_ip && (int)blockIdx.x >= ip_nfull) { PHASE_BEGIN(); const int ci = (int)blockIdx.x - ip_nfull, nc = F.G - ip_nfull;
            p0_late(F, ci * NWAVES + F.wave, nc * NWAVES, ci * NTHREADS + F.tid, nc * NTHREADS); }
    }
    SEAM(PH_INPROJ);
    if (IN(PH_ROWA)) { PHASE_BEGIN();
        p2a_rows(F, gw, NGW);
        for (int it = blockIdx.x; it < CONV_ITEMS; it += F.G) conv_item(F, it);
    }
    SEAM(PH_ROWA);
    if (IN(PH_QKV)) { PHASE_BEGIN();
        const int sb = (int)blockIdx.x;
        const int xb = (F.G >= 214) ? 192 : 0, xe = sb - xb;
        { pg8::Gemm g{wsp<bf16>(F, WS_CQN), wsp<bf16>(F, WS_WUQ), M, NQP, 384}; QOrder S; S.init(F.G, sb, (xe >= 0 && xe < 6) ? xe : -1);
          EpiQ3 E{wsp<bf16>(F, WS_Q), wsp<float>(F, WS_SSQQ), wsp<float>(F, WS_TAB)}; pg8::gemm_phase<EpiQ3, QOrder, true, true>(ring, g, S, E, F.wave); }
        { pg8::Gemm g{wsp<bf16>(F, WS_CKV), wsp<bf16>(F, WS_WKV), M, 1024, 256}; ExtraOrder S; S.init(1024, F.G, sb, (xe >= 6 && xe < 14) ? xe - 6 : -1);
          EpiKV3 E{wsp<bf16>(F, WS_K), wsp<bf16>(F, WS_V), wsp<float>(F, WS_KPE), wsp<float>(F, WS_KPESSQ)}; pg8::gemm_phase<EpiKV3, ExtraOrder, true, true>(ring, g, S, E, F.wave); }
        { pg8::Gemm g{wsp<bf16>(F, WS_T), wsp<bf16>(F, WS_WC), M, 1024, 512}; ExtraOrder S; S.init(1024, F.G, sb, (xe >= 14 && xe < 22) ? xe - 14 : -1);
          EpiConv E{wsp<bf16>(F, WS_G), wsp<bf16>(F, WS_CONVO)}; pg8::gemm_phase<EpiConv, ExtraOrder, true, true>(ring, g, S, E, F.wave); }
        if (F.G > xb + 22) { if (sb >= xb + 22) { PHASE_BEGIN(); convert_weights<1>(F, (sb - xb - 22) * NWAVES + F.wave, (F.G - xb - 22) * NWAVES); } }
        else { PHASE_BEGIN(); convert_weights<1>(F, gw, NGW); }
    }
    SEAM(PH_QKV);
    if (IN(PH_ATTN)) { PHASE_BEGIN();
        attn_prompt_phase(F);
        PHASE_BEGIN(); attn_sample_phase<0>(F);
    }
    SEAM(PH_ATTN);
    if (IN(PH_MERGE)) { PHASE_BEGIN();
        pg8::Gemm g{wsp<bf16>(F, WS_O), wsp<bf16>(F, WS_WO), M, 1024, 512}; pg8::StaticOrder S; S.init(M, 1024, F.G, (int)blockIdx.x);
        EpiMerge E{wsp<bf16>(F, WS_G), wsp<bf16>(F, WS_CONVO), wsp<bf16>(F, WS_MERGED)}; pg8::gemm_phase<EpiMerge, pg8::StaticOrder, true, true>(ring, g, S, E, F.wave);
        { const int nfirst = (66 * 4 > F.G) ? 66 * 4 - F.G : 0;
          const int sb2 = (int)blockIdx.x;
          if (F.G > nfirst && nfirst < F.G) { if (sb2 >= nfirst) { PHASE_BEGIN(); convert_weights<2>(F, (sb2 - nfirst) * NWAVES + F.wave, (F.G - nfirst) * NWAVES); css_copy(F, (sb2 - nfirst) * NTHREADS + F.tid, (F.G - nfirst) * NTHREADS); } }
          else { PHASE_BEGIN(); convert_weights<2>(F, gw, NGW); css_copy(F, (int)blockIdx.x * NTHREADS + F.tid, F.G * NTHREADS); } }
    }
    SEAM(PH_MERGE);
    if (IN(PH_OUT)) { PHASE_BEGIN();
        { pg8::Gemm g{wsp<bf16>(F, WS_MERGED), wsp<bf16>(F, WS_WOUT), MP, 1024, 1024}; pg8::StaticOrder S; S.init(MP, 1024, F.G, (int)blockIdx.x);
          EpiOut E{INP(I_XP), INP(I_XS), F.out + O_YP, wsp<bf16>(F, WS_X1B), wsp<float>(F, WS_SSQ2)}; pg8::gemm_phase<EpiOut, pg8::StaticOrder, true, true>(ring, g, S, E, F.wave); }
        {
            const int sb = (int)blockIdx.x, ch = sb >> 3;
            pg8::Gemm g{wsp<bf16>(F, WS_MERGED) + (size_t)MP * 1024 + 256 * (ch & 3), wsp<bf16>(F, WS_WOUT) + 256 * (ch & 3), MS, 1024, 256, 1024, 1024}; ListOrder S{sb & 7, 4, sb < 8 * OUT_SPLIT ? 1 : 0};
            EpiPart E{wsp<float>(F, WS_PARTK) + (size_t)(ch & 3) * 512 * 1024}; pg8::gemm_phase<EpiPart, ListOrder, true, true>(ring, g, S, E, F.wave); }
        xcd_barrier(bar);
        PHASE_BEGIN();
        for (int r = gw; r < MS; r += NGW) fixup_out_row(F, r);
        rinvf_rows(F, (int)blockIdx.x * NTHREADS + F.tid, F.G * NTHREADS);
    }
    SEAM(PH_OUT);
    if (IN(PH_GU)) { PHASE_BEGIN();
        pg8::Gemm g{wsp<bf16>(F, WS_X1B), wsp<bf16>(F, WS_WGU), M, NGU, 1024}; pg8::StaticOrder S; S.init(M, NGU, F.G, (int)blockIdx.x);
        EpiGateUp E{wsp<float>(F, WS_RINVF), wsp<bf16>(F, WS_ACT)}; pg8::gemm_phase<EpiGateUp, pg8::StaticOrder, true, true>(ring, g, S, E, F.wave);
    }
    SEAM(PH_GU);
    if (IN(PH_DOWN)) { PHASE_BEGIN();
        {
            const int sb = (int)blockIdx.x; int ch = sb >> 3; if (ch >= DOWN_SPLIT) ch = 0;
            pg8::Gemm g{wsp<bf16>(F, WS_ACT) + (size_t)MP * DFF + 256 * ch, wsp<bf16>(F, WS_WD) + 256 * ch, MS, 1024, 256, DFF, DFF}; ListOrder S{sb & 7, 4, sb < 8 * DOWN_SPLIT ? 1 : 0};
            EpiPartWT E{wsp<float>(F, WS_PARTK) + (size_t)ch * 512 * 1024}; pg8::gemm_phase<EpiPartWT, ListOrder, true, true>(ring, g, S, E, F.wave);
            if (sb < 8 * DOWN_SPLIT) { asm volatile("s_waitcnt vmcnt(0)" ::: "memory"); __syncthreads(); if (F.tid == 0) (void)xb_add((unsigned*)(F.ctl + CW_DFLAG), 1u); } }
        { pg8::Gemm g{wsp<bf16>(F, WS_ACT), wsp<bf16>(F, WS_WD), MP, 1024, DFF}; pg8::StaticOrder S; S.init(MP, 1024, F.G, (int)blockIdx.x);
          EpiDown E{F.out + O_YP, wsp<bf16>(F, WS_X1B)}; pg8::gemm_phase<EpiDown, pg8::StaticOrder, true, true>(ring, g, S, E, F.wave); }
        PHASE_BEGIN();
        if (F.tid == 0) { unsigned* f_ = (unsigned*)(F.ctl + CW_DFLAG); XB_SPIN(xb_ld(f_) < (unsigned)(8 * DOWN_SPLIT), bar.bar);
            __builtin_amdgcn_fence(__ATOMIC_ACQUIRE, "agent"); asm volatile("s_waitcnt vmcnt(0)" ::: "memory"); }
        __syncthreads();
        for (int r = gw; r < MS; r += NGW) fixup_down_row(F, r);
    }
#undef IN
#undef SEAM
}

static int g_grid = 0;
inline bool setup_once() {
    if (g_grid == 0) {
        int dev = 0, cus = 0, per_cu = 0;
        if (hipGetDevice(&dev) != hipSuccess || hipDeviceGetAttribute(&cus, hipDeviceAttributeMultiprocessorCount, dev) != hipSuccess) { g_grid = -1; return false; }
        if (hipFuncSetAttribute((const void*)fused_fwd, hipFuncAttributeMaxDynamicSharedMemorySize, LDS_BYTES) != hipSuccess) { g_grid = -1; return false; }
        if (hipOccupancyMaxActiveBlocksPerMultiprocessor(&per_cu, (const void*)fused_fwd, NTHREADS, LDS_BYTES) != hipSuccess || per_cu < 1) { fprintf(stderr, "occupancy query says %d\n", per_cu); }
        (void)hipGetLastError();
        g_grid = cus;
    }
    return g_grid > 0;
}
inline void launch_phases(void* const* d_in, void* d_out, void* d_ws, hipStream_t stream, int lo, int hi, int li) {
    Args a{};
    for (int i = 0; i < 26; ++i) a.in[i] = (const float*)d_in[i];
    a.out = (float*)d_out; a.ws = (unsigned char*)d_ws; a.ph_lo = lo; a.ph_hi = hi; a.li = li; a.pad = 0;
    hipLaunchKernelGGL(fused_fwd, dim3(g_grid), dim3(NTHREADS), LDS_BYTES, stream, a);
}
}
extern "C" void kernel_launch(void* const* d_in, const int* in_sizes, int n_in, void* d_out, int out_size, void* d_ws, size_t ws_size, hipStream_t stream) {
    if (!mk::setup_once()) return;
    if (n_in != 26 || (size_t)out_size != mk::O_END || ws_size < mk::WS_END) { fprintf(stderr, "kernel_launch: unexpected shapes\n"); return; }
    if (hipMemsetAsync((char*)d_ws + mk::WS_CTL, 0, mk::CTL_ZERO_BYTES, stream) != hipSuccess) return;
    mk::launch_phases(d_in, d_out, d_ws, stream, 0, mk::PH_N, 0);
}
```
